# Optimizing an MI355X kernel written in HIP

```python
import math
import jax
import jax.numpy as jnp
from jax import lax
import numpy as np

D_MODEL = 2048
BATCH = 4
SEQ = 2048
DEPTH = 2

GRID_W = 64
CTX_LEN = 256
N_MOD = 9
N_NORMS = 6
D_FF = 5504
FFN_RES_WEIGHT = 0.5
EPS = 1e-6

ATT_HEADS = 8
ATT_QK = 64
ATT_V = 2 * ATT_QK
ATT_BLOCK = 128
ROPE_THETA = 10000.0
ROPE_PAIRS = ATT_QK // 4
LAMBDA_INIT_BASE = 0.8
LAMBDA_INIT_AMP = 0.6
LAMBDA_INIT_RATE = 0.3

REC_HEADS = 8
REC_DK = 128
REC_DV = 128
REC_CHUNK = 64

CONV_WIDTH = D_MODEL
CONV_K = 3

N_EVEN = (DEPTH + 1) // 2
N_ODD = DEPTH // 2
ATT_QK_COLS = ATT_HEADS * 2 * ATT_QK
ATT_V_COLS = ATT_HEADS * ATT_V
REC_K_COLS = REC_HEADS * REC_DK
REC_V_COLS = REC_HEADS * REC_DV
MIX_SPLITS = (ATT_QK_COLS, ATT_QK_COLS, ATT_V_COLS, REC_K_COLS, REC_K_COLS, REC_K_COLS, REC_V_COLS, REC_V_COLS)
MIX_IN = 2 * ATT_QK_COLS + ATT_V_COLS + 3 * REC_K_COLS + 2 * REC_V_COLS
MIX_OUT = ATT_V_COLS + REC_V_COLS

kernel_name = 'hybrid_diffattn_hgrn2_shortconv_dit'


def _rms_norm(x, g):
    xf = x.astype(jnp.float32)
    y = xf * lax.rsqrt(jnp.mean(xf * xf, axis=-1, keepdims=True) + EPS)
    return (y * g.astype(jnp.float32)).astype(x.dtype)


def _modulation(cond, w, b):
    m = jax.nn.silu(cond) @ w + b
    return jnp.split(m[..., None, :], N_MOD, axis=-1)


def _modulate(x, g, shift, scale):
    return _rms_norm(x, g) * (1 + scale) + shift


def _residual(x, y, g, gate, weight):
    return x + weight * gate * _rms_norm(y, g)


def _swiglu(h, w_gate, w_up, w_down):
    return (jax.nn.silu(h @ w_gate) * (h @ w_up)) @ w_down


def _ffn_half(x, mods, g_pre, g_post, w_gate, w_up, w_down):
    shift, scale, gate = mods
    y = _swiglu(_modulate(x, g_pre, shift, scale), w_gate, w_up, w_down)
    return _residual(x, y, g_post, gate, FFN_RES_WEIGHT)


def _axial_rope(t, n):
    rows = n // GRID_W
    row = jnp.broadcast_to(jnp.arange(rows, dtype=jnp.float32)[:, None], (rows, GRID_W)).reshape(n)
    col = jnp.broadcast_to(jnp.arange(GRID_W, dtype=jnp.float32)[None, :], (rows, GRID_W)).reshape(n)
    freqs = ROPE_THETA ** (-jnp.arange(ROPE_PAIRS, dtype=jnp.float32) / ROPE_PAIRS)

    def rot(part, pos):
        ang = (pos[:, None] * freqs)[:, None, None, :]
        cos, sin = jnp.cos(ang), jnp.sin(ang)
        p = part.astype(jnp.float32)
        p1, p2 = p[..., :ROPE_PAIRS], p[..., ROPE_PAIRS:]
        return jnp.concatenate([p1 * cos - p2 * sin, p2 * cos + p1 * sin], axis=-1)

    half = ATT_QK // 2
    out = jnp.concatenate([rot(t[..., :half], row), rot(t[..., half:], col)], axis=-1)
    return out.astype(t.dtype)


def _diff_attend(q, k, v, lam):
    s = jnp.einsum('bqhmd,bkhmd->bhmqk', q, k).astype(jnp.float32) * (ATT_QK ** -0.5)
    p = jax.nn.softmax(s, axis=-1)
    w = (p[:, :, 0] - lam * p[:, :, 1]).astype(v.dtype)
    return jnp.einsum('bhqk,bkhv->bqhv', w, v)


def _diff_attention(q_lat, k_lat, v_lat, q_ctx, k_ctx, v_ctx, lam, with_ctx_out):
    k_all = jnp.concatenate([k_ctx, k_lat], axis=1)
    v_all = jnp.concatenate([v_ctx, v_lat], axis=1)
    b, n = q_lat.shape[:2]
    nblk = n // ATT_BLOCK
    qb = jnp.moveaxis(q_lat.reshape(b, nblk, ATT_BLOCK, ATT_HEADS, 2, ATT_QK), 1, 0)
    o = lax.map(lambda qi: _diff_attend(qi, k_all, v_all, lam), qb)
    o_lat = jnp.moveaxis(o, 0, 1).reshape(b, n, ATT_HEADS, ATT_V)
    o_ctx = _diff_attend(q_ctx, k_ctx, v_ctx, lam) if with_ctx_out else None
    return o_lat, o_ctx


def _gates(z, lb):
    lb = lb.reshape(REC_HEADS, REC_DK)
    f = lb + (1.0 - lb) * jax.nn.sigmoid(z)
    return 1.0 - f, jnp.log(f)


def _gla_chunked(q, k, v, log_f, state, with_output):
    b, n, h, dk = q.shape
    nc = n // REC_CHUNK

    def chunks(a):
        return jnp.moveaxis(a.reshape(b, nc, REC_CHUNK, h, a.shape[-1]), 1, 0)

    lower = jnp.tril(jnp.ones((REC_CHUNK, REC_CHUNK), dtype=bool))[None, :, :, None, None]

    def step(s, inp):
        qc, kc, vc, gc = inp
        cum = jnp.cumsum(gc, axis=1)
        last = cum[:, -1]
        s_new = s * jnp.exp(last)[..., None] + jnp.einsum('bshk,bshv->bhkv', kc * jnp.exp(last[:, None] - cum), vc)
        if not with_output:
            return s_new, None
        o_inter = jnp.einsum('bthk,bhkv->bthv', qc * jnp.exp(cum), s)
        decay = jnp.exp(jnp.where(lower, cum[:, :, None] - cum[:, None], -jnp.inf))
        att = jnp.einsum('bthk,bshk,btshk->bhts', qc, kc, decay)
        return s_new, o_inter + jnp.einsum('bhts,bshv->bthv', att, vc)

    s_final, o = lax.scan(step, state, (chunks(q), chunks(k), chunks(v), chunks(log_f)))
    if with_output:
        o = jnp.moveaxis(o, 0, 1).reshape(b, n, h, v.shape[-1])
    return o, s_final


def _hgrn2_bidir(rec_lat, rec_ctx, lb_fwd, lb_bwd, with_ctx_out):
    q_l, zf_l, zb_l, i_l = rec_lat
    q_c, zf_c, zb_c, i_c = rec_ctx
    s0 = jnp.zeros((q_l.shape[0], REC_HEADS, REC_DK, REC_DV), jnp.float32)
    flip = lambda a: jnp.flip(a, axis=1)
    k_c, g_c = _gates(zf_c, lb_fwd)
    k_l, g_l = _gates(zf_l, lb_fwd)
    oc_f, s_f = _gla_chunked(q_c, k_c, i_c, g_c, s0, with_ctx_out)
    ol_f, _ = _gla_chunked(q_l, k_l, i_l, g_l, s_f, True)
    k_c, g_c = _gates(flip(zb_c), lb_bwd)
    k_l, g_l = _gates(flip(zb_l), lb_bwd)
    oc_b, s_b = _gla_chunked(flip(q_c), k_c, flip(i_c), g_c, s0, with_ctx_out)
    ol_b, _ = _gla_chunked(flip(q_l), k_l, flip(i_l), g_l, s_b, True)
    o_lat = ol_f + flip(ol_b)
    o_ctx = oc_f + flip(oc_b) if with_ctx_out else None
    return o_lat, o_ctx


def _mixer_even(h_lat, h_ctx, w_in, w_out, lam_vecs, att_norm_g, rec_norm_g, lb_fwd, lb_bwd, lam_init, with_ctx_out):
    split_at = np.cumsum(MIX_SPLITS)[:-1].tolist()

    def project(h):
        b, n = h.shape[:2]
        qa, ka, va, qr, zf, zb, ir, gr = jnp.split(h @ w_in, split_at, axis=-1)
        att = (qa.reshape(b, n, ATT_HEADS, 2, ATT_QK), ka.reshape(b, n, ATT_HEADS, 2, ATT_QK),
               va.reshape(b, n, ATT_HEADS, ATT_V))
        f32 = lambda a, d: a.reshape(b, n, REC_HEADS, d).astype(jnp.float32)
        rec = (f32(qr, REC_DK) * (REC_DK ** -0.5), f32(zf, REC_DK), f32(zb, REC_DK), f32(ir, REC_DV))
        return att, rec, gr.reshape(b, n, REC_HEADS, REC_DV)

    (qa_l, ka_l, va_l), rec_l, g_l = project(h_lat)
    (qa_c, ka_c, va_c), rec_c, g_c = project(h_ctx)
    n = h_lat.shape[1]
    qa_l = _axial_rope(qa_l, n)
    ka_l = _axial_rope(ka_l, n)
    lv = lam_vecs.astype(jnp.float32)
    lam = jnp.exp(jnp.sum(lv[0] * lv[1])) - jnp.exp(jnp.sum(lv[2] * lv[3])) + lam_init
    oa_l, oa_c = _diff_attention(qa_l, ka_l, va_l, qa_c, ka_c, va_c, lam, with_ctx_out)
    or_l, or_c = _hgrn2_bidir(rec_l, rec_c, lb_fwd, lb_bwd, with_ctx_out)

    def merge(oa, orec, g):
        b, n = g.shape[:2]
        oa = _rms_norm(oa, att_norm_g) * (1.0 - lam_init)
        orec = (_rms_norm(orec, rec_norm_g) * jax.nn.silu(g.astype(jnp.float32))).astype(g.dtype)
        return jnp.concatenate([oa.reshape(b, n, ATT_V_COLS), orec.reshape(b, n, REC_V_COLS)], axis=-1) @ w_out

    y_lat = merge(oa_l, or_l, g_l)
    y_ctx = merge(oa_c, or_c, g_c) if with_ctx_out else None
    return y_lat, y_ctx


def _short_conv(h, w_in, conv_w, w_out):
    b_gate, c_gate, v = jnp.split(h @ w_in, 3, axis=-1)
    u = lax.conv_general_dilated(c_gate * v, conv_w[:, None, :], window_strides=(1,), padding='SAME',
                                 dimension_numbers=('NWC', 'WIO', 'NWC'), feature_group_count=CONV_WIDTH)
    return (b_gate * u) @ w_out


def setup_inputs(seed: int = 0) -> dict:
    key = jax.random.key(seed)
    ks = jax.random.split(key, 20)
    nrm = lambda k, shape, std: std * jax.random.normal(k, shape, jnp.float32)
    return {
        'x': nrm(ks[0], (BATCH, SEQ, D_MODEL), 1.0),
        'c': nrm(ks[1], (BATCH, D_MODEL), 1.0),
        'ctx': nrm(ks[2], (BATCH, CTX_LEN, D_MODEL), 1.0),
        'c_ctx': nrm(ks[3], (D_MODEL,), 1.0),
        'ada_w': nrm(ks[4], (DEPTH, D_MODEL, N_MOD * D_MODEL), 0.5 * D_MODEL ** -0.5),
        'ada_b': nrm(ks[5], (DEPTH, N_MOD * D_MODEL), 0.02),
        'norm_g': 1.0 + nrm(ks[6], (DEPTH, N_NORMS, D_MODEL), 0.02),
        'ffn_w_gate': nrm(ks[7], (DEPTH, 2, D_MODEL, D_FF), D_MODEL ** -0.5),
        'ffn_w_up': nrm(ks[8], (DEPTH, 2, D_MODEL, D_FF), D_MODEL ** -0.5),
        'ffn_w_down': nrm(ks[9], (DEPTH, 2, D_FF, D_MODEL), D_FF ** -0.5),
        'mix_w_in': nrm(ks[10], (N_EVEN, D_MODEL, MIX_IN), D_MODEL ** -0.5),
        'mix_w_out': nrm(ks[11], (N_EVEN, MIX_OUT, D_MODEL), MIX_OUT ** -0.5),
        'diff_lambda': nrm(ks[12], (N_EVEN, 4, ATT_QK), 0.1),
        'diff_norm_g': 1.0 + nrm(ks[13], (N_EVEN, ATT_V), 0.02),
        'rec_norm_g': 1.0 + nrm(ks[14], (N_EVEN, REC_DV), 0.02),
        'rec_lb': nrm(ks[15], (2, N_EVEN + 1, REC_K_COLS), 0.1),
        'conv_w_in': nrm(ks[16], (N_ODD, D_MODEL, 3 * CONV_WIDTH), D_MODEL ** -0.5),
        'conv_w': nrm(ks[17], (N_ODD, CONV_K, CONV_WIDTH), CONV_K ** -0.5),
        'conv_w_out': nrm(ks[18], (N_ODD, CONV_WIDTH, D_MODEL), CONV_WIDTH ** -0.5),
    }


def reference(x, c, ctx, c_ctx, ada_w, ada_b, norm_g, ffn_w_gate, ffn_w_up, ffn_w_down, mix_w_in, mix_w_out,
              diff_lambda, diff_norm_g, rec_norm_g, rec_lb, conv_w_in, conv_w, conv_w_out):
    x_ctx = ctx
    lb_all = jnp.cumsum(jax.nn.softmax(rec_lb.astype(jnp.float32), axis=1), axis=1)
    for l in range(DEPTH):
        even = l % 2 == 0
        ctx_out = any(j % 2 == 0 for j in range(l + 1, DEPTH))
        ctx_in = even or ctx_out
        g_n = norm_g[l]
        m_lat = _modulation(c, ada_w[l], ada_b[l])
        ffn1 = (ffn_w_gate[l, 0], ffn_w_up[l, 0], ffn_w_down[l, 0])
        ffn2 = (ffn_w_gate[l, 1], ffn_w_up[l, 1], ffn_w_down[l, 1])
        x = _ffn_half(x, m_lat[0:3], g_n[0], g_n[1], *ffn1)
        if ctx_in:
            m_ctx = _modulation(c_ctx, ada_w[l], ada_b[l])
            x_ctx = _ffn_half(x_ctx, m_ctx[0:3], g_n[0], g_n[1], *ffn1)
        h_lat = _modulate(x, g_n[2], m_lat[3], m_lat[4])
        if even:
            e = l // 2
            h_ctx = _modulate(x_ctx, g_n[2], m_ctx[3], m_ctx[4])
            lam_init = LAMBDA_INIT_BASE - LAMBDA_INIT_AMP * math.exp(-LAMBDA_INIT_RATE * l)
            y_lat, y_ctx = _mixer_even(h_lat, h_ctx, mix_w_in[e], mix_w_out[e], diff_lambda[e], diff_norm_g[e],
                                       rec_norm_g[e], lb_all[0, e], lb_all[1, e], lam_init, ctx_out)
        else:
            o = l // 2
            y_lat = _short_conv(h_lat, conv_w_in[o], conv_w[o], conv_w_out[o])
            y_ctx = None
            if ctx_out:
                h_ctx = _modulate(x_ctx, g_n[2], m_ctx[3], m_ctx[4])
                y_ctx = _short_conv(h_ctx, conv_w_in[o], conv_w[o], conv_w_out[o])
        x = _residual(x, y_lat, g_n[3], m_lat[5], 1.0)
        x = _ffn_half(x, m_lat[6:9], g_n[4], g_n[5], *ffn2)
        if ctx_out:
            x_ctx = _residual(x_ctx, y_ctx, g_n[3], m_ctx[5], 1.0)
            x_ctx = _ffn_half(x_ctx, m_ctx[6:9], g_n[4], g_n[5], *ffn2)
    return x
```

```cpp
#include <hip/hip_runtime.h>
#include <hip/hip_cooperative_groups.h>
#include <cstdio>
#include <cstdint>
namespace cg = cooperative_groups;

#ifndef MK_MULTI
#define MK_MULTI 0
#endif

#ifndef MK_PROBE
#define MK_PROBE 0
#endif
#ifndef MK_DIAG_ZERO
#define MK_DIAG_ZERO 0
#endif
#define LAS __attribute__((address_space(3)))
typedef unsigned short bf16_t;
typedef short bf16x8 __attribute__((ext_vector_type(8)));
typedef short s16x4 __attribute__((ext_vector_type(4)));
typedef float f32x2 __attribute__((ext_vector_type(2)));
typedef float f32x4 __attribute__((ext_vector_type(4)));
typedef float f32x16 __attribute__((ext_vector_type(16)));
typedef unsigned u32x2 __attribute__((ext_vector_type(2)));
typedef unsigned u32x4 __attribute__((ext_vector_type(4)));

constexpr int DM = 2048, NB = 4, SEQ = 2048, CTX = 256, RS = SEQ + CTX, MR = NB * RS, ML = NB * SEQ, DFF = 5504, MODW = 9 * DM, MIXIN = 8192;
constexpr float EPS = 1e-6f;
constexpr int NPHASE = 23;
constexpr int LDS_BYTES = 147456;

struct Args { const float* in[19]; float* out; unsigned char* ws; int ph_lo, ph_hi; };
enum { I_X = 0, I_C, I_CTX, I_CCTX, I_ADAW, I_ADAB, I_NORMG, I_WG, I_WU, I_WDN, I_MIXIN, I_MIXOUT, I_DLAM, I_DNG, I_RNG, I_RLB, I_CWIN, I_CW, I_CWOUT };

constexpr size_t WS_MOD = 0;
constexpr size_t WS_ROPE = WS_MOD + (size_t)2 * 5 * MODW * 4;
constexpr size_t SZ_WGU = (size_t)2 * DFF * DM * 2, SZ_WD = (size_t)DM * DFF * 2;
constexpr size_t WS_BAR = WS_ROPE + 8192;
constexpr size_t WS_WGU = WS_BAR + 16384;
constexpr size_t WS_WD = WS_WGU + 4 * SZ_WGU;
constexpr size_t WS_WMI = WS_WD + 4 * SZ_WD;
constexpr size_t WS_WMO = WS_WMI + (size_t)MIXIN * DM * 2;
constexpr size_t WS_WCI = WS_WMO + (size_t)DM * DM * 2;
constexpr size_t WS_WCO = WS_WCI + (size_t)3 * DM * DM * 2;
constexpr size_t WS_H = WS_WCO + (size_t)DM * DM * 2;
constexpr size_t WS_ACT = WS_H + (size_t)MR * DM * 2;
constexpr size_t WS_Y = WS_ACT + (size_t)MR * DFF * 2;
constexpr size_t WS_MP = WS_Y + (size_t)MR * DM * 4;
constexpr size_t WS_OATT = WS_MP + (size_t)MR * MIXIN * 2;
constexpr size_t WS_OREC = WS_OATT + (size_t)2 * ML * 1024 * 4;
constexpr size_t WS_MG = WS_OREC + (size_t)2 * ML * 1024 * 4;
constexpr size_t WS_XB = WS_MG + (size_t)ML * DM * 2;
constexpr size_t WS_END = WS_XB + (size_t)ML * DM * 2;

typedef __bf16 bf16x2_t __attribute__((ext_vector_type(2)));
__device__ __forceinline__ unsigned cvtpk(float lo, float hi) { const f32x2 v = {lo, hi}; const bf16x2_t b = __builtin_convertvector(v, bf16x2_t); return __builtin_bit_cast(unsigned, b); }
__device__ __forceinline__ float bflo(unsigned w) { return __uint_as_float(w << 16); }
__device__ __forceinline__ float bfhi(unsigned w) { return __uint_as_float(w & 0xffff0000u); }
__device__ __forceinline__ float wave_sum(float v) {
#pragma unroll
    for (int o = 1; o < 64; o <<= 1) v += __shfl_xor(v, o);
    return v;
}
__device__ __forceinline__ int otid() { int t = threadIdx.x; asm volatile("" : "+v"(t)); return t; }
__device__ __forceinline__ int obid() { int t = blockIdx.x; asm volatile("" : "+s"(t)); return t; }
__device__ __forceinline__ float sigmoidf_(float x) { return __builtin_amdgcn_rcpf(1.f + __expf(-x)); }
__device__ __forceinline__ float siluf_(float x) { return x * sigmoidf_(x); }

namespace pg8 {
#define PG8_LAS __attribute__((address_space(3)))
typedef unsigned short bf16_t;
typedef short bf16x8 __attribute__((ext_vector_type(8)));
typedef float f32x4 __attribute__((ext_vector_type(4)));
typedef unsigned u32x4 __attribute__((ext_vector_type(4)));
constexpr int BM = 256, BK = 64, HALF = 128, HTB = HALF * BK * 2  , STAGE_BYTES = 8 * HTB, NXCD = 8, WGM = 8;

__host__ __device__ __forceinline__ int lds_byte(int r, int c) { const int st = (r >> 4) * 2 + (c >> 5), rr = r & 15, cc = c & 31, ob = rr * 64 + cc * 2; return st * 1024 + (ob ^ (((ob >> 9) & 1) << 5)); }
__host__ __device__ __forceinline__ void stage_rc(int b, int& R, int& C) { const int st = b / 1024, sb = b % 1024, swz = sb ^ (((sb >> 9) & 1) << 5); R = (st >> 1) * 16 + swz / 64; C = (st & 1) * 32 + (swz % 64) / 2; }
__host__ __device__ __forceinline__ int perm32(int rho) { const int n = rho >> 4, i = rho & 15; return 8 * (i >> 2) + 4 * n + (i & 3); }

struct Unit { int pm, pn; };
struct Gemm { const bf16_t* A; const bf16_t* Bt; int M, N, K; };

struct StaticOrder {
    int nM, nN, nwg, G, c;
    __host__ __device__ void init(int M, int N, int G_, int c_) { nM = M / BM; nN = N / BM; nwg = nM * nN; G = G_; c = c_; }
    __host__ __device__ bool next(int i, Unit& u) const {
        const long L = (long)i * G + c; if (L >= nwg) return false;
        int wgid = (int)L; { const int q = nwg / NXCD, r = nwg % NXCD, xcd = wgid % NXCD, off = wgid / NXCD; wgid = (xcd < r ? xcd * (q + 1) : r * (q + 1) + (xcd - r) * q) + off; }
        const int nig = WGM * nN, gid = wgid / nig, fm = gid * WGM, gsz = (nM - fm) < WGM ? (nM - fm) : WGM;
        u.pm = fm + ((wgid % nig) % gsz); u.pn = (wgid % nig) / gsz; return true;
    }
    __device__ __forceinline__ void a_ready(const Unit&) const {}
    __device__ __forceinline__ void done(const Unit&) const {}
};

__device__ __forceinline__ unsigned cvt_pk_bf16(float lo, float hi) { return ::cvtpk(lo, hi); }
typedef float f32x2 __attribute__((ext_vector_type(2)));

__device__ __forceinline__ void st8_bf16(bf16_t* p, const f32x4 v0, const f32x4 v1) {
    u32x4 w; w.x = cvt_pk_bf16(v0[0], v0[1]); w.y = cvt_pk_bf16(v0[2], v0[3]); w.z = cvt_pk_bf16(v1[0], v1[1]); w.w = cvt_pk_bf16(v1[2], v1[3]); *(u32x4*)p = w;
}
__device__ __forceinline__ float silu_e(float g) { return g * __builtin_amdgcn_rcpf(1.f + __expf(-g)); }
struct EpiPair {
    static constexpr bool PERM = true, AFTER_DRAIN = false;
    bf16_t* O1; int ld1; bf16_t* O0; int ld0; int nplain; int silu;
    __device__ __forceinline__ void operator()(const f32x4 (&acc)[2][2][4][2], const Unit& u, int wr, int wc, int fr, int fq) const {
        const int row0 = u.pm * BM + wr * 64 + fr;
        if (u.pn < nplain) {
            const int col0 = u.pn * BM + wc * 32 + 8 * fq;
#pragma unroll
            for (int ai = 0; ai < 2; ++ai)
#pragma unroll
                for (int m = 0; m < 4; ++m) { bf16_t* rowp = O0 + (size_t)(row0 + ai * HALF + m * 16) * ld0 + col0;
#pragma unroll
                    for (int bj = 0; bj < 2; ++bj) st8_bf16(rowp + bj * HALF, acc[ai][bj][m][0], acc[ai][bj][m][1]); }
        } else {
            const int col0 = (u.pn - nplain) * HALF + wc * 32 + 8 * fq;
#pragma unroll
            for (int ai = 0; ai < 2; ++ai)
#pragma unroll
                for (int m = 0; m < 4; ++m) { bf16_t* rowp = O1 + (size_t)(row0 + ai * HALF + m * 16) * ld1 + col0;
                    f32x4 g0 = acc[ai][0][m][0], g1 = acc[ai][0][m][1]; const f32x4 u0 = acc[ai][1][m][0], u1 = acc[ai][1][m][1];
                    if (silu) {
#pragma unroll
                        for (int e = 0; e < 4; ++e) { g0[e] = silu_e(g0[e]); g1[e] = silu_e(g1[e]); } }
                    st8_bf16(rowp, g0 * u0, g1 * u1); }
        }
    }
};
struct EpiB16 {
    static constexpr bool PERM = true, AFTER_DRAIN = false;
    bf16_t* O; int ld;
    __device__ __forceinline__ void operator()(const f32x4 (&acc)[2][2][4][2], const Unit& u, int wr, int wc, int fr, int fq) const {
        const int row0 = u.pm * BM + wr * 64 + fr, col0 = u.pn * BM + wc * 32 + 8 * fq;
#pragma unroll
        for (int ai = 0; ai < 2; ++ai)
#pragma unroll
            for (int m = 0; m < 4; ++m) { bf16_t* rowp = O + (size_t)(row0 + ai * HALF + m * 16) * ld + col0;
#pragma unroll
                for (int bj = 0; bj < 2; ++bj) st8_bf16(rowp + bj * HALF, acc[ai][bj][m][0], acc[ai][bj][m][1]); }
    }
};
struct EpiMix {
    static constexpr bool PERM = true, AFTER_DRAIN = false;
    bf16_t* O; int ld; const f32x2* rope;
    __device__ __forceinline__ void operator()(const f32x4 (&acc)[2][2][4][2], const Unit& u, int wr, int wc, int fr, int fq) const {
        const int row0 = u.pm * BM + wr * 64 + fr, col0 = u.pn * BM + wc * 32 + 8 * fq;
        const int pmod = u.pm % 9;
        if (u.pn >= 8 || pmod == 0) {
#pragma unroll
            for (int ai = 0; ai < 2; ++ai)
#pragma unroll
                for (int m = 0; m < 4; ++m) { bf16_t* rowp = O + (size_t)(row0 + ai * HALF + m * 16) * ld + col0;
#pragma unroll
                    for (int bj = 0; bj < 2; ++bj) st8_bf16(rowp + bj * HALF, acc[ai][bj][m][0], acc[ai][bj][m][1]); }
        } else {
            const int half = wc & 1, i0 = 8 * (fq & 1); const float sgn = fq < 2 ? -1.f : 1.f;
#pragma unroll
            for (int ai = 0; ai < 2; ++ai) {
                const int tb = (pmod - 1) * 256 + ai * HALF + wr * 64;
#pragma unroll
                for (int m = 0; m < 4; ++m) {
                    const int pos = half ? (m * 16 + fr) : (tb >> 6);
                    const f32x4* rp = (const f32x4*)(rope + pos * 16 + i0);
                    const f32x4 c01 = rp[0], c23 = rp[1], c45 = rp[2], c67 = rp[3];
                    const float cs[8] = {c01[0], c01[2], c23[0], c23[2], c45[0], c45[2], c67[0], c67[2]};
                    const float sn[8] = {c01[1], c01[3], c23[1], c23[3], c45[1], c45[3], c67[1], c67[3]};
                    bf16_t* rowp = O + (size_t)(row0 + ai * HALF + m * 16) * ld + col0;
#pragma unroll
                    for (int bj = 0; bj < 2; ++bj) {
                        f32x4 v0 = acc[ai][bj][m][0], v1 = acc[ai][bj][m][1], o0, o1;
#pragma unroll
                        for (int e = 0; e < 4; ++e) { const float p0 = __shfl_xor(v0[e], 32), p1 = __shfl_xor(v1[e], 32);
                            o0[e] = v0[e] * cs[e] + sgn * p0 * sn[e]; o1[e] = v1[e] * cs[4 + e] + sgn * p1 * sn[4 + e]; }
                        st8_bf16(rowp + bj * HALF, o0, o1);
                    }
                }
            }
        }
    }
};

template <class Epi, class Sched, bool ALIGN_EPI = false, bool SP2 = false>
__device__ __forceinline__ void gemm_phase(PG8_LAS unsigned char* lds, const Gemm g, const Sched& S, const Epi& E) {
    const int tid = otid(), wid = __builtin_amdgcn_readfirstlane(tid >> 6), lane = tid & 63, wr = wid >> 2, wc = wid & 3, fr = lane & 15, fq = lane >> 4;
    const int K = g.K, nt = K / BK;
    unsigned voffA[2], voffB[2];
#pragma unroll
    for (int i = 0; i < 2; ++i) { int R, C; stage_rc(tid * 16 + i * 8192, R, C); const int Rb = Epi::PERM ? ((R & ~31) + perm32(R & 31)) : R;
        voffA[i] = (unsigned)(R * K + C) * 2u; voffB[i] = (unsigned)(Rb * K + C) * 2u; }
    const size_t kstep = (size_t)(BK * 2);
    const size_t hstep = (size_t)HALF * K * 2;
    const size_t tstep = 2 * hstep;
    const unsigned ldsw = (unsigned)wid * 1024u;
    const int aoff = lds_byte(wr * 64 + fr, fq * 8), boff = lds_byte(wc * 32 + fr, fq * 8);
#define PG8_SA(b, h) (((b) * 2 + (h)) * HTB)
#define PG8_SB(b, h) ((4 + (b) * 2 + (h)) * HTB)
#define PG8_STAGE(bufoff, gbase, voff) do { _Pragma("unroll") for (int _i = 0; _i < 2; ++_i) \
        __builtin_amdgcn_global_load_lds((const unsigned*)((const char*)(gbase) + (voff)[_i]), (PG8_LAS unsigned*)(lds + (bufoff) + ldsw + _i * 8192), 16, 0, 0); } while (0)
#define PG8_LDA(dst, b, h) do { _Pragma("unroll") for (int m = 0; m < 4; ++m) _Pragma("unroll") for (int k = 0; k < 2; ++k) dst[m][k] = *(const PG8_LAS bf16x8*)(lds + PG8_SA(b, h) + aoff + m * 2048 + k * 1024); } while (0)
#define PG8_LDB(dst, b, h) do { _Pragma("unroll") for (int n = 0; n < 2; ++n) _Pragma("unroll") for (int k = 0; k < 2; ++k) dst[n][k] = *(const PG8_LAS bf16x8*)(lds + PG8_SB(b, h) + boff + n * 2048 + k * 1024); } while (0)
#define PG8_MMA(ai, bj, At, Bt) do { __builtin_amdgcn_s_setprio(1); _Pragma("unroll") for (int m = 0; m < 4; ++m) _Pragma("unroll") for (int n = 0; n < 2; ++n) _Pragma("unroll") for (int k = 0; k < 2; ++k) \
        acc[ai][bj][m][n] = __builtin_amdgcn_mfma_f32_16x16x32_bf16(Bt[n][k], At[m][k], acc[ai][bj][m][n], 0, 0, 0); __builtin_amdgcn_s_setprio(0); } while (0)
#define PG8_WAIT_V(n) asm volatile("s_waitcnt vmcnt(" #n ")" ::: "memory")
#define PG8_WAIT_L(n) asm volatile("s_waitcnt lgkmcnt(" #n ")" ::: "memory")
#define PG8_BAR __builtin_amdgcn_s_barrier()
#define PG8_SCHED __builtin_amdgcn_sched_barrier(0)
    Unit cur, nxt; int ui = 0;
    if (!S.next(0, cur)) return;
    f32x4 acc[2][2][4][2];
#pragma unroll
    for (int a = 0; a < 2; ++a)
#pragma unroll
        for (int b = 0; b < 2; ++b)
#pragma unroll
            for (int m = 0; m < 4; ++m)
#pragma unroll
                for (int n = 0; n < 2; ++n) acc[a][b][m][n] = (f32x4){0.f, 0.f, 0.f, 0.f};
    bf16x8 At[4][2], B0[2][2], B1[2][2];
    const char* cA = (const char*)g.A + (size_t)cur.pm * tstep; const char* cB = (const char*)g.Bt + (size_t)cur.pn * tstep;
    S.a_ready(cur);
    if constexpr (SP2) {
        PG8_STAGE(PG8_SB(0, 0), cB, voffB); PG8_STAGE(PG8_SB(0, 1), cB + hstep, voffB); PG8_STAGE(PG8_SA(0, 0), cA, voffA); PG8_STAGE(PG8_SA(0, 1), cA + hstep, voffA);
        if (wr == 1) PG8_BAR;
        PG8_WAIT_V(2); PG8_BAR;
        PG8_STAGE(PG8_SB(1, 0), cB + kstep, voffB); PG8_STAGE(PG8_SA(1, 0), cA + kstep, voffA); PG8_STAGE(PG8_SB(1, 1), cB + hstep + kstep, voffB);
        PG8_WAIT_V(6); PG8_BAR;
    } else {
        PG8_STAGE(PG8_SB(0, 0), cB, voffB); PG8_STAGE(PG8_SA(0, 0), cA, voffA); PG8_STAGE(PG8_SB(0, 1), cB + hstep, voffB); PG8_STAGE(PG8_SA(0, 1), cA + hstep, voffA);
        if (wr == 1) PG8_BAR;
        PG8_WAIT_V(4); PG8_BAR;
        PG8_STAGE(PG8_SB(1, 0), cB + kstep, voffB); PG8_STAGE(PG8_SA(1, 0), cA + kstep, voffA); PG8_STAGE(PG8_SB(1, 1), cB + hstep + kstep, voffB);
        PG8_WAIT_V(6); PG8_BAR;
    }
    for (;;) {
        const bool has_next = S.next(ui + 1, nxt);
        const char* nA = has_next ? (const char*)g.A + (size_t)nxt.pm * tstep : cA; const char* nB = has_next ? (const char*)g.Bt + (size_t)nxt.pn * tstep : cB;
        for (int t = 0; t < nt; t += 2) {
            const bool last = (t == nt - 2);
            const char* a1 = cA + (size_t)(t + 1) * kstep;
            const char* a2 = last ? nA : cA + (size_t)(t + 2) * kstep; const char* b2 = last ? nB : cB + (size_t)(t + 2) * kstep;
            const char* a3 = a2 + kstep; const char* b3 = b2 + kstep;
            if (last && has_next) S.a_ready(nxt);
            if constexpr (SP2) {
            PG8_LDB(B0, 0, 0); PG8_LDB(B1, 0, 1); PG8_SCHED; PG8_LDA(At, 0, 0); PG8_STAGE(PG8_SA(1, 1), a1 + hstep, voffA);
            PG8_WAIT_V(8); PG8_WAIT_L(0); PG8_BAR; PG8_MMA(0, 0, At, B0); PG8_MMA(0, 1, At, B1); PG8_BAR; PG8_SCHED;
            PG8_LDA(At, 0, 1); PG8_STAGE(PG8_SB(0, 0), b2, voffB); PG8_STAGE(PG8_SB(0, 1), b2 + hstep, voffB); PG8_STAGE(PG8_SA(0, 0), a2, voffA);
            PG8_WAIT_V(8); PG8_WAIT_L(0); PG8_BAR; PG8_MMA(1, 0, At, B0); PG8_MMA(1, 1, At, B1); PG8_BAR; PG8_SCHED;
            PG8_LDB(B0, 1, 0); PG8_LDB(B1, 1, 1); PG8_SCHED; PG8_LDA(At, 1, 0); PG8_STAGE(PG8_SA(0, 1), a2 + hstep, voffA);
            PG8_WAIT_V(8); PG8_WAIT_L(0); PG8_BAR; PG8_MMA(0, 0, At, B0); PG8_MMA(0, 1, At, B1); PG8_BAR; PG8_SCHED;
            PG8_LDA(At, 1, 1); PG8_STAGE(PG8_SB(1, 0), b3, voffB); PG8_STAGE(PG8_SB(1, 1), b3 + hstep, voffB); PG8_STAGE(PG8_SA(1, 0), a3, voffA);
            PG8_WAIT_V(8); PG8_WAIT_L(0); PG8_BAR; PG8_MMA(1, 0, At, B0); PG8_MMA(1, 1, At, B1); PG8_BAR; PG8_SCHED;
            } else {
            PG8_LDB(B0, 0, 0); PG8_SCHED; PG8_LDA(At, 0, 0); PG8_STAGE(PG8_SA(1, 1), a1 + hstep, voffA);
            PG8_WAIT_L(8); PG8_BAR; PG8_WAIT_L(0); PG8_MMA(0, 0, At, B0); PG8_BAR; PG8_SCHED;
            PG8_LDB(B1, 0, 1); PG8_STAGE(PG8_SB(0, 0), b2, voffB);
            PG8_BAR; PG8_WAIT_L(0); PG8_MMA(0, 1, At, B1); PG8_BAR;
            PG8_LDA(At, 0, 1); PG8_STAGE(PG8_SA(0, 0), a2, voffA);
            PG8_BAR; PG8_WAIT_L(0); PG8_MMA(1, 0, At, B0); PG8_BAR; PG8_SCHED;
            PG8_STAGE(PG8_SB(0, 1), b2 + hstep, voffB);
            PG8_WAIT_V(6); PG8_BAR; PG8_MMA(1, 1, At, B1); PG8_BAR;
            PG8_LDB(B0, 1, 0); PG8_SCHED; PG8_LDA(At, 1, 0); PG8_STAGE(PG8_SA(0, 1), a2 + hstep, voffA);
            PG8_WAIT_L(8); PG8_BAR; PG8_WAIT_L(0); PG8_MMA(0, 0, At, B0); PG8_BAR; PG8_SCHED;
            PG8_LDB(B1, 1, 1); PG8_STAGE(PG8_SB(1, 0), b3, voffB);
            PG8_BAR; PG8_WAIT_L(0); PG8_MMA(0, 1, At, B1); PG8_BAR;
            PG8_LDA(At, 1, 1); PG8_STAGE(PG8_SA(1, 0), a3, voffA);
            PG8_BAR; PG8_WAIT_L(0); PG8_MMA(1, 0, At, B0); PG8_BAR; PG8_SCHED;
            PG8_STAGE(PG8_SB(1, 1), b3 + hstep, voffB);
            PG8_WAIT_V(6); PG8_BAR; PG8_MMA(1, 1, At, B1); PG8_BAR;
            }
        }
        if constexpr (ALIGN_EPI) { if (wr == 0) PG8_BAR; }
        if constexpr (!Epi::AFTER_DRAIN) { E(acc, cur, wr, wc, fr, fq); S.done(cur); }
        if (!has_next) break;
#pragma unroll
        for (int a = 0; a < 2; ++a)
#pragma unroll
            for (int b = 0; b < 2; ++b)
#pragma unroll
                for (int m = 0; m < 4; ++m)
#pragma unroll
                    for (int n = 0; n < 2; ++n) acc[a][b][m][n] = (f32x4){0.f, 0.f, 0.f, 0.f};
        cur = nxt; cA = nA; cB = nB; ++ui;
        if constexpr (ALIGN_EPI) { if (wr == 1) PG8_BAR; }
    }
    PG8_WAIT_V(0);
    if constexpr (!ALIGN_EPI) { if (wr == 0) PG8_BAR; }
    PG8_BAR;
    if constexpr (Epi::AFTER_DRAIN) { E.fused(acc, cur, wr, wc, fr, fq, lds, wid, lane); S.done(cur); }
#undef PG8_SA
#undef PG8_SB
#undef PG8_STAGE
#undef PG8_LDA
#undef PG8_LDB
#undef PG8_MMA
#undef PG8_WAIT_V
#undef PG8_WAIT_L
#undef PG8_BAR
#undef PG8_SCHED
}
}

namespace att {
constexpr int NW = 8, QBLK = 32, KVBLK = 64, DV = 128, DQ = 64;
constexpr float SCALE = 0.125f, THR = 8.f;
constexpr int LDQ = MIXIN, LDK = MIXIN, LDO = 1024;
constexpr int SHM_V = KVBLK * DV * 2, SHM_K = KVBLK * DQ * 2, SHM_ATTN = 2 * SHM_V + 2 * SHM_K + NW * 64 * 4;
#define KSWZ(row, colB) ((row) * 128 + ((colB) ^ (((row) & 7) << 4)))
#define SBAR() __builtin_amdgcn_sched_barrier(0)
__device__ __forceinline__ int crow(int r, int hi) { return (r & 3) + 8 * (r >> 2) + 4 * hi; }
__device__ __forceinline__ unsigned cvtpkv(float lo, float hi) { unsigned r; asm volatile("v_cvt_pk_bf16_f32 %0, %1, %2" : "=v"(r) : "v"(lo), "v"(hi)); return r; }
__device__ __forceinline__ void partialSM(f32x16& p0, f32x16& p1, float& m_reg, float& mn, float& alpha) {
  constexpr float C = SCALE * 1.4426950408889634f;
  float pmax = p0[0]; for (int r = 1; r < 16; ++r) pmax = fmaxf(pmax, p0[r]); for (int r = 0; r < 16; ++r) pmax = fmaxf(pmax, p1[r]);
  { auto rr = __builtin_amdgcn_permlane32_swap(__float_as_uint(pmax), __float_as_uint(pmax), false, false);
    pmax = fmaxf(__uint_as_float(rr[0]), __uint_as_float(rr[1])); }
  if (__builtin_expect(__all(pmax - m_reg <= THR / SCALE), 1)) { mn = m_reg; alpha = 1.f; }
  else { mn = fmaxf(m_reg, pmax); alpha = __builtin_amdgcn_exp2f((m_reg - mn) * C); m_reg = mn; }
  float mnC = -mn * C;
  for (int r = 0; r < 16; ++r) p0[r] = fmaf(p0[r], C, mnC); for (int r = 0; r < 16; ++r) p1[r] = fmaf(p1[r], C, mnC);
  for (int r = 0; r < 16; ++r) p0[r] = __builtin_amdgcn_exp2f(p0[r]);
}
__device__ __forceinline__ void finishSM(f32x16& p0, f32x16& p1, float alpha, float& l_reg, bf16x8& pa0, bf16x8& pa1, bf16x8& pa2, bf16x8& pa3) {
  for (int r = 0; r < 16; ++r) p1[r] = __builtin_amdgcn_exp2f(p1[r]);
  float ps = 0; for (int r = 0; r < 16; ++r) ps += p0[r]; for (int r = 0; r < 16; ++r) ps += p1[r];
  { auto rr = __builtin_amdgcn_permlane32_swap(__float_as_uint(ps), __float_as_uint(ps), false, false);
    ps = __uint_as_float(rr[0]) + __uint_as_float(rr[1]); }
  l_reg = l_reg * alpha + ps;
#define PK4(P, BASE, OUT) do { unsigned a0 = cvtpkv(P[BASE + 0], P[BASE + 1]), a1 = cvtpkv(P[BASE + 2], P[BASE + 3]);   \
    unsigned b0 = cvtpkv(P[BASE + 4], P[BASE + 5]), b1 = cvtpkv(P[BASE + 6], P[BASE + 7]);                              \
    auto r0 = __builtin_amdgcn_permlane32_swap(a0, b0, false, false); auto r1 = __builtin_amdgcn_permlane32_swap(a1, b1, false, false); \
    u32x4 w = {r0[0], r1[0], r0[1], r1[1]}; OUT = *reinterpret_cast<bf16x8*>(&w); } while (0)
  PK4(p0, 0, pa0); PK4(p0, 8, pa1); PK4(p1, 0, pa2); PK4(p1, 8, pa3);
#undef PK4
}
__device__ __forceinline__ void qkt(f32x16& p0, f32x16& p1, const bf16_t* Ks, const bf16x8* qr, int r32, int hi) {
  p0 = f32x16{}; p1 = f32x16{};
#pragma unroll
  for (int d0 = 0; d0 < 4; ++d0) { int cb = (d0 * 16 + hi * 8) * 2;
    bf16x8 b0 = *reinterpret_cast<const bf16x8*>((const char*)Ks + KSWZ(r32, cb));
    bf16x8 b1 = *reinterpret_cast<const bf16x8*>((const char*)Ks + KSWZ(32 + r32, cb));
    p0 = __builtin_amdgcn_mfma_f32_32x32x16_bf16(b0, qr[d0], p0, 0, 0, 0);
    p1 = __builtin_amdgcn_mfma_f32_32x32x16_bf16(b1, qr[d0], p1, 0, 0, 0); }
}
__device__ __forceinline__ int v_st(int k, int c) { const int kk = (k & ~0xC) | ((k & 4) << 1) | ((k & 8) >> 1); return ((kk >> 3) * 4 + (c >> 5)) * 512 + ((kk & 7) * 32 + (c & 31)) * 2; }
__device__ __forceinline__ int v_rd_base(int lane) { return ((lane & 3) << 3) | (((lane >> 2) & 3) << 6) | (((lane >> 4) & 1) << 5) | (((lane >> 5) & 1) << 8); }
constexpr int v_rd_off(int d0, int ks, int half) { return d0 * 512 + ks * 4096 + half * 2048; }
template <int OFF> __device__ __forceinline__ s16x4 tr_read(int vb) {
  s16x4 r; asm volatile("ds_read_b64_tr_b16 %0, %1 offset:%2" : "=&v"(r) : "v"(vb), "i"(OFF) : "memory"); return r;
}
template <int D0> __device__ __forceinline__ void pv_one(f32x16& od, int vb, bf16x8 pa0, bf16x8 pa1, bf16x8 pa2, bf16x8 pa3) {
  const s16x4 l0 = tr_read<v_rd_off(D0, 0, 0)>(vb), h0 = tr_read<v_rd_off(D0, 0, 1)>(vb), l1 = tr_read<v_rd_off(D0, 1, 0)>(vb), h1 = tr_read<v_rd_off(D0, 1, 1)>(vb);
  const s16x4 l2 = tr_read<v_rd_off(D0, 2, 0)>(vb), h2 = tr_read<v_rd_off(D0, 2, 1)>(vb), l3 = tr_read<v_rd_off(D0, 3, 0)>(vb), h3 = tr_read<v_rd_off(D0, 3, 1)>(vb);
  asm volatile("s_waitcnt lgkmcnt(0)" ::: "memory"); SBAR();
#define PK(L, H) (bf16x8){L[0], L[1], L[2], L[3], H[0], H[1], H[2], H[3]}
  od = __builtin_amdgcn_mfma_f32_32x32x16_bf16(pa0, PK(l0, h0), od, 0, 0, 0);
  od = __builtin_amdgcn_mfma_f32_32x32x16_bf16(pa1, PK(l1, h1), od, 0, 0, 0);
  od = __builtin_amdgcn_mfma_f32_32x32x16_bf16(pa2, PK(l2, h2), od, 0, 0, 0);
  od = __builtin_amdgcn_mfma_f32_32x32x16_bf16(pa3, PK(l3, h3), od, 0, 0, 0);
#undef PK
}
__device__ __forceinline__ void pv_d0(f32x16* o, int vb, bf16x8 pa0, bf16x8 pa1, bf16x8 pa2, bf16x8 pa3) {
  pv_one<0>(o[0], vb, pa0, pa1, pa2, pa3); pv_one<1>(o[1], vb, pa0, pa1, pa2, pa3); pv_one<2>(o[2], vb, pa0, pa1, pa2, pa3); pv_one<3>(o[3], vb, pa0, pa1, pa2, pa3);
}
__device__ __forceinline__ void attn_body(const bf16_t* __restrict__ Qb, const bf16_t* __restrict__ Kh, const bf16_t* __restrict__ Vh, bf16_t* __restrict__ Ob, int seq, char* lds) {
  const int tid = otid(), wid = tid >> 6, lane = tid & 63, r32 = lane & 31, hi = lane >> 5;
  bf16_t* V_lds = (bf16_t*)lds; bf16_t* K_lds = (bf16_t*)(lds + 2 * SHM_V);
  float* ws = (float*)(lds + 2 * SHM_V + 2 * SHM_K) + wid * 64; float* li_l = ws; float* al_l = ws + 32;
  float m_reg = -1e30f, l_reg = 0; f32x16 o[4] = {}; bf16x8 qr[4];
  const bf16_t* Qw = Qb + (long)(wid * QBLK + r32) * LDQ + hi * 8;
#pragma unroll
  for (int d0 = 0; d0 < 4; ++d0) qr[d0] = *reinterpret_cast<const bf16x8*>(Qw + d0 * 16);
  const int sr = tid >> 4, sc = (tid & 15) * 8, vst0 = v_st(sr, sc), vst1 = v_st(32 + sr, sc);
  const int kr = tid >> 3, kc = (tid & 7) * 8, kst = KSWZ(kr, kc * 2);
  const int vb0 = (int)(uintptr_t)V_lds + v_rd_base(lane);
  struct { bf16x8 vs0, vs1, ks0; } sr_[2];
#define SLOAD(i, k0) do { sr_[i].vs0 = *reinterpret_cast<const bf16x8*>(&Vh[(long)((k0) + sr) * LDK + sc]); sr_[i].vs1 = *reinterpret_cast<const bf16x8*>(&Vh[(long)((k0) + 32 + sr) * LDK + sc]); \
    sr_[i].ks0 = *reinterpret_cast<const bf16x8*>(&Kh[(long)((k0) + kr) * LDK + kc]); } while (0)
#define SWRITE(b, i) do { *(bf16x8*)((char*)V_lds + (b) * SHM_V + vst0) = sr_[i].vs0;          \
    *(bf16x8*)((char*)V_lds + (b) * SHM_V + vst1) = sr_[i].vs1;                                  \
    *(bf16x8*)((char*)K_lds + (b) * SHM_K + kst) = sr_[i].ks0; } while (0)
#define SWAIT() asm volatile("s_waitcnt vmcnt(3)" ::: "memory")
#define RESC(a) do { if (__any((a) < 1.f)) { if (hi == 0) al_l[r32] = (a); asm volatile("s_waitcnt lgkmcnt(0)" ::: "memory"); \
    for (int d = 0; d < 4; ++d) for (int r = 0; r < 16; ++r) o[d][r] *= al_l[crow(r, hi)]; } } while (0)
  f32x16 pA0, pA1, pB0, pB1; float mnA, mnB, alA, alB; bf16x8 pa0, pa1, pa2, pa3; const int NT = seq / KVBLK;
  constexpr int SE = 0, SO = 1;
  SLOAD(SE, 0); asm volatile("s_waitcnt vmcnt(0)" ::: "memory"); SWRITE(0, SE); __syncthreads();
  qkt(pA0, pA1, K_lds, qr, r32, hi); partialSM(pA0, pA1, m_reg, mnA, alA);
  SLOAD(SO, KVBLK); if (2 < NT) SLOAD(SE, 2 * KVBLK);
  SWAIT(); SWRITE(1, SO); __syncthreads();
  for (int j = 1; j + 1 < NT; j += 2) {
    SBAR(); qkt(pB0, pB1, (bf16_t*)((char*)K_lds + SHM_K), qr, r32, hi);
    finishSM(pA0, pA1, alA, l_reg, pa0, pa1, pa2, pa3); SBAR();
    SLOAD(SO, (j + 2) * KVBLK); SBAR();
    pv_d0(o, vb0, pa0, pa1, pa2, pa3); partialSM(pB0, pB1, m_reg, mnB, alB);
    __syncthreads(); SWAIT(); SWRITE(0, SE);
    RESC(alB); __syncthreads();
    SBAR(); qkt(pA0, pA1, K_lds, qr, r32, hi);
    finishSM(pB0, pB1, alB, l_reg, pa0, pa1, pa2, pa3); SBAR();
    if (j + 3 < NT) SLOAD(SE, (j + 3) * KVBLK); SBAR();
    pv_d0(o, vb0 + (int)SHM_V, pa0, pa1, pa2, pa3); partialSM(pA0, pA1, m_reg, mnA, alA);
    __syncthreads(); SWAIT(); SWRITE(1, SO);
    RESC(alA); __syncthreads();
  }
  SBAR(); qkt(pB0, pB1, (bf16_t*)((char*)K_lds + SHM_K), qr, r32, hi);
  finishSM(pA0, pA1, alA, l_reg, pa0, pa1, pa2, pa3); SBAR();
  pv_d0(o, vb0, pa0, pa1, pa2, pa3); partialSM(pB0, pB1, m_reg, mnB, alB);
  __syncthreads(); RESC(alB);
  finishSM(pB0, pB1, alB, l_reg, pa0, pa1, pa2, pa3); SBAR();
  pv_d0(o, vb0 + (int)SHM_V, pa0, pa1, pa2, pa3);
  if (hi == 0) li_l[r32] = l_reg; asm volatile("s_waitcnt lgkmcnt(0)" ::: "memory");
  float rli[16];
#pragma unroll
  for (int r = 0; r < 16; ++r) rli[r] = __builtin_amdgcn_rcpf(li_l[crow(r, hi)]);
  bf16_t* Ow = Ob + (long)(wid * QBLK) * LDO;
#pragma unroll
  for (int r = 0; r < 16; ++r) { int orow = crow(r, hi);
    for (int d0 = 0; d0 < 4; ++d0) Ow[(long)orow * LDO + d0 * 32 + r32] = (bf16_t)(::cvtpk(o[d0][r] * rli[r], 0.f) & 0xffffu); }
#undef SLOAD
#undef SWRITE
#undef SWAIT
#undef RESC
}
}

__device__ __forceinline__ int hcrow(int r, int hi) { return (r & 3) + 8 * (r >> 2) + 4 * hi; }
__device__ __forceinline__ void hgrn_unit(const Args& a, LAS unsigned char* lds, int unit) {
    const int tid = otid(), w = __builtin_amdgcn_readfirstlane(tid >> 6), lane = tid & 63, r32 = lane & 31, hi = lane >> 5;
    const int dir = unit & 1, h = (unit >> 1) & 7, b = unit >> 4;
    constexpr int PQ = 136, PS = 72;
    LAS bf16_t* Qt = (LAS bf16_t*)lds;
    LAS bf16_t* Kt = Qt + 64 * PQ;
    LAS bf16_t* KhT = Kt + 64 * PQ;
    LAS bf16_t* Vt = KhT + 128 * PS;
    LAS bf16_t* At = Vt + 128 * PS;
    LAS bf16_t* St = At + 64 * PS;
    LAS float* part = (LAS float*)(St + 128 * PQ);
    LAS float* dec = part + 8 * 128;
    const bf16_t* MP = (const bf16_t*)(a.ws + WS_MP);
    bf16_t* OREC = (bf16_t*)(a.ws + WS_OREC) + (size_t)dir * ML * 1024;
    const int kp = lane;
    float lb[2];
#pragma unroll
    for (int j = 0; j < 2; ++j) { const float a0 = a.in[I_RLB][(dir * 2 + 0) * 1024 + h * 128 + 2 * kp + j], a1 = a.in[I_RLB][(dir * 2 + 1) * 1024 + h * 128 + 2 * kp + j];
        lb[j] = 1.f / (1.f + __expf(a1 - a0)); }
    __syncthreads();
    for (int i = tid; i < 128 * PQ / 2; i += 512) ((LAS unsigned*)St)[i] = 0u;
    f32x16 S[2] = {};
    unsigned q2[8], z2[8], v2[8];
    const int zcol = (dir ? 5120 : 4096) + h * 128 + 2 * kp, qcol = 3072 + h * 128 + 2 * kp, vcol = 6144 + h * 128 + 2 * kp;
#define HG_ROWBASE(c) (b * RS + (dir ? ((c) < 4 ? 192 - 64 * (c) : RS - 64 * ((c) - 3)) : 64 * (c)))
#define HG_LOAD(c) do { const int rb_ = HG_ROWBASE(c); _Pragma("unroll") for (int e = 0; e < 8; ++e) { const int tau = 8 * w + e, rr = dir ? 63 - tau : tau; \
        const bf16_t* rp = MP + (size_t)(rb_ + rr) * MIXIN; q2[e] = *(const unsigned*)(rp + qcol); z2[e] = *(const unsigned*)(rp + zcol); v2[e] = *(const unsigned*)(rp + vcol); } } while (0)
    HG_LOAD(0);
    const int ti = w >> 2, vi = w & 3, ki = w >> 1, vi0 = 2 * (w & 1);
    for (int c = 0; c < 36; ++c) {
        const int rowbase = HG_ROWBASE(c);
        float Pl[8][2], fk[8][2]; float p0 = 1.f, p1 = 1.f;
#pragma unroll
        for (int e = 0; e < 8; ++e) {
            const float f0 = lb[0] + (1.f - lb[0]) * sigmoidf_(bflo(z2[e])), f1 = lb[1] + (1.f - lb[1]) * sigmoidf_(bfhi(z2[e]));
            p0 *= f0; p1 *= f1; Pl[e][0] = p0; Pl[e][1] = p1; fk[e][0] = 1.f - f0; fk[e][1] = 1.f - f1;
        }
        *(LAS f32x2*)(part + w * 128 + 2 * kp) = (f32x2){p0, p1};
        __syncthreads();
        float off0 = 1.f, off1 = 1.f, tot0 = 1.f, tot1 = 1.f;
#pragma unroll
        for (int x = 0; x < 8; ++x) { const f32x2 pp = *(LAS f32x2*)(part + x * 128 + 2 * kp); tot0 *= pp[0]; tot1 *= pp[1]; if (x < w) { off0 *= pp[0]; off1 *= pp[1]; } }
        unsigned kh0[4], kh1[4], vt0[4], vt1[4];
        float kha[8][2];
#pragma unroll
        for (int e = 0; e < 8; ++e) {
            const int tau = 8 * w + e;
            const float P0 = fmaxf(off0 * Pl[e][0], 1e-35f), P1 = fmaxf(off1 * Pl[e][1], 1e-35f);
            const float i0 = __builtin_amdgcn_rcpf(P0), i1 = __builtin_amdgcn_rcpf(P1);
            const float qs0 = bflo(q2[e]) * 0.08838834764831845f * P0, qs1 = bfhi(q2[e]) * 0.08838834764831845f * P1;
            const float kt0 = fk[e][0] * i0, kt1 = fk[e][1] * i1;
            kha[e][0] = kt0 * tot0; kha[e][1] = kt1 * tot1;
            *(LAS unsigned*)(Qt + tau * PQ + 2 * kp) = cvtpk(qs0, qs1);
            *(LAS unsigned*)(Kt + tau * PQ + 2 * kp) = cvtpk(kt0, kt1);
        }
#pragma unroll
        for (int e = 0; e < 4; ++e) { kh0[e] = cvtpk(kha[2 * e][0], kha[2 * e + 1][0]); kh1[e] = cvtpk(kha[2 * e][1], kha[2 * e + 1][1]);
            vt0[e] = (v2[2 * e] & 0xffffu) | (v2[2 * e + 1] << 16); vt1[e] = (v2[2 * e] >> 16) | (v2[2 * e + 1] & 0xffff0000u); }
        *(LAS u32x4*)(KhT + (2 * kp) * PS + 8 * w) = (u32x4){kh0[0], kh0[1], kh0[2], kh0[3]};
        *(LAS u32x4*)(KhT + (2 * kp + 1) * PS + 8 * w) = (u32x4){kh1[0], kh1[1], kh1[2], kh1[3]};
        *(LAS u32x4*)(Vt + (2 * kp) * PS + 8 * w) = (u32x4){vt0[0], vt0[1], vt0[2], vt0[3]};
        *(LAS u32x4*)(Vt + (2 * kp + 1) * PS + 8 * w) = (u32x4){vt1[0], vt1[1], vt1[2], vt1[3]};
        if (w == 0) *(LAS f32x2*)(dec + 2 * kp) = (f32x2){tot0, tot1};
        if (c + 1 < 36) HG_LOAD(c + 1);
        __syncthreads();
        const bool outc = c >= 4;
        f32x16 o = {};
        if (outc) {
#pragma unroll
            for (int j = 0; j < 8; ++j) { const bf16x8 A = *(const LAS bf16x8*)(Qt + (32 * ti + r32) * PQ + 16 * j + 8 * hi), B = *(const LAS bf16x8*)(St + (32 * vi + r32) * PQ + 16 * j + 8 * hi);
                o = __builtin_amdgcn_mfma_f32_32x32x16_bf16(A, B, o, 0, 0, 0); }
            if (w < 4) {
                const int ta = w >> 1, sa = w & 1;
                f32x16 acc = {};
                if (sa <= ta) {
#pragma unroll
                    for (int j = 0; j < 8; ++j) { const bf16x8 A = *(const LAS bf16x8*)(Qt + (32 * ta + r32) * PQ + 16 * j + 8 * hi), B = *(const LAS bf16x8*)(Kt + (32 * sa + r32) * PQ + 16 * j + 8 * hi);
                        acc = __builtin_amdgcn_mfma_f32_32x32x16_bf16(A, B, acc, 0, 0, 0); }
                }
#pragma unroll
                for (int i = 0; i < 16; ++i) { const int t = 32 * ta + hcrow(i, hi), s = 32 * sa + r32; const float v = (s <= t) ? acc[i] : 0.f;
                    At[t * PS + s] = (bf16_t)(cvtpk(v, 0.f) & 0xffffu); }
            }
        }
#pragma unroll
        for (int x = 0; x < 2; ++x) {
#pragma unroll
            for (int i = 0; i < 16; ++i) S[x][i] *= dec[32 * ki + hcrow(i, hi)];
#pragma unroll
            for (int j = 0; j < 4; ++j) { const bf16x8 A = *(const LAS bf16x8*)(KhT + (32 * ki + r32) * PS + 16 * j + 8 * hi), B = *(const LAS bf16x8*)(Vt + (32 * (vi0 + x) + r32) * PS + 16 * j + 8 * hi);
                S[x] = __builtin_amdgcn_mfma_f32_32x32x16_bf16(A, B, S[x], 0, 0, 0); }
        }
        __syncthreads();
        if (outc) {
#pragma unroll
            for (int j = 0; j < 4; ++j) { const bf16x8 A = *(const LAS bf16x8*)(At + (32 * ti + r32) * PS + 16 * j + 8 * hi), B = *(const LAS bf16x8*)(Vt + (32 * vi + r32) * PS + 16 * j + 8 * hi);
                o = __builtin_amdgcn_mfma_f32_32x32x16_bf16(A, B, o, 0, 0, 0); }
#pragma unroll
            for (int i = 0; i < 16; ++i) { const int tau = 32 * ti + hcrow(i, hi), rr = dir ? 63 - tau : tau; const int lrow = rowbase + rr - 256 * (b + 1);
                OREC[(size_t)lrow * 1024 + h * 128 + 32 * vi + r32] = (bf16_t)(cvtpk(o[i], 0.f) & 0xffffu); }
        }
#pragma unroll
        for (int x = 0; x < 2; ++x)
#pragma unroll
            for (int g = 0; g < 4; ++g) { const int k0 = 32 * ki + 8 * g + 4 * hi;
                *(LAS u32x2*)(St + (32 * (vi0 + x) + r32) * PQ + k0) = (u32x2){cvtpk(S[x][4 * g], S[x][4 * g + 1]), cvtpk(S[x][4 * g + 2], S[x][4 * g + 3])}; }
    }
    __syncthreads();
#undef HG_LOAD
#undef HG_ROWBASE
}

__device__ __forceinline__ void transpose_item(const float* __restrict__ src, int ldn, int k0, int n0, bf16_t* __restrict__ dst, int Kd, int drow, LAS float* scr, int lane) {
    const int cl = (lane & 15) * 4, ks = lane >> 4;
    f32x4 v[16];
#pragma unroll
    for (int i = 0; i < 16; ++i) v[i] = __builtin_nontemporal_load((const f32x4*)(src + (size_t)(k0 + 4 * i + ks) * ldn + n0 + cl));
#pragma unroll
    for (int i = 0; i < 16; ++i) { LAS float* s = scr + (4 * i + ks) * 65 + cl; s[0] = v[i][0]; s[1] = v[i][1]; s[2] = v[i][2]; s[3] = v[i][3]; }
    asm volatile("s_waitcnt lgkmcnt(0)" ::: "memory");
    const int c = lane & 7;
#pragma unroll
    for (int j = 0; j < 8; ++j) { const int n = (lane >> 3) + 8 * j; const LAS float* s = scr + (8 * c) * 65 + n;
        u32x4 o; o.x = cvtpk(s[0 * 65], s[1 * 65]); o.y = cvtpk(s[2 * 65], s[3 * 65]); o.z = cvtpk(s[4 * 65], s[5 * 65]); o.w = cvtpk(s[6 * 65], s[7 * 65]);
        __builtin_nontemporal_store(o, (u32x4*)(dst + (size_t)(drow + n) * Kd + k0 + 8 * c)); }
    asm volatile("s_waitcnt lgkmcnt(0)" ::: "memory");
}
constexpr int T_FFN = 12 * 2752, T_MI = 4096, T_SQ = 1024, T_CI = 3072, T_ALL = T_FFN + T_MI + 2 * T_SQ + T_CI;
__device__ __forceinline__ void convert_item(const Args& a, int it, LAS float* scr, int lane) {
    bf16_t* WGU = (bf16_t*)(a.ws + WS_WGU); bf16_t* WD = (bf16_t*)(a.ws + WS_WD);
        const float* src; int ldn, k0, n0, Kd, drow; bf16_t* dst;
        if (it < T_FFN) { const int m = it / 2752, r = it % 2752, f = m / 3, kind = m % 3;
            if (kind < 2) { k0 = (r / 86) * 64; n0 = (r % 86) * 64; src = a.in[kind ? I_WU : I_WG] + (size_t)f * DM * DFF; ldn = DFF; Kd = DM; dst = WGU + (size_t)f * 2 * DFF * DM; drow = (n0 >> 7) * 256 + kind * 128 + (n0 & 127); }
            else { k0 = (r / 32) * 64; n0 = (r % 32) * 64; src = a.in[I_WDN] + (size_t)f * DFF * DM; ldn = DM; Kd = DFF; dst = WD + (size_t)f * DM * DFF; drow = n0; }
        } else if (it < T_FFN + T_MI) { const int r = it - T_FFN; k0 = (r / 128) * 64; n0 = (r % 128) * 64; src = a.in[I_MIXIN]; ldn = MIXIN; Kd = DM; dst = (bf16_t*)(a.ws + WS_WMI); drow = n0; }
        else if (it < T_FFN + T_MI + T_SQ) { const int r = it - T_FFN - T_MI; k0 = (r / 32) * 64; n0 = (r % 32) * 64; src = a.in[I_MIXOUT]; ldn = DM; Kd = DM; dst = (bf16_t*)(a.ws + WS_WMO); drow = n0; }
        else if (it < T_FFN + T_MI + 2 * T_SQ) { const int r = it - T_FFN - T_MI - T_SQ; k0 = (r / 32) * 64; n0 = (r % 32) * 64; src = a.in[I_CWOUT]; ldn = DM; Kd = DM; dst = (bf16_t*)(a.ws + WS_WCO); drow = n0; }
        else { const int r = it - T_FFN - T_MI - 2 * T_SQ; k0 = (r / 96) * 64; n0 = (r % 96) * 64; src = a.in[I_CWIN]; ldn = 3 * DM; Kd = DM; dst = (bf16_t*)(a.ws + WS_WCI);
            if (n0 < DM) drow = n0; else if (n0 < 2 * DM) { const int j = n0 - DM; drow = DM + (j >> 7) * 256 + (j & 127); } else { const int j = n0 - 2 * DM; drow = DM + (j >> 7) * 256 + 128 + (j & 127); } }
        transpose_item(src, ldn, k0, n0, dst, Kd, drow, scr, lane);
}
#ifndef NSTEAL
#define NSTEAL 4
#endif
__device__ __forceinline__ void convert_steal(const Args& a, LAS unsigned char* lds, unsigned* ctr, int lo1, int n1, int lo2, int n2) {
    const int tid = otid(), w = __builtin_amdgcn_readfirstlane(tid >> 6), lane = tid & 63;
    LAS float* scr = (LAS float*)lds + w * (64 * 65);
    volatile LAS int* bc = (volatile LAS int*)(lds + LDS_BYTES - 32);
    const int n = n1 + n2;
    for (;;) {
        __syncthreads();
        if (tid == 0) bc[0] = (int)__hip_atomic_fetch_add(ctr, (unsigned)NSTEAL, __ATOMIC_RELAXED, __HIP_MEMORY_SCOPE_AGENT);
        __syncthreads();
        const int base = bc[0];
        if (base >= n) break;
        const int j = base + w;
        if (w < NSTEAL && j < n) convert_item(a, j < n1 ? lo1 + j : lo2 + (j - n1), scr, lane);
    }
}
__device__ __forceinline__ void gemv_fill(const Args& a, LAS unsigned char* lds) {
    LAS float* sc = (LAS float*)lds;
    for (int i = otid(); i < 5 * 2048; i += 512) { const float v = i < 8192 ? a.in[I_C][i] : a.in[I_CCTX][i - 8192]; sc[i] = siluf_(v); }
    __syncthreads();
}
__device__ __forceinline__ void gemv_item(const Args& a, LAS unsigned char* lds, int it) {
    const int tid = otid(), w = __builtin_amdgcn_readfirstlane(tid >> 6), lane = tid & 63;
    LAS float* sc = (LAS float*)lds; LAS float* red = sc + 5 * 2048;
    float* MOD = (float*)(a.ws + WS_MOD);
    const int l = it / 288, n0 = (it % 288) * 64, cl = (lane & 15) * 4, ks = lane >> 4;
    const float* W = a.in[I_ADAW] + (size_t)l * DM * MODW + n0 + cl;
    f32x4 acc[5] = {};
#pragma unroll 8
    for (int kk = 0; kk < 256; kk += 4) { const int k = w * 256 + kk + ks; const f32x4 wv = __builtin_nontemporal_load((const f32x4*)(W + (size_t)k * MODW));
#pragma unroll
        for (int i = 0; i < 5; ++i) acc[i] += wv * sc[i * 2048 + k]; }
#pragma unroll
    for (int i = 0; i < 5; ++i)
#pragma unroll
        for (int e = 0; e < 4; ++e) { float v = acc[i][e]; v += __shfl_xor(v, 16); v += __shfl_xor(v, 32); acc[i][e] = v; }
    if (lane < 16) {
#pragma unroll
        for (int i = 0; i < 5; ++i) *(LAS f32x4*)(red + (w * 5 + i) * 64 + cl) = acc[i]; }
    __syncthreads();
    if (tid < 320) { const int i = tid >> 6, cc = tid & 63; float s = a.in[I_ADAB][l * MODW + n0 + cc];
#pragma unroll
        for (int x = 0; x < 8; ++x) s += red[(x * 5 + i) * 64 + cc];
        MOD[((size_t)l * 5 + i) * MODW + n0 + cc] = s; }
    __syncthreads();
}
__device__ __forceinline__ void gemv_steal(const Args& a, LAS unsigned char* lds, unsigned* ctr, int lo, int n) {
    volatile LAS int* bc = (volatile LAS int*)(lds + LDS_BYTES - 32);
    bool filled = false;
    for (;;) {
        __syncthreads();
        if (otid() == 0) bc[0] = (int)__hip_atomic_fetch_add(ctr, 1u, __ATOMIC_RELAXED, __HIP_MEMORY_SCOPE_AGENT);
        __syncthreads();
        const int j = bc[0];
        if (j >= n) break;
        if (!filled) { gemv_fill(a, lds); filled = true; }
        gemv_item(a, lds, lo + j);
    }
}
__device__ __forceinline__ void phase0(const Args& a, LAS unsigned char* lds, int G) {
    const int tid = otid(), w = __builtin_amdgcn_readfirstlane(tid >> 6), lane = tid & 63, bid = obid();
    { const int id = bid * 512 + tid; if (id < 1024) { const int pos = id >> 4, i = id & 15; const float fr = __builtin_amdgcn_exp2f(-(float)i * (13.287712379549449f / 16.f)); const float ang = (float)pos * fr;
        ((f32x2*)(a.ws + WS_ROPE))[id] = (f32x2){__cosf(ang), __sinf(ang)}; } }
    gemv_fill(a, lds);
    for (int it = bid; it < 288; it += G) gemv_item(a, lds, it);
    LAS float* scr = (LAS float*)lds + w * (64 * 65);
    for (int it = bid * 8 + w; it < 2 * 2752; it += G * 8) convert_item(a, it, scr, lane);
}

struct RowP { const bf16_t* xinb; bf16_t* xoutb; const bf16_t* y; const float* xin; const float* ctxin; float* xout; bf16_t* h; int modeR; float wgt; const float* modg; int gidx; const float* gpost; const float* modh; int sidx; const float* gpre; int has_y, has_h; };
__device__ __forceinline__ void row_phase(const RowP& p, int G) {
    const int tid = otid(), w = tid >> 6, lane = tid & 63;
    const int nrows = p.modeR ? MR : ML;
    for (int r0 = (obid() * 8 + w) * 2; r0 < nrows; r0 += G * 16) {
        int mi; const float* xrow; float* xo; size_t lrow = 0;
        if (p.modeR) { const int b = r0 / RS, s = r0 % RS; if (s < CTX) { mi = 4; xrow = p.ctxin + (size_t)(b * CTX + s) * DM; xo = nullptr; } else { mi = b; lrow = (size_t)(b * SEQ + s - CTX); xrow = p.xin + lrow * DM; xo = p.xout; } }
        else { mi = r0 / SEQ; lrow = (size_t)r0; xrow = p.xin + lrow * DM; xo = p.xout; }
        const bool isctx = p.modeR && mi == 4;
        f32x4 xv[2][4][2]; u32x4 yv[2][4];
        if (p.xinb && !isctx) {
#pragma unroll
            for (int q = 0; q < 2; ++q)
#pragma unroll
                for (int j = 0; j < 4; ++j) { const u32x4 xx = *(const u32x4*)(p.xinb + (lrow + q) * DM + 8 * lane + 512 * j);
                    xv[q][j][0] = (f32x4){bflo(xx[0]), bfhi(xx[0]), bflo(xx[1]), bfhi(xx[1])}; xv[q][j][1] = (f32x4){bflo(xx[2]), bfhi(xx[2]), bflo(xx[3]), bfhi(xx[3])}; }
        } else {
#pragma unroll
            for (int q = 0; q < 2; ++q)
#pragma unroll
                for (int j = 0; j < 4; ++j) { const float* xp = xrow + (size_t)q * DM + 8 * lane + 512 * j; xv[q][j][0] = *(const f32x4*)xp; xv[q][j][1] = *(const f32x4*)(xp + 4); }
        }
        if (p.has_y) {
#pragma unroll
            for (int q = 0; q < 2; ++q)
#pragma unroll
                for (int j = 0; j < 4; ++j) yv[q][j] = *(const u32x4*)(p.y + (size_t)(r0 + q) * DM + 8 * lane + 512 * j);
            float ss[2] = {0.f, 0.f};
#pragma unroll
            for (int q = 0; q < 2; ++q)
#pragma unroll
                for (int j = 0; j < 4; ++j)
#pragma unroll
                    for (int e = 0; e < 4; ++e) { const float a = bflo(yv[q][j][e]), b = bfhi(yv[q][j][e]); ss[q] += a * a + b * b; }
            const float ry0 = rsqrtf(wave_sum(ss[0]) * (1.f / DM) + EPS) * p.wgt, ry1 = rsqrtf(wave_sum(ss[1]) * (1.f / DM) + EPS) * p.wgt;
            const float* gate = p.modg + (size_t)mi * MODW + p.gidx * DM;
#pragma unroll
            for (int j = 0; j < 4; ++j) { const int c = 8 * lane + 512 * j;
                const f32x4 gt0 = *(const f32x4*)(gate + c) * *(const f32x4*)(p.gpost + c), gt1 = *(const f32x4*)(gate + c + 4) * *(const f32x4*)(p.gpost + c + 4);
#pragma unroll
                for (int q = 0; q < 2; ++q) { const float ry = q ? ry1 : ry0; const u32x4 yy = yv[q][j];
                    const f32x4 y0 = {bflo(yy[0]), bfhi(yy[0]), bflo(yy[1]), bfhi(yy[1])}, y1 = {bflo(yy[2]), bfhi(yy[2]), bflo(yy[3]), bfhi(yy[3])};
                    xv[q][j][0] = xv[q][j][0] + gt0 * (y0 * ry); xv[q][j][1] = xv[q][j][1] + gt1 * (y1 * ry);
                    if (!isctx) { if (p.xoutb) *(u32x4*)(p.xoutb + (lrow + q) * DM + c) = (u32x4){cvtpk(xv[q][j][0][0], xv[q][j][0][1]), cvtpk(xv[q][j][0][2], xv[q][j][0][3]), cvtpk(xv[q][j][1][0], xv[q][j][1][1]), cvtpk(xv[q][j][1][2], xv[q][j][1][3])};
                                  else { float* op = xo + (lrow + q) * DM + c; *(f32x4*)op = xv[q][j][0]; *(f32x4*)(op + 4) = xv[q][j][1]; } } } }
        }
        if (p.has_h) {
            float ss[2] = {0.f, 0.f};
#pragma unroll
            for (int q = 0; q < 2; ++q)
#pragma unroll
                for (int j = 0; j < 4; ++j)
#pragma unroll
                    for (int k = 0; k < 2; ++k) { const f32x4 v = xv[q][j][k]; ss[q] += (v[0] * v[0] + v[1] * v[1]) + (v[2] * v[2] + v[3] * v[3]); }
            const float rx0 = rsqrtf(wave_sum(ss[0]) * (1.f / DM) + EPS), rx1 = rsqrtf(wave_sum(ss[1]) * (1.f / DM) + EPS);
            const float* sh = p.modh + (size_t)mi * MODW + p.sidx * DM; const float* scl = sh + DM;
#pragma unroll
            for (int j = 0; j < 4; ++j) { const int c = 8 * lane + 512 * j;
                const f32x4 m0 = *(const f32x4*)(p.gpre + c) * (*(const f32x4*)(scl + c) + 1.f), m1 = *(const f32x4*)(p.gpre + c + 4) * (*(const f32x4*)(scl + c + 4) + 1.f);
                const f32x4 s0 = *(const f32x4*)(sh + c), s1 = *(const f32x4*)(sh + c + 4);
#pragma unroll
                for (int q = 0; q < 2; ++q) { const float rx = q ? rx1 : rx0;
                    const f32x4 h0 = (xv[q][j][0] * rx) * m0 + s0, h1 = (xv[q][j][1] * rx) * m1 + s1;
                    *(u32x4*)(p.h + (size_t)(r0 + q) * DM + c) = (u32x4){cvtpk(h0[0], h0[1]), cvtpk(h0[2], h0[3]), cvtpk(h1[0], h1[1]), cvtpk(h1[2], h1[3])}; } }
        }
    }
}

__device__ __forceinline__ float half_sum(float v) {
#pragma unroll
    for (int o = 1; o < 32; o <<= 1) v += __shfl_xor(v, o);
    return v;
}
__device__ __forceinline__ void merge_phase(const Args& a, int G) {
    const int tid = otid(), w = tid >> 6, lane = tid & 63, l32 = lane & 31, hsel = lane >> 5;
    const float* dl = a.in[I_DLAM];
    const float s01 = wave_sum(dl[lane] * dl[64 + lane]), s23 = wave_sum(dl[128 + lane] * dl[192 + lane]);
    const float lam = __expf(s01) - __expf(s23) + 0.2f;
    const bf16_t* OA = (const bf16_t*)(a.ws + WS_OATT); const bf16_t* OR = (const bf16_t*)(a.ws + WS_OREC); const bf16_t* MP = (const bf16_t*)(a.ws + WS_MP); bf16_t* MG = (bf16_t*)(a.ws + WS_MG);
    const f32x4 ga = *(const f32x4*)(a.in[I_DNG] + 4 * l32) * 0.8f, gr = *(const f32x4*)(a.in[I_RNG] + 4 * l32);
    for (int lr = obid() * 8 + w; lr < ML; lr += G * 8) {
        const int b = lr / SEQ; const size_t rrow = (size_t)(lr + 256 * (b + 1));
        f32x4 o1[4], o2[4], of[4], ob[4]; u32x2 gw[4];
#pragma unroll
        for (int hp = 0; hp < 4; ++hp) { const size_t c0 = (size_t)lr * 1024 + (2 * hp + hsel) * 128 + 4 * l32;
            const u32x2 a1 = *(const u32x2*)(OA + c0), a2 = *(const u32x2*)(OA + (size_t)ML * 1024 + c0), r1 = *(const u32x2*)(OR + c0), r2 = *(const u32x2*)(OR + (size_t)ML * 1024 + c0);
            o1[hp] = (f32x4){bflo(a1[0]), bfhi(a1[0]), bflo(a1[1]), bfhi(a1[1])}; o2[hp] = (f32x4){bflo(a2[0]), bfhi(a2[0]), bflo(a2[1]), bfhi(a2[1])};
            of[hp] = (f32x4){bflo(r1[0]), bfhi(r1[0]), bflo(r1[1]), bfhi(r1[1])}; ob[hp] = (f32x4){bflo(r2[0]), bfhi(r2[0]), bflo(r2[1]), bfhi(r2[1])};
            gw[hp] = *(const u32x2*)(MP + rrow * MIXIN + 7168 + (2 * hp + hsel) * 128 + 4 * l32); }
#pragma unroll
        for (int hp = 0; hp < 4; ++hp) { const int c0 = (2 * hp + hsel) * 128 + 4 * l32;
            const f32x4 d = o1[hp] - o2[hp] * lam; const float r = rsqrtf(half_sum((d[0] * d[0] + d[1] * d[1]) + (d[2] * d[2] + d[3] * d[3])) * (1.f / 128.f) + EPS);
            const f32x4 x = d * r * ga;
            *(u32x2*)(MG + (size_t)lr * DM + c0) = (u32x2){cvtpk(x[0], x[1]), cvtpk(x[2], x[3])};
            const f32x4 o = of[hp] + ob[hp]; const float rr = rsqrtf(half_sum((o[0] * o[0] + o[1] * o[1]) + (o[2] * o[2] + o[3] * o[3])) * (1.f / 128.f) + EPS);
            const f32x4 g = {siluf_(bflo(gw[hp][0])), siluf_(bfhi(gw[hp][0])), siluf_(bflo(gw[hp][1])), siluf_(bfhi(gw[hp][1]))};
            const f32x4 y = o * rr * gr * g;
            *(u32x2*)(MG + (size_t)lr * DM + 1024 + c0) = (u32x2){cvtpk(y[0], y[1]), cvtpk(y[2], y[3])}; }
    }
}

__device__ __forceinline__ void conv_phase(const Args& a, int G) {
    const bf16_t* BG = (const bf16_t*)(a.ws + WS_MP); const bf16_t* CV = BG + (size_t)ML * DM; bf16_t* MG = (bf16_t*)(a.ws + WS_MG); const float* cw = a.in[I_CW];
    const int tid = otid(), c = (tid & 255) * 8, rh = tid >> 8;
    f32x4 w0[2], w1[2], w2[2];
#pragma unroll
    for (int k = 0; k < 2; ++k) { w0[k] = *(const f32x4*)(cw + c + 4 * k); w1[k] = *(const f32x4*)(cw + DM + c + 4 * k); w2[k] = *(const f32x4*)(cw + 2 * DM + c + 4 * k); }
    const u32x4 z = {0u, 0u, 0u, 0u};
    for (int it = obid(); it < ML / 16; it += G) {
        const int r0 = it * 16 + rh * 8;
        const int t0 = r0 & (SEQ - 1);
        u32x4 prev = t0 > 0 ? *(const u32x4*)(CV + (size_t)(r0 - 1) * DM + c) : z;
        u32x4 cur = *(const u32x4*)(CV + (size_t)r0 * DM + c);
#pragma unroll
        for (int i = 0; i < 8; ++i) {
            const int lr = r0 + i;
            const u32x4 nxt = (t0 + i < SEQ - 1) ? *(const u32x4*)(CV + (size_t)(lr + 1) * DM + c) : z;
            const u32x4 bg = *(const u32x4*)(BG + (size_t)lr * DM + c);
            u32x4 o;
#pragma unroll
            for (int e = 0; e < 4; ++e) { const int k = e >> 1, q = (e & 1) * 2;
                const float lo = bflo(bg[e]) * (w0[k][q] * bflo(prev[e]) + w1[k][q] * bflo(cur[e]) + w2[k][q] * bflo(nxt[e]));
                const float hi = bfhi(bg[e]) * (w0[k][q + 1] * bfhi(prev[e]) + w1[k][q + 1] * bfhi(cur[e]) + w2[k][q + 1] * bfhi(nxt[e]));
                o[e] = cvtpk(lo, hi); }
            *(u32x4*)(MG + (size_t)lr * DM + c) = o;
            prev = cur; cur = nxt;
        }
    }
}

#define XB_TMO      128
#define XB_XCNT(j)  (256  + 64 * (j))
#define XB_XSUB(j)  (1280 + 64 * (j))
#define XB_XGEN(j)  (2304 + 64 * (j))
#define XB_TOP      3328
#define XB_TOPGEN   3392
#define XCD_BAR_WORDS 3456
#define XB_SPIN_CAP (1u << 18)

__device__ __forceinline__ unsigned xb_ld(unsigned* p)              { return __hip_atomic_load(p, __ATOMIC_RELAXED, __HIP_MEMORY_SCOPE_AGENT); }
__device__ __forceinline__ unsigned xb_add(unsigned* p, unsigned v) { return __hip_atomic_fetch_add(p, v, __ATOMIC_RELAXED, __HIP_MEMORY_SCOPE_AGENT); }
__device__ __forceinline__ unsigned xb_xcc_id() { return (unsigned)__builtin_amdgcn_s_getreg((3 << 11) | 20) & 0xFu; }
#define XB_SPIN(cond, bar) do { unsigned _sp = 0; while (cond) { __builtin_amdgcn_s_sleep(1); \
    if ((++_sp & 255u) == 0u) { if (xb_ld(&(bar)[XB_TMO])) break; if (_sp > XB_SPIN_CAP) { atomicAdd(&(bar)[XB_TMO], 1u); break; } } } } while (0)

struct XcdBarrier {
    unsigned* bar; unsigned x;
    volatile LAS unsigned* st;
};

__device__ __forceinline__ XcdBarrier xcd_barrier_post(unsigned* bar, volatile LAS unsigned* st) {
    XcdBarrier b; b.bar = bar; b.x = xb_xcc_id(); b.st = st;
    if (threadIdx.x == 0) (void)xb_add(&bar[XB_XCNT(b.x)], 1u);
    return b;
}
__device__ __forceinline__ void xcd_barrier_complete(unsigned* bar, unsigned x, unsigned& nloc, unsigned& nx) {
    const unsigned G = gridDim.x * gridDim.y * gridDim.z;
    unsigned sum, cnt, mine, sp = 0u;
    for (;;) {
        sum = 0u; cnt = 0u; mine = 0u;
#pragma unroll
        for (unsigned j = 0; j < 16; ++j) { const unsigned c = xb_ld(&bar[XB_XCNT(j)]); sum += c; cnt += (c > 0u) ? 1u : 0u; mine = (j == x) ? c : mine; }
        if (sum == G) break;
        __builtin_amdgcn_s_sleep(1);
        if ((++sp & 255u) == 0u) { if (xb_ld(&bar[XB_TMO])) break; if (sp > XB_SPIN_CAP) { atomicAdd(&bar[XB_TMO], 1u); break; } }
    }
    nloc = mine > 0u ? mine : 1u; nx = cnt > 0u ? cnt : 1u;
}

__device__ __forceinline__ void xcd_barrier(const XcdBarrier& b) {
    asm volatile("s_waitcnt vmcnt(0)" ::: "memory");
    __syncthreads();
    if (threadIdx.x == 0) {
        unsigned* bar = b.bar;
        __builtin_amdgcn_s_waitcnt(0);
        unsigned nloc = b.st[0], nx = b.st[1];
        if (nloc == 0u) { xcd_barrier_complete(bar, b.x, nloc, nx); b.st[0] = nloc; b.st[1] = nx; }
        const unsigned old = xb_add(&bar[XB_XSUB(b.x)], 1u);
        const unsigned gen = old / nloc;
        if (old + 1u == (gen + 1u) * nloc) {
            __builtin_amdgcn_fence(__ATOMIC_RELEASE, "agent");
            asm volatile("s_waitcnt vmcnt(0)" ::: "memory");
            const unsigned og = xb_add(&bar[XB_TOP], 1u);
            const unsigned tg = og / nx;
            if (og + 1u == (tg + 1u) * nx) xb_add(&bar[XB_TOPGEN], 1u);
            else XB_SPIN(xb_ld(&bar[XB_TOPGEN]) == tg, bar);
            __builtin_amdgcn_fence(__ATOMIC_ACQUIRE, "agent");
            xb_add(&bar[XB_XGEN(b.x)], 1u);
            asm volatile("s_waitcnt vmcnt(0)" ::: "memory");
        } else {
            XB_SPIN(xb_ld(&bar[XB_XGEN(b.x)]) == gen, bar);
            __builtin_amdgcn_fence(__ATOMIC_ACQUIRE, "agent");
            asm volatile("s_waitcnt vmcnt(0)" ::: "memory");
        }
    }
    __syncthreads();
}

#define CTR_WORD(k) (3520 + 64 * (k))
#ifndef PHMASK
#define PHMASK 0x1ff
#endif
#define PHM(x) (((PHMASK) >> (x)) & 1)
__global__ void __launch_bounds__(512, 2) mega(Args a) {
    extern __shared__ __attribute__((aligned(16))) unsigned char smem[];
    LAS unsigned char* lds = (LAS unsigned char*)smem;
    const int G = gridDim.x;
    unsigned char* ws = a.ws;
    bf16_t* H = (bf16_t*)(ws + WS_H); bf16_t* ACT = (bf16_t*)(ws + WS_ACT); bf16_t* Y = (bf16_t*)(ws + WS_Y); bf16_t* MP = (bf16_t*)(ws + WS_MP); bf16_t* MG = (bf16_t*)(ws + WS_MG);
    const float* MOD = (const float*)(ws + WS_MOD);
#if MK_DIAG_ZERO
    for (int i = otid(); i < LDS_BYTES / 4; i += 512) ((LAS unsigned*)lds)[i] = 0u;
    __syncthreads();
#endif
    XcdBarrier bar; bar.bar = (unsigned*)(ws + WS_BAR); bar.x = 0; bar.st = (volatile LAS unsigned*)(lds + LDS_BYTES - 16);
    unsigned* const ctrs = (unsigned*)(ws + WS_BAR);
    if (a.ph_lo < 0) cg::this_grid().sync();
    if (otid() < 4) ((LAS unsigned*)(lds + LDS_BYTES - 16))[otid()] = 0u;
    __syncthreads();
    if (a.ph_hi - a.ph_lo > 1) bar = xcd_barrier_post((unsigned*)(ws + WS_BAR), (volatile LAS unsigned*)(lds + LDS_BYTES - 16));
    for (int ph = a.ph_lo; ph < a.ph_hi; ++ph) {
      for (int rep = 0; rep < (((MK_PROBE >> ph) & 1) ? 2 : 1); ++rep) {
        const int bid = obid();
        if (PHM(0) && ph == 0) { phase0(a, lds, G); }
        else if (PHM(1) && (ph == 1 || ph == 4 || ph == 9 || ph == 12 || ph == 15 || ph == 19 || ph == 22)) {
            RowP p; p.y = Y; p.ctxin = a.in[I_CTX]; p.xout = a.out; p.h = H;
            bf16_t* XB = (bf16_t*)(ws + WS_XB);
            p.modeR = (ph <= 4); p.xin = a.in[I_X]; p.xinb = (ph <= 4) ? nullptr : XB; p.xoutb = (ph == 22) ? nullptr : XB; p.has_y = (ph != 1); p.has_h = (ph != 22);
            const int lg = (ph <= 12) ? 0 : 1;
            const int lh = (ph <= 9) ? 0 : 1;
            const int sub = (ph == 4 || ph == 15) ? 0 : (ph == 9 || ph == 19) ? 1 : 2;
            const int nxt = (ph == 1 || ph == 12) ? 0 : (ph == 4 || ph == 15) ? 1 : 2;
            p.wgt = (sub == 1) ? 1.f : 0.5f;
            p.modg = MOD + (size_t)lg * 5 * MODW; p.gidx = 3 * sub + 2; p.gpost = a.in[I_NORMG] + (size_t)(lg * 6 + 2 * sub + 1) * DM;
            p.modh = MOD + (size_t)lh * 5 * MODW; p.sidx = 3 * nxt; p.gpre = a.in[I_NORMG] + (size_t)(lh * 6 + 2 * nxt) * DM;
            row_phase(p, G);
        }
        else if (PHM(2) && (ph == 2 || ph == 10 || ph == 13 || ph == 20)) {
            const int f = (ph == 2) ? 0 : (ph == 10) ? 1 : (ph == 13) ? 2 : 3; const int M = (ph == 2) ? MR : ML;
            pg8::Gemm g{H, (const bf16_t*)(ws + WS_WGU + (size_t)f * SZ_WGU), M, 2 * DFF, DM}; pg8::StaticOrder S; S.init(M, 2 * DFF, G, bid);
            pg8::EpiPair E{ACT, DFF, nullptr, 0, 0, 1};
            pg8::gemm_phase<pg8::EpiPair, pg8::StaticOrder, true, true>(lds, g, S, E);
            if (ph == 2) convert_steal(a, lds, ctrs + CTR_WORD(0), 2 * 2752, 2752, T_FFN, T_MI + T_SQ);
            else if (ph == 10) convert_steal(a, lds, ctrs + CTR_WORD(2), 9 * 2752, 2 * 2752, 0, 0);
            else if (ph == 13) convert_steal(a, lds, ctrs + CTR_WORD(3), 11 * 2752, 2752, 0, 0);
        }
        else if (PHM(2) && ph == 16) {
            pg8::Gemm g{H, (const bf16_t*)(ws + WS_WCI), ML, 3 * DM, DM}; pg8::StaticOrder S; S.init(ML, 3 * DM, G, bid);
            pg8::EpiPair E{MP + (size_t)ML * DM, DM, MP, DM, 8, 0};
            pg8::gemm_phase<pg8::EpiPair, pg8::StaticOrder, true, true>(lds, g, S, E);
        }
        else if (PHM(3) && (ph == 3 || ph == 11 || ph == 14 || ph == 21 || ph == 8 || ph == 18)) {
            const bool down = !(ph == 8 || ph == 18);
            const int f = (ph == 3) ? 0 : (ph == 11) ? 1 : (ph == 14) ? 2 : 3; const int M = (ph == 3) ? MR : ML;
            const bf16_t* A = down ? ACT : MG; const bf16_t* Bt = down ? (const bf16_t*)(ws + WS_WD + (size_t)f * SZ_WD) : (const bf16_t*)(ws + (ph == 8 ? WS_WMO : WS_WCO));
            pg8::Gemm g{A, Bt, M, DM, down ? DFF : DM}; pg8::StaticOrder S; S.init(M, DM, G, bid);
            pg8::EpiB16 E{Y, DM};
            pg8::gemm_phase<pg8::EpiB16, pg8::StaticOrder, true, true>(lds, g, S, E);
            if (ph == 3) { convert_steal(a, lds, ctrs + CTR_WORD(1), 3 * 2752, 6 * 2752, T_FFN + T_MI + T_SQ, T_SQ + T_CI);
                           gemv_steal(a, lds, ctrs + CTR_WORD(5), 288, 288); }
        }
        else if (PHM(4) && ph == 5) {
            pg8::Gemm g{H, (const bf16_t*)(ws + WS_WMI), MR, MIXIN, DM}; pg8::StaticOrder S; S.init(MR, MIXIN, G, bid);
            pg8::EpiMix E{MP, MIXIN, (const f32x2*)(ws + WS_ROPE)};
            pg8::gemm_phase<pg8::EpiMix, pg8::StaticOrder, true, true>(lds, g, S, E);
        }
        else if (ph == 6) {
            bf16_t* OATT = (bf16_t*)(ws + WS_OATT);
            if (G >= 128) { if (bid < 64 && PHM(5)) hgrn_unit(a, lds, bid); }
            else { for (int u = bid; u < 64; u += G) if (PHM(5)) hgrn_unit(a, lds, u); }
            volatile LAS int* bc = (volatile LAS int*)(lds + LDS_BYTES - 32);
            for (;;) {
                __syncthreads();
                if (otid() == 0) bc[0] = (int)__hip_atomic_fetch_add(ctrs + CTR_WORD(4), 1u, __ATOMIC_RELAXED, __HIP_MEMORY_SCOPE_AGENT);
                __syncthreads();
                const int u = bc[0];
                if (u >= 512) break;
                const int qb = u & 7, mp = (u >> 3) & 1, h = (u >> 4) & 7, b = u >> 7;
                const bf16_t* base = MP + (size_t)(b * RS) * MIXIN;
                if (PHM(6)) att::attn_body(base + (size_t)(CTX + qb * 256) * MIXIN + h * 128 + mp * 64, base + 1024 + h * 128 + mp * 64, base + 2048 + h * 128,
                               OATT + (size_t)mp * ML * 1024 + (size_t)(b * SEQ + qb * 256) * 1024 + h * 128, RS, (char*)smem);
            }
        }
        else if (PHM(7) && ph == 7) { merge_phase(a, G); }
        else if (PHM(8) && ph == 17) { conv_phase(a, G); }
        if (ph + 1 < a.ph_hi) xcd_barrier(bar);
      }
    }

}

extern "C" void kernel_launch(void* const* d_in, const int* in_sizes, int n_in, void* d_out, int out_size, void* d_ws, size_t ws_size, hipStream_t stream) {
    static int grid = 0;
    if (grid == 0) {
        if (n_in != 19 || out_size != ML * DM || ws_size < WS_END) { fprintf(stderr, "kernel_launch: unexpected shapes: n_in %d out %d ws %zu (need %zu)\n", n_in, out_size, ws_size, (size_t)WS_END); grid = -1; return; }
        int dev = 0, cus = 0, per_cu = 0;
        hipGetDevice(&dev); hipDeviceGetAttribute(&cus, hipDeviceAttributeMultiprocessorCount, dev);
        if (hipFuncSetAttribute((const void*)mega, hipFuncAttributeMaxDynamicSharedMemorySize, LDS_BYTES) != hipSuccess) { fprintf(stderr, "kernel_launch: hipFuncSetAttribute failed\n"); grid = -1; return; }
        if (hipOccupancyMaxActiveBlocksPerMultiprocessor(&per_cu, (const void*)mega, 512, LDS_BYTES) != hipSuccess || per_cu < 1) { fprintf(stderr, "kernel_launch: occupancy query gave %d\n", per_cu); per_cu = 1; }
        (void)hipGetLastError();
        grid = cus * per_cu;
        fprintf(stderr, "kernel_launch: grid %d (cus %d x %d)\n", grid, cus, per_cu);
    }
    if (grid < 0) return;
#if MK_DIAG_ZERO
    (void)hipMemsetAsync(d_ws, 0, WS_END, stream);
    (void)hipMemsetAsync(d_out, 0, (size_t)ML * DM * 4, stream);
#endif
    (void)hipMemsetAsync((unsigned char*)d_ws + WS_BAR, 0, 16384, stream);
    Args a{};
    for (int i = 0; i < 19; ++i) a.in[i] = (const float*)d_in[i];
    a.out = (float*)d_out; a.ws = (unsigned char*)d_ws;
#if MK_MULTI
    for (int ph = 0; ph < NPHASE; ++ph) { a.ph_lo = ph; a.ph_hi = ph + 1; hipLaunchKernelGGL(mega, dim3(grid), dim3(512), LDS_BYTES, stream, a); }
#else
    a.ph_lo = 0; a.ph_hi = NPHASE;
    void* args[] = {&a};
    hipError_t e = hipLaunchCooperativeKernel((const void*)mega, dim3(grid), dim3(512), args, LDS_BYTES, stream);
    if (e != hipSuccess) fprintf(stderr, "kernel_launch: cooperative launch failed: %s (grid %d)\n", hipGetErrorString(e), grid);
#endif
}
```

```cpp
#include <hip/hip_runtime.h>
#include <hip/hip_cooperative_groups.h>
#include <cstdio>
#include <cstdint>
namespace cg = cooperative_groups;

#ifndef MK_MULTI
#define MK_MULTI 0
#endif

#ifndef MK_PROBE
#define MK_PROBE 0
#endif
#ifndef MK_DIAG_ZERO
#define MK_DIAG_ZERO 0
#endif
#define LAS __attribute__((address_space(3)))
typedef unsigned short bf16_t;
typedef short bf16x8 __attribute__((ext_vector_type(8)));
typedef short s16x4 __attribute__((ext_vector_type(4)));
typedef float f32x2 __attribute__((ext_vector_type(2)));
typedef float f32x4 __attribute__((ext_vector_type(4)));
typedef float f32x16 __attribute__((ext_vector_type(16)));
typedef unsigned u32x2 __attribute__((ext_vector_type(2)));
typedef unsigned u32x4 __attribute__((ext_vector_type(4)));

constexpr int DM = 2048, NB = 4, SEQ = 2048, CTX = 256, RS = SEQ + CTX, MR = NB * RS, ML = NB * SEQ, DFF = 5504, MODW = 9 * DM, MIXIN = 8192;
constexpr float EPS = 1e-6f;
constexpr int NPHASE = 23;
constexpr int LDS_BYTES = 147456;

struct Args { const float* in[19]; float* out; unsigned char* ws; int ph_lo, ph_hi; };
enum { I_X = 0, I_C, I_CTX, I_CCTX, I_ADAW, I_ADAB, I_NORMG, I_WG, I_WU, I_WDN, I_MIXIN, I_MIXOUT, I_DLAM, I_DNG, I_RNG, I_RLB, I_CWIN, I_CW, I_CWOUT };

constexpr size_t WS_MOD = 0;
constexpr size_t WS_ROPE = WS_MOD + (size_t)2 * 5 * MODW * 4;
constexpr size_t SZ_WGU = (size_t)2 * DFF * DM * 2, SZ_WD = (size_t)DM * DFF * 2;
constexpr size_t WS_BAR = WS_ROPE + 8192;
constexpr size_t WS_WGU = WS_BAR + 16384;
constexpr size_t WS_WD = WS_WGU + 4 * SZ_WGU;
constexpr size_t WS_WMI = WS_WD + 4 * SZ_WD;
constexpr size_t WS_WMO = WS_WMI + (size_t)MIXIN * DM * 2;
constexpr size_t WS_WCI = WS_WMO + (size_t)DM * DM * 2;
constexpr size_t WS_WCO = WS_WCI + (size_t)3 * DM * DM * 2;
constexpr size_t WS_H = WS_WCO + (size_t)DM * DM * 2;
constexpr size_t WS_ACT = WS_H + (size_t)MR * DM * 2;
constexpr size_t WS_Y = WS_ACT + (size_t)MR * DFF * 2;
constexpr size_t WS_MP = WS_Y + (size_t)MR * DM * 4;
constexpr size_t WS_OATT = WS_MP + (size_t)MR * MIXIN * 2;
constexpr size_t WS_OREC = WS_OATT + (size_t)2 * ML * 1024 * 4;
constexpr size_t WS_MG = WS_OREC + (size_t)2 * ML * 1024 * 4;
constexpr size_t WS_XB = WS_MG + (size_t)ML * DM * 2;
constexpr size_t WS_END = WS_XB + (size_t)ML * DM * 2;

typedef __bf16 bf16x2_t __attribute__((ext_vector_type(2)));
__device__ __forceinline__ unsigned cvtpk(float lo, float hi) { const f32x2 v = {lo, hi}; const bf16x2_t b = __builtin_convertvector(v, bf16x2_t); return __builtin_bit_cast(unsigned, b); }
__device__ __forceinline__ float bflo(unsigned w) { return __uint_as_float(w << 16); }
__device__ __forceinline__ float bfhi(unsigned w) { return __uint_as_float(w & 0xffff0000u); }
__device__ __forceinline__ float wave_sum(float v) {
#pragma unroll
    for (int o = 1; o < 64; o <<= 1) v += __shfl_xor(v, o);
    return v;
}
__device__ __forceinline__ int otid() { int t = threadIdx.x; asm volatile("" : "+v"(t)); return t; }
__device__ __forceinline__ int obid() { int t = blockIdx.x; asm volatile("" : "+s"(t)); return t; }
__device__ __forceinline__ float sigmoidf_(float x) { return __builtin_amdgcn_rcpf(1.f + __expf(-x)); }
__device__ __forceinline__ float siluf_(float x) { return x * sigmoidf_(x); }

namespace pg8 {
#define PG8_LAS __attribute__((address_space(3)))
typedef unsigned short bf16_t;
typedef short bf16x8 __attribute__((ext_vector_type(8)));
typedef float f32x4 __attribute__((ext_vector_type(4)));
typedef unsigned u32x4 __attribute__((ext_vector_type(4)));
constexpr int BM = 256, BK = 64, HALF = 128, HTB = HALF * BK * 2  , STAGE_BYTES = 8 * HTB, NXCD = 8, WGM = 8;

__host__ __device__ __forceinline__ int lds_byte(int r, int c) { const int st = (r >> 4) * 2 + (c >> 5), rr = r & 15, cc = c & 31, ob = rr * 64 + cc * 2; return st * 1024 + (ob ^ (((ob >> 9) & 1) << 5)); }
__host__ __device__ __forceinline__ void stage_rc(int b, int& R, int& C) { const int st = b / 1024, sb = b % 1024, swz = sb ^ (((sb >> 9) & 1) << 5); R = (st >> 1) * 16 + swz / 64; C = (st & 1) * 32 + (swz % 64) / 2; }
__host__ __device__ __forceinline__ int perm32(int rho) { const int n = rho >> 4, i = rho & 15; return 8 * (i >> 2) + 4 * n + (i & 3); }

struct Unit { int pm, pn; };
struct Gemm { const bf16_t* A; const bf16_t* Bt; int M, N, K; };

struct StaticOrder {
    int nM, nN, nwg, G, c;
    __host__ __device__ void init(int M, int N, int G_, int c_) { nM = M / BM; nN = N / BM; nwg = nM * nN; G = G_; c = c_; }
    __host__ __device__ bool next(int i, Unit& u) const {
        const long L = (long)i * G + c; if (L >= nwg) return false;
        int wgid = (int)L; { const int q = nwg / NXCD, r = nwg % NXCD, xcd = wgid % NXCD, off = wgid / NXCD; wgid = (xcd < r ? xcd * (q + 1) : r * (q + 1) + (xcd - r) * q) + off; }
        const int nig = WGM * nN, gid = wgid / nig, fm = gid * WGM, gsz = (nM - fm) < WGM ? (nM - fm) : WGM;
        u.pm = fm + ((wgid % nig) % gsz); u.pn = (wgid % nig) / gsz; return true;
    }
    __device__ __forceinline__ void a_ready(const Unit&) const {}
    __device__ __forceinline__ void done(const Unit&) const {}
};

__device__ __forceinline__ unsigned cvt_pk_bf16(float lo, float hi) { return ::cvtpk(lo, hi); }
typedef float f32x2 __attribute__((ext_vector_type(2)));

__device__ __forceinline__ void st8_bf16(bf16_t* p, const f32x4 v0, const f32x4 v1) {
    u32x4 w; w.x = cvt_pk_bf16(v0[0], v0[1]); w.y = cvt_pk_bf16(v0[2], v0[3]); w.z = cvt_pk_bf16(v1[0], v1[1]); w.w = cvt_pk_bf16(v1[2], v1[3]); *(u32x4*)p = w;
}
__device__ __forceinline__ float silu_e(float g) { return g * __builtin_amdgcn_rcpf(1.f + __expf(-g)); }
struct EpiPair {
    static constexpr bool PERM = true, AFTER_DRAIN = false;
    bf16_t* O1; int ld1; bf16_t* O0; int ld0; int nplain; int silu;
    __device__ __forceinline__ void operator()(const f32x4 (&acc)[2][2][4][2], const Unit& u, int wr, int wc, int fr, int fq) const {
        const int row0 = u.pm * BM + wr * 64 + fr;
        if (u.pn < nplain) {
            const int col0 = u.pn * BM + wc * 32 + 8 * fq;
#pragma unroll
            for (int ai = 0; ai < 2; ++ai)
#pragma unroll
                for (int m = 0; m < 4; ++m) { bf16_t* rowp = O0 + (size_t)(row0 + ai * HALF + m * 16) * ld0 + col0;
#pragma unroll
                    for (int bj = 0; bj < 2; ++bj) st8_bf16(rowp + bj * HALF, acc[ai][bj][m][0], acc[ai][bj][m][1]); }
        } else {
            const int col0 = (u.pn - nplain) * HALF + wc * 32 + 8 * fq;
#pragma unroll
            for (int ai = 0; ai < 2; ++ai)
#pragma unroll
                for (int m = 0; m < 4; ++m) { bf16_t* rowp = O1 + (size_t)(row0 + ai * HALF + m * 16) * ld1 + col0;
                    f32x4 g0 = acc[ai][0][m][0], g1 = acc[ai][0][m][1]; const f32x4 u0 = acc[ai][1][m][0], u1 = acc[ai][1][m][1];
                    if (silu) {
#pragma unroll
                        for (int e = 0; e < 4; ++e) { g0[e] = silu_e(g0[e]); g1[e] = silu_e(g1[e]); } }
                    st8_bf16(rowp, g0 * u0, g1 * u1); }
        }
    }
};
struct EpiB16 {
    static constexpr bool PERM = true, AFTER_DRAIN = false;
    bf16_t* O; int ld;
    __device__ __forceinline__ void operator()(const f32x4 (&acc)[2][2][4][2], const Unit& u, int wr, int wc, int fr, int fq) const {
        const int row0 = u.pm * BM + wr * 64 + fr, col0 = u.pn * BM + wc * 32 + 8 * fq;
#pragma unroll
        for (int ai = 0; ai < 2; ++ai)
#pragma unroll
            for (int m = 0; m < 4; ++m) { bf16_t* rowp = O + (size_t)(row0 + ai * HALF + m * 16) * ld + col0;
#pragma unroll
                for (int bj = 0; bj < 2; ++bj) st8_bf16(rowp + bj * HALF, acc[ai][bj][m][0], acc[ai][bj][m][1]); }
    }
};
struct EpiMix {
    static constexpr bool PERM = true, AFTER_DRAIN = false;
    bf16_t* O; int ld; const f32x2* rope;
    __device__ __forceinline__ void operator()(const f32x4 (&acc)[2][2][4][2], const Unit& u, int wr, int wc, int fr, int fq) const {
        const int row0 = u.pm * BM + wr * 64 + fr, col0 = u.pn * BM + wc * 32 + 8 * fq;
        const int pmod = u.pm % 9;
        if (u.pn >= 8 || pmod == 0) {
#pragma unroll
            for (int ai = 0; ai < 2; ++ai)
#pragma unroll
                for (int m = 0; m < 4; ++m) { bf16_t* rowp = O + (size_t)(row0 + ai * HALF + m * 16) * ld + col0;
#pragma unroll
                    for (int bj = 0; bj < 2; ++bj) st8_bf16(rowp + bj * HALF, acc[ai][bj][m][0], acc[ai][bj][m][1]); }
        } else {
            const int half = wc & 1, i0 = 8 * (fq & 1); const float sgn = fq < 2 ? -1.f : 1.f;
#pragma unroll
            for (int ai = 0; ai < 2; ++ai) {
                const int tb = (pmod - 1) * 256 + ai * HALF + wr * 64;
#pragma unroll
                for (int m = 0; m < 4; ++m) {
                    const int pos = half ? (m * 16 + fr) : (tb >> 6);
                    const f32x4* rp = (const f32x4*)(rope + pos * 16 + i0);
                    const f32x4 c01 = rp[0], c23 = rp[1], c45 = rp[2], c67 = rp[3];
                    const float cs[8] = {c01[0], c01[2], c23[0], c23[2], c45[0], c45[2], c67[0], c67[2]};
                    const float sn[8] = {c01[1], c01[3], c23[1], c23[3], c45[1], c45[3], c67[1], c67[3]};
                    bf16_t* rowp = O + (size_t)(row0 + ai * HALF + m * 16) * ld + col0;
#pragma unroll
                    for (int bj = 0; bj < 2; ++bj) {
                        f32x4 v0 = acc[ai][bj][m][0], v1 = acc[ai][bj][m][1], o0, o1;
#pragma unroll
                        for (int e = 0; e < 4; ++e) { const float p0 = __shfl_xor(v0[e], 32), p1 = __shfl_xor(v1[e], 32);
                            o0[e] = v0[e] * cs[e] + sgn * p0 * sn[e]; o1[e] = v1[e] * cs[4 + e] + sgn * p1 * sn[4 + e]; }
                        st8_bf16(rowp + bj * HALF, o0, o1);
                    }
                }
            }
        }
    }
};

template <class Epi, class Sched, bool ALIGN_EPI = false, bool SP2 = false>
__device__ __forceinline__ void gemm_phase(PG8_LAS unsigned char* lds, const Gemm g, const Sched& S, const Epi& E) {
    const int tid = otid(), wid = __builtin_amdgcn_readfirstlane(tid >> 6), lane = tid & 63, wr = wid >> 2, wc = wid & 3, fr = lane & 15, fq = lane >> 4;
    const int K = g.K, nt = K / BK;
    unsigned voffA[2], voffB[2];
#pragma unroll
    for (int i = 0; i < 2; ++i) { int R, C; stage_rc(tid * 16 + i * 8192, R, C); const int Rb = Epi::PERM ? ((R & ~31) + perm32(R & 31)) : R;
        voffA[i] = (unsigned)(R * K + C) * 2u; voffB[i] = (unsigned)(Rb * K + C) * 2u; }
    const size_t kstep = (size_t)(BK * 2);
    const size_t hstep = (size_t)HALF * K * 2;
    const size_t tstep = 2 * hstep;
    const unsigned ldsw = (unsigned)wid * 1024u;
    const int aoff = lds_byte(wr * 64 + fr, fq * 8), boff = lds_byte(wc * 32 + fr, fq * 8);
#define PG8_SA(b, h) (((b) * 2 + (h)) * HTB)
#define PG8_SB(b, h) ((4 + (b) * 2 + (h)) * HTB)
#define PG8_STAGE(bufoff, gbase, voff) do { _Pragma("unroll") for (int _i = 0; _i < 2; ++_i) \
        __builtin_amdgcn_global_load_lds((const unsigned*)((const char*)(gbase) + (voff)[_i]), (PG8_LAS unsigned*)(lds + (bufoff) + ldsw + _i * 8192), 16, 0, 0); } while (0)
#define PG8_LDA(dst, b, h) do { _Pragma("unroll") for (int m = 0; m < 4; ++m) _Pragma("unroll") for (int k = 0; k < 2; ++k) dst[m][k] = *(const PG8_LAS bf16x8*)(lds + PG8_SA(b, h) + aoff + m * 2048 + k * 1024); } while (0)
#define PG8_LDB(dst, b, h) do { _Pragma("unroll") for (int n = 0; n < 2; ++n) _Pragma("unroll") for (int k = 0; k < 2; ++k) dst[n][k] = *(const PG8_LAS bf16x8*)(lds + PG8_SB(b, h) + boff + n * 2048 + k * 1024); } while (0)
#define PG8_MMA(ai, bj, At, Bt) do { __builtin_amdgcn_s_setprio(1); _Pragma("unroll") for (int m = 0; m < 4; ++m) _Pragma("unroll") for (int n = 0; n < 2; ++n) _Pragma("unroll") for (int k = 0; k < 2; ++k) \
        acc[ai][bj][m][n] = __builtin_amdgcn_mfma_f32_16x16x32_bf16(Bt[n][k], At[m][k], acc[ai][bj][m][n], 0, 0, 0); __builtin_amdgcn_s_setprio(0); } while (0)
#define PG8_WAIT_V(n) asm volatile("s_waitcnt vmcnt(" #n ")" ::: "memory")
#define PG8_WAIT_L(n) asm volatile("s_waitcnt lgkmcnt(" #n ")" ::: "memory")
#define PG8_BAR __builtin_amdgcn_s_barrier()
#define PG8_SCHED __builtin_amdgcn_sched_barrier(0)
    Unit cur, nxt; int ui = 0;
    if (!S.next(0, cur)) return;
    f32x4 acc[2][2][4][2];
#pragma unroll
    for (int a = 0; a < 2; ++a)
#pragma unroll
        for (int b = 0; b < 2; ++b)
#pragma unroll
            for (int m = 0; m < 4; ++m)
#pragma unroll
                for (int n = 0; n < 2; ++n) acc[a][b][m][n] = (f32x4){0.f, 0.f, 0.f, 0.f};
    bf16x8 At[4][2], B0[2][2], B1[2][2];
    const char* cA = (const char*)g.A + (size_t)cur.pm * tstep; const char* cB = (const char*)g.Bt + (size_t)cur.pn * tstep;
    S.a_ready(cur);
    if constexpr (SP2) {
        PG8_STAGE(PG8_SB(0, 0), cB, voffB); PG8_STAGE(PG8_SB(0, 1), cB + hstep, voffB); PG8_STAGE(PG8_SA(0, 0), cA, voffA); PG8_STAGE(PG8_SA(0, 1), cA + hstep, voffA);
        if (wr == 1) PG8_BAR;
        PG8_WAIT_V(2); PG8_BAR;
        PG8_STAGE(PG8_SB(1, 0), cB + kstep, voffB); PG8_STAGE(PG8_SA(1, 0), cA + kstep, voffA); PG8_STAGE(PG8_SB(1, 1), cB + hstep + kstep, voffB);
        PG8_WAIT_V(6); PG8_BAR;
    } else {
        PG8_STAGE(PG8_SB(0, 0), cB, voffB); PG8_STAGE(PG8_SA(0, 0), cA, voffA); PG8_STAGE(PG8_SB(0, 1), cB + hstep, voffB); PG8_STAGE(PG8_SA(0, 1), cA + hstep, voffA);
        if (wr == 1) PG8_BAR;
        PG8_WAIT_V(4); PG8_BAR;
        PG8_STAGE(PG8_SB(1, 0), cB + kstep, voffB); PG8_STAGE(PG8_SA(1, 0), cA + kstep, voffA); PG8_STAGE(PG8_SB(1, 1), cB + hstep + kstep, voffB);
        PG8_WAIT_V(6); PG8_BAR;
    }
    for (;;) {
        const bool has_next = S.next(ui + 1, nxt);
        const char* nA = has_next ? (const char*)g.A + (size_t)nxt.pm * tstep : cA; const char* nB = has_next ? (const char*)g.Bt + (size_t)nxt.pn * tstep : cB;
        for (int t = 0; t < nt; t += 2) {
            const bool last = (t == nt - 2);
            const char* a1 = cA + (size_t)(t + 1) * kstep;
            const char* a2 = last ? nA : cA + (size_t)(t + 2) * kstep; const char* b2 = last ? nB : cB + (size_t)(t + 2) * kstep;
            const char* a3 = a2 + kstep; const char* b3 = b2 + kstep;
            if (last && has_next) S.a_ready(nxt);
            if constexpr (SP2) {
            PG8_LDB(B0, 0, 0); PG8_LDB(B1, 0, 1); PG8_SCHED; PG8_LDA(At, 0, 0); PG8_STAGE(PG8_SA(1, 1), a1 + hstep, voffA);
            PG8_WAIT_V(8); PG8_WAIT_L(0); PG8_BAR; PG8_MMA(0, 0, At, B0); PG8_MMA(0, 1, At, B1); PG8_BAR; PG8_SCHED;
            PG8_LDA(At, 0, 1); PG8_STAGE(PG8_SB(0, 0), b2, voffB); PG8_STAGE(PG8_SB(0, 1), b2 + hstep, voffB); PG8_STAGE(PG8_SA(0, 0), a2, voffA);
            PG8_WAIT_V(8); PG8_WAIT_L(0); PG8_BAR; PG8_MMA(1, 0, At, B0); PG8_MMA(1, 1, At, B1); PG8_BAR; PG8_SCHED;
            PG8_LDB(B0, 1, 0); PG8_LDB(B1, 1, 1); PG8_SCHED; PG8_LDA(At, 1, 0); PG8_STAGE(PG8_SA(0, 1), a2 + hstep, voffA);
            PG8_WAIT_V(8); PG8_WAIT_L(0); PG8_BAR; PG8_MMA(0, 0, At, B0); PG8_MMA(0, 1, At, B1); PG8_BAR; PG8_SCHED;
            PG8_LDA(At, 1, 1); PG8_STAGE(PG8_SB(1, 0), b3, voffB); PG8_STAGE(PG8_SB(1, 1), b3 + hstep, voffB); PG8_STAGE(PG8_SA(1, 0), a3, voffA);
            PG8_WAIT_V(8); PG8_WAIT_L(0); PG8_BAR; PG8_MMA(1, 0, At, B0); PG8_MMA(1, 1, At, B1); PG8_BAR; PG8_SCHED;
            } else {
            PG8_LDB(B0, 0, 0); PG8_SCHED; PG8_LDA(At, 0, 0); PG8_STAGE(PG8_SA(1, 1), a1 + hstep, voffA);
            PG8_WAIT_L(8); PG8_BAR; PG8_WAIT_L(0); PG8_MMA(0, 0, At, B0); PG8_BAR; PG8_SCHED;
            PG8_LDB(B1, 0, 1); PG8_STAGE(PG8_SB(0, 0), b2, voffB);
            PG8_BAR; PG8_WAIT_L(0); PG8_MMA(0, 1, At, B1); PG8_BAR;
            PG8_LDA(At, 0, 1); PG8_STAGE(PG8_SA(0, 0), a2, voffA);
            PG8_BAR; PG8_WAIT_L(0); PG8_MMA(1, 0, At, B0); PG8_BAR; PG8_SCHED;
            PG8_STAGE(PG8_SB(0, 1), b2 + hstep, voffB);
            PG8_WAIT_V(6); PG8_BAR; PG8_MMA(1, 1, At, B1); PG8_BAR;
            PG8_LDB(B0, 1, 0); PG8_SCHED; PG8_LDA(At, 1, 0); PG8_STAGE(PG8_SA(0, 1), a2 + hstep, voffA);
            PG8_WAIT_L(8); PG8_BAR; PG8_WAIT_L(0); PG8_MMA(0, 0, At, B0); PG8_BAR; PG8_SCHED;
            PG8_LDB(B1, 1, 1); PG8_STAGE(PG8_SB(1, 0), b3, voffB);
            PG8_BAR; PG8_WAIT_L(0); PG8_MMA(0, 1, At, B1); PG8_BAR;
            PG8_LDA(At, 1, 1); PG8_STAGE(PG8_SA(1, 0), a3, voffA);
            PG8_BAR; PG8_WAIT_L(0); PG8_MMA(1, 0, At, B0); PG8_BAR; PG8_SCHED;
            PG8_STAGE(PG8_SB(1, 1), b3 + hstep, voffB);
            PG8_WAIT_V(6); PG8_BAR; PG8_MMA(1, 1, At, B1); PG8_BAR;
            }
        }
        if constexpr (ALIGN_EPI) { if (wr == 0) PG8_BAR; }
        if constexpr (!Epi::AFTER_DRAIN) { E(acc, cur, wr, wc, fr, fq); S.done(cur); }
        if (!has_next) break;
#pragma unroll
        for (int a = 0; a < 2; ++a)
#pragma unroll
            for (int b = 0; b < 2; ++b)
#pragma unroll
                for (int m = 0; m < 4; ++m)
#pragma unroll
                    for (int n = 0; n < 2; ++n) acc[a][b][m][n] = (f32x4){0.f, 0.f, 0.f, 0.f};
        cur = nxt; cA = nA; cB = nB; ++ui;
        if constexpr (ALIGN_EPI) { if (wr == 1) PG8_BAR; }
    }
    PG8_WAIT_V(0);
    if constexpr (!ALIGN_EPI) { if (wr == 0) PG8_BAR; }
    PG8_BAR;
    if constexpr (Epi::AFTER_DRAIN) { E.fused(acc, cur, wr, wc, fr, fq, lds, wid, lane); S.done(cur); }
#undef PG8_SA
#undef PG8_SB
#undef PG8_STAGE
#undef PG8_LDA
#undef PG8_LDB
#undef PG8_MMA
#undef PG8_WAIT_V
#undef PG8_WAIT_L
#undef PG8_BAR
#undef PG8_SCHED
}
}

namespace att {
constexpr int NW = 8, QBLK = 32, KVBLK = 64, DV = 128, DQ = 64;
constexpr float SCALE = 0.125f, THR = 8.f;
constexpr int LDQ = MIXIN, LDK = MIXIN, LDO = 1024;
constexpr int SHM_V = KVBLK * DV * 2, SHM_K = KVBLK * DQ * 2, SHM_ATTN = 2 * SHM_V + 2 * SHM_K + NW * 64 * 4;
#define KSWZ(row, colB) ((row) * 128 + ((colB) ^ (((row) & 7) << 4)))
#define SBAR() __builtin_amdgcn_sched_barrier(0)
__device__ __forceinline__ int crow(int r, int hi) { return (r & 3) + 8 * (r >> 2) + 4 * hi; }
__device__ __forceinline__ unsigned cvtpkv(float lo, float hi) { unsigned r; asm volatile("v_cvt_pk_bf16_f32 %0, %1, %2" : "=v"(r) : "v"(lo), "v"(hi)); return r; }
__device__ __forceinline__ void partialSM(f32x16& p0, f32x16& p1, float& m_reg, float& mn, float& alpha) {
  constexpr float C = SCALE * 1.4426950408889634f;
  float pmax = p0[0]; for (int r = 1; r < 16; ++r) pmax = fmaxf(pmax, p0[r]); for (int r = 0; r < 16; ++r) pmax = fmaxf(pmax, p1[r]);
  { auto rr = __builtin_amdgcn_permlane32_swap(__float_as_uint(pmax), __float_as_uint(pmax), false, false);
    pmax = fmaxf(__uint_as_float(rr[0]), __uint_as_float(rr[1])); }
  if (__builtin_expect(__all(pmax - m_reg <= THR / SCALE), 1)) { mn = m_reg; alpha = 1.f; }
  else { mn = fmaxf(m_reg, pmax); alpha = __builtin_amdgcn_exp2f((m_reg - mn) * C); m_reg = mn; }
  float mnC = -mn * C;
  for (int r = 0; r < 16; ++r) p0[r] = fmaf(p0[r], C, mnC); for (int r = 0; r < 16; ++r) p1[r] = fmaf(p1[r], C, mnC);
  for (int r = 0; r < 16; ++r) p0[r] = __builtin_amdgcn_exp2f(p0[r]);
}
__device__ __forceinline__ void finishSM(f32x16& p0, f32x16& p1, float alpha, float& l_reg, bf16x8& pa0, bf16x8& pa1, bf16x8& pa2, bf16x8& pa3) {
  for (int r = 0; r < 16; ++r) p1[r] = __builtin_amdgcn_exp2f(p1[r]);
  float ps = 0; for (int r = 0; r < 16; ++r) ps += p0[r]; for (int r = 0; r < 16; ++r) ps += p1[r];
  { auto rr = __builtin_amdgcn_permlane32_swap(__float_as_uint(ps), __float_as_uint(ps), false, false);
    ps = __uint_as_float(rr[0]) + __uint_as_float(rr[1]); }
  l_reg = l_reg * alpha + ps;
#define PK4(P, BASE, OUT) do { unsigned a0 = cvtpkv(P[BASE + 0], P[BASE + 1]), a1 = cvtpkv(P[BASE + 2], P[BASE + 3]);   \
    unsigned b0 = cvtpkv(P[BASE + 4], P[BASE + 5]), b1 = cvtpkv(P[BASE + 6], P[BASE + 7]);                              \
    auto r0 = __builtin_amdgcn_permlane32_swap(a0, b0, false, false); auto r1 = __builtin_amdgcn_permlane32_swap(a1, b1, false, false); \
    u32x4 w = {r0[0], r1[0], r0[1], r1[1]}; OUT = *reinterpret_cast<bf16x8*>(&w); } while (0)
  PK4(p0, 0, pa0); PK4(p0, 8, pa1); PK4(p1, 0, pa2); PK4(p1, 8, pa3);
#undef PK4
}
__device__ __forceinline__ void qkt(f32x16& p0, f32x16& p1, const bf16_t* Ks, const bf16x8* qr, int r32, int hi) {
  p0 = f32x16{}; p1 = f32x16{};
#pragma unroll
  for (int d0 = 0; d0 < 4; ++d0) { int cb = (d0 * 16 + hi * 8) * 2;
    bf16x8 b0 = *reinterpret_cast<const bf16x8*>((const char*)Ks + KSWZ(r32, cb));
    bf16x8 b1 = *reinterpret_cast<const bf16x8*>((const char*)Ks + KSWZ(32 + r32, cb));
    p0 = __builtin_amdgcn_mfma_f32_32x32x16_bf16(b0, qr[d0], p0, 0, 0, 0);
    p1 = __builtin_amdgcn_mfma_f32_32x32x16_bf16(b1, qr[d0], p1, 0, 0, 0); }
}
__device__ __forceinline__ int v_st(int k, int c) { const int kk = (k & ~0xC) | ((k & 4) << 1) | ((k & 8) >> 1); return ((kk >> 3) * 4 + (c >> 5)) * 512 + ((kk & 7) * 32 + (c & 31)) * 2; }
__device__ __forceinline__ int v_rd_base(int lane) { return ((lane & 3) << 3) | (((lane >> 2) & 3) << 6) | (((lane >> 4) & 1) << 5) | (((lane >> 5) & 1) << 8); }
constexpr int v_rd_off(int d0, int ks, int half) { return d0 * 512 + ks * 4096 + half * 2048; }
template <int OFF> __device__ __forceinline__ s16x4 tr_read(int vb) {
  s16x4 r; asm volatile("ds_read_b64_tr_b16 %0, %1 offset:%2" : "=&v"(r) : "v"(vb), "i"(OFF) : "memory"); return r;
}
template <int D0> __device__ __forceinline__ void pv_one(f32x16& od, int vb, bf16x8 pa0, bf16x8 pa1, bf16x8 pa2, bf16x8 pa3) {
  const s16x4 l0 = tr_read<v_rd_off(D0, 0, 0)>(vb), h0 = tr_read<v_rd_off(D0, 0, 1)>(vb), l1 = tr_read<v_rd_off(D0, 1, 0)>(vb), h1 = tr_read<v_rd_off(D0, 1, 1)>(vb);
  const s16x4 l2 = tr_read<v_rd_off(D0, 2, 0)>(vb), h2 = tr_read<v_rd_off(D0, 2, 1)>(vb), l3 = tr_read<v_rd_off(D0, 3, 0)>(vb), h3 = tr_read<v_rd_off(D0, 3, 1)>(vb);
  asm volatile("s_waitcnt lgkmcnt(0)" ::: "memory"); SBAR();
#define PK(L, H) (bf16x8){L[0], L[1], L[2], L[3], H[0], H[1], H[2], H[3]}
  od = __builtin_amdgcn_mfma_f32_32x32x16_bf16(pa0, PK(l0, h0), od, 0, 0, 0);
  od = __builtin_amdgcn_mfma_f32_32x32x16_bf16(pa1, PK(l1, h1), od, 0, 0, 0);
  od = __builtin_amdgcn_mfma_f32_32x32x16_bf16(pa2, PK(l2, h2), od, 0, 0, 0);
  od = __builtin_amdgcn_mfma_f32_32x32x16_bf16(pa3, PK(l3, h3), od, 0, 0, 0);
#undef PK
}
__device__ __forceinline__ void pv_d0(f32x16* o, int vb, bf16x8 pa0, bf16x8 pa1, bf16x8 pa2, bf16x8 pa3) {
  pv_one<0>(o[0], vb, pa0, pa1, pa2, pa3); pv_one<1>(o[1], vb, pa0, pa1, pa2, pa3); pv_one<2>(o[2], vb, pa0, pa1, pa2, pa3); pv_one<3>(o[3], vb, pa0, pa1, pa2, pa3);
}
__device__ __forceinline__ void attn_body(const bf16_t* __restrict__ Qb, const bf16_t* __restrict__ Kh, const bf16_t* __restrict__ Vh, float* __restrict__ Ob, int seq, char* lds) {
  const int tid = otid(), wid = tid >> 6, lane = tid & 63, r32 = lane & 31, hi = lane >> 5;
  bf16_t* V_lds = (bf16_t*)lds; bf16_t* K_lds = (bf16_t*)(lds + 2 * SHM_V);
  float* ws = (float*)(lds + 2 * SHM_V + 2 * SHM_K) + wid * 64; float* li_l = ws; float* al_l = ws + 32;
  float m_reg = -1e30f, l_reg = 0; f32x16 o[4] = {}; bf16x8 qr[4];
  const bf16_t* Qw = Qb + (long)(wid * QBLK + r32) * LDQ + hi * 8;
#pragma unroll
  for (int d0 = 0; d0 < 4; ++d0) qr[d0] = *reinterpret_cast<const bf16x8*>(Qw + d0 * 16);
  const int sr = tid >> 4, sc = (tid & 15) * 8, vst0 = v_st(sr, sc), vst1 = v_st(32 + sr, sc);
  const int kr = tid >> 3, kc = (tid & 7) * 8, kst = KSWZ(kr, kc * 2);
  const int vb0 = (int)(uintptr_t)V_lds + v_rd_base(lane);
  struct { bf16x8 vs0, vs1, ks0; } sr_[2];
#define SLOAD(i, k0) do { sr_[i].vs0 = *reinterpret_cast<const bf16x8*>(&Vh[(long)((k0) + sr) * LDK + sc]); sr_[i].vs1 = *reinterpret_cast<const bf16x8*>(&Vh[(long)((k0) + 32 + sr) * LDK + sc]); \
    sr_[i].ks0 = *reinterpret_cast<const bf16x8*>(&Kh[(long)((k0) + kr) * LDK + kc]); } while (0)
#define SWRITE(b, i) do { *(bf16x8*)((char*)V_lds + (b) * SHM_V + vst0) = sr_[i].vs0;          \
    *(bf16x8*)((char*)V_lds + (b) * SHM_V + vst1) = sr_[i].vs1;                                  \
    *(bf16x8*)((char*)K_lds + (b) * SHM_K + kst) = sr_[i].ks0; } while (0)
#define SWAIT() asm volatile("s_waitcnt vmcnt(3)" ::: "memory")
#define RESC(a) do { if (__any((a) < 1.f)) { if (hi == 0) al_l[r32] = (a); asm volatile("s_waitcnt lgkmcnt(0)" ::: "memory"); \
    for (int d = 0; d < 4; ++d) for (int r = 0; r < 16; ++r) o[d][r] *= al_l[crow(r, hi)]; } } while (0)
  f32x16 pA0, pA1, pB0, pB1; float mnA, mnB, alA, alB; bf16x8 pa0, pa1, pa2, pa3; const int NT = seq / KVBLK;
  constexpr int SE = 0, SO = 1;
  SLOAD(SE, 0); asm volatile("s_waitcnt vmcnt(0)" ::: "memory"); SWRITE(0, SE); __syncthreads();
  qkt(pA0, pA1, K_lds, qr, r32, hi); partialSM(pA0, pA1, m_reg, mnA, alA);
  SLOAD(SO, KVBLK); if (2 < NT) SLOAD(SE, 2 * KVBLK);
  SWAIT(); SWRITE(1, SO); __syncthreads();
  for (int j = 1; j + 1 < NT; j += 2) {
    SBAR(); qkt(pB0, pB1, (bf16_t*)((char*)K_lds + SHM_K), qr, r32, hi);
    finishSM(pA0, pA1, alA, l_reg, pa0, pa1, pa2, pa3); SBAR();
    SLOAD(SO, (j + 2) * KVBLK); SBAR();
    pv_d0(o, vb0, pa0, pa1, pa2, pa3); partialSM(pB0, pB1, m_reg, mnB, alB);
    __syncthreads(); SWAIT(); SWRITE(0, SE);
    RESC(alB); __syncthreads();
    SBAR(); qkt(pA0, pA1, K_lds, qr, r32, hi);
    finishSM(pB0, pB1, alB, l_reg, pa0, pa1, pa2, pa3); SBAR();
    if (j + 3 < NT) SLOAD(SE, (j + 3) * KVBLK); SBAR();
    pv_d0(o, vb0 + (int)SHM_V, pa0, pa1, pa2, pa3); partialSM(pA0, pA1, m_reg, mnA, alA);
    __syncthreads(); SWAIT(); SWRITE(1, SO);
    RESC(alA); __syncthreads();
  }
  SBAR(); qkt(pB0, pB1, (bf16_t*)((char*)K_lds + SHM_K), qr, r32, hi);
  finishSM(pA0, pA1, alA, l_reg, pa0, pa1, pa2, pa3); SBAR();
  pv_d0(o, vb0, pa0, pa1, pa2, pa3); partialSM(pB0, pB1, m_reg, mnB, alB);
  __syncthreads(); RESC(alB);
  finishSM(pB0, pB1, alB, l_reg, pa0, pa1, pa2, pa3); SBAR();
  pv_d0(o, vb0 + (int)SHM_V, pa0, pa1, pa2, pa3);
  if (hi == 0) li_l[r32] = l_reg; asm volatile("s_waitcnt lgkmcnt(0)" ::: "memory");
  float rli[16];
#pragma unroll
  for (int r = 0; r < 16; ++r) rli[r] = __builtin_amdgcn_rcpf(li_l[crow(r, hi)]);
  float* Ow = Ob + (long)(wid * QBLK) * LDO;
#pragma unroll
  for (int r = 0; r < 16; ++r) { int orow = crow(r, hi);
    for (int d0 = 0; d0 < 4; ++d0) Ow[(long)orow * LDO + d0 * 32 + r32] = o[d0][r] * rli[r]; }
#undef SLOAD
#undef SWRITE
#undef SWAIT
#undef RESC
}
}

__device__ __forceinline__ int hcrow(int r, int hi) { return (r & 3) + 8 * (r >> 2) + 4 * hi; }
__device__ __forceinline__ void hgrn_unit(const Args& a, LAS unsigned char* lds, int unit) {
    const int tid = otid(), w = __builtin_amdgcn_readfirstlane(tid >> 6), lane = tid & 63, r32 = lane & 31, hi = lane >> 5;
    const int dir = unit & 1, h = (unit >> 1) & 7, b = unit >> 4;
    constexpr int PQ = 136, PS = 72;
    LAS bf16_t* Qt = (LAS bf16_t*)lds;
    LAS bf16_t* Kt = Qt + 64 * PQ;
    LAS bf16_t* KhT = Kt + 64 * PQ;
    LAS bf16_t* Vt = KhT + 128 * PS;
    LAS bf16_t* At = Vt + 128 * PS;
    LAS bf16_t* St = At + 64 * PS;
    LAS float* part = (LAS float*)(St + 128 * PQ);
    LAS float* dec = part + 8 * 128;
    const bf16_t* MP = (const bf16_t*)(a.ws + WS_MP);
    float* OREC = (float*)(a.ws + WS_OREC) + (size_t)dir * ML * 1024;
    const int kp = lane;
    float lb[2];
#pragma unroll
    for (int j = 0; j < 2; ++j) { const float a0 = a.in[I_RLB][(dir * 2 + 0) * 1024 + h * 128 + 2 * kp + j], a1 = a.in[I_RLB][(dir * 2 + 1) * 1024 + h * 128 + 2 * kp + j];
        lb[j] = 1.f / (1.f + __expf(a1 - a0)); }
    __syncthreads();
    for (int i = tid; i < 128 * PQ / 2; i += 512) ((LAS unsigned*)St)[i] = 0u;
    f32x16 S[2] = {};
    unsigned q2[8], z2[8], v2[8];
    const int zcol = (dir ? 5120 : 4096) + h * 128 + 2 * kp, qcol = 3072 + h * 128 + 2 * kp, vcol = 6144 + h * 128 + 2 * kp;
#define HG_ROWBASE(c) (b * RS + (dir ? ((c) < 4 ? 192 - 64 * (c) : RS - 64 * ((c) - 3)) : 64 * (c)))
#define HG_LOAD(c) do { const int rb_ = HG_ROWBASE(c); _Pragma("unroll") for (int e = 0; e < 8; ++e) { const int tau = 8 * w + e, rr = dir ? 63 - tau : tau; \
        const bf16_t* rp = MP + (size_t)(rb_ + rr) * MIXIN; q2[e] = *(const unsigned*)(rp + qcol); z2[e] = *(const unsigned*)(rp + zcol); v2[e] = *(const unsigned*)(rp + vcol); } } while (0)
    HG_LOAD(0);
    const int ti = w >> 2, vi = w & 3, ki = w >> 1, vi0 = 2 * (w & 1);
    for (int c = 0; c < 36; ++c) {
        const int rowbase = HG_ROWBASE(c);
        float Pl[8][2], fk[8][2]; float p0 = 1.f, p1 = 1.f;
#pragma unroll
        for (int e = 0; e < 8; ++e) {
            const float f0 = lb[0] + (1.f - lb[0]) * sigmoidf_(bflo(z2[e])), f1 = lb[1] + (1.f - lb[1]) * sigmoidf_(bfhi(z2[e]));
            p0 *= f0; p1 *= f1; Pl[e][0] = p0; Pl[e][1] = p1; fk[e][0] = 1.f - f0; fk[e][1] = 1.f - f1;
        }
        *(LAS f32x2*)(part + w * 128 + 2 * kp) = (f32x2){p0, p1};
        __syncthreads();
        float off0 = 1.f, off1 = 1.f, tot0 = 1.f, tot1 = 1.f;
#pragma unroll
        for (int x = 0; x < 8; ++x) { const f32x2 pp = *(LAS f32x2*)(part + x * 128 + 2 * kp); tot0 *= pp[0]; tot1 *= pp[1]; if (x < w) { off0 *= pp[0]; off1 *= pp[1]; } }
        unsigned kh0[4], kh1[4], vt0[4], vt1[4];
        float kha[8][2];
#pragma unroll
        for (int e = 0; e < 8; ++e) {
            const int tau = 8 * w + e;
            const float P0 = fmaxf(off0 * Pl[e][0], 1e-35f), P1 = fmaxf(off1 * Pl[e][1], 1e-35f);
            const float i0 = __builtin_amdgcn_rcpf(P0), i1 = __builtin_amdgcn_rcpf(P1);
            const float qs0 = bflo(q2[e]) * 0.08838834764831845f * P0, qs1 = bfhi(q2[e]) * 0.08838834764831845f * P1;
            const float kt0 = fk[e][0] * i0, kt1 = fk[e][1] * i1;
            kha[e][0] = kt0 * tot0; kha[e][1] = kt1 * tot1;
            *(LAS unsigned*)(Qt + tau * PQ + 2 * kp) = cvtpk(qs0, qs1);
            *(LAS unsigned*)(Kt + tau * PQ + 2 * kp) = cvtpk(kt0, kt1);
        }
#pragma unroll
        for (int e = 0; e < 4; ++e) { kh0[e] = cvtpk(kha[2 * e][0], kha[2 * e + 1][0]); kh1[e] = cvtpk(kha[2 * e][1], kha[2 * e + 1][1]);
            vt0[e] = (v2[2 * e] & 0xffffu) | (v2[2 * e + 1] << 16); vt1[e] = (v2[2 * e] >> 16) | (v2[2 * e + 1] & 0xffff0000u); }
        *(LAS u32x4*)(KhT + (2 * kp) * PS + 8 * w) = (u32x4){kh0[0], kh0[1], kh0[2], kh0[3]};
        *(LAS u32x4*)(KhT + (2 * kp + 1) * PS + 8 * w) = (u32x4){kh1[0], kh1[1], kh1[2], kh1[3]};
        *(LAS u32x4*)(Vt + (2 * kp) * PS + 8 * w) = (u32x4){vt0[0], vt0[1], vt0[2], vt0[3]};
        *(LAS u32x4*)(Vt + (2 * kp + 1) * PS + 8 * w) = (u32x4){vt1[0], vt1[1], vt1[2], vt1[3]};
        if (w == 0) *(LAS f32x2*)(dec + 2 * kp) = (f32x2){tot0, tot1};
        if (c + 1 < 36) HG_LOAD(c + 1);
        __syncthreads();
        const bool outc = c >= 4;
        f32x16 o = {};
        if (outc) {
#pragma unroll
            for (int j = 0; j < 8; ++j) { const bf16x8 A = *(const LAS bf16x8*)(Qt + (32 * ti + r32) * PQ + 16 * j + 8 * hi), B = *(const LAS bf16x8*)(St + (32 * vi + r32) * PQ + 16 * j + 8 * hi);
                o = __builtin_amdgcn_mfma_f32_32x32x16_bf16(A, B, o, 0, 0, 0); }
            if (w < 4) {
                const int ta = w >> 1, sa = w & 1;
                f32x16 acc = {};
                if (sa <= ta) {
#pragma unroll
                    for (int j = 0; j < 8; ++j) { const bf16x8 A = *(const LAS bf16x8*)(Qt + (32 * ta + r32) * PQ + 16 * j + 8 * hi), B = *(const LAS bf16x8*)(Kt + (32 * sa + r32) * PQ + 16 * j + 8 * hi);
                        acc = __builtin_amdgcn_mfma_f32_32x32x16_bf16(A, B, acc, 0, 0, 0); }
                }
#pragma unroll
                for (int i = 0; i < 16; ++i) { const int t = 32 * ta + hcrow(i, hi), s = 32 * sa + r32; const float v = (s <= t) ? acc[i] : 0.f;
                    At[t * PS + s] = (bf16_t)(cvtpk(v, 0.f) & 0xffffu); }
            }
        }
#pragma unroll
        for (int x = 0; x < 2; ++x) {
#pragma unroll
            for (int i = 0; i < 16; ++i) S[x][i] *= dec[32 * ki + hcrow(i, hi)];
#pragma unroll
            for (int j = 0; j < 4; ++j) { const bf16x8 A = *(const LAS bf16x8*)(KhT + (32 * ki + r32) * PS + 16 * j + 8 * hi), B = *(const LAS bf16x8*)(Vt + (32 * (vi0 + x) + r32) * PS + 16 * j + 8 * hi);
                S[x] = __builtin_amdgcn_mfma_f32_32x32x16_bf16(A, B, S[x], 0, 0, 0); }
        }
        __syncthreads();
        if (outc) {
#pragma unroll
            for (int j = 0; j < 4; ++j) { const bf16x8 A = *(const LAS bf16x8*)(At + (32 * ti + r32) * PS + 16 * j + 8 * hi), B = *(const LAS bf16x8*)(Vt + (32 * vi + r32) * PS + 16 * j + 8 * hi);
                o = __builtin_amdgcn_mfma_f32_32x32x16_bf16(A, B, o, 0, 0, 0); }
#pragma unroll
            for (int i = 0; i < 16; ++i) { const int tau = 32 * ti + hcrow(i, hi), rr = dir ? 63 - tau : tau; const int lrow = rowbase + rr - 256 * (b + 1);
                OREC[(size_t)lrow * 1024 + h * 128 + 32 * vi + r32] = o[i]; }
        }
#pragma unroll
        for (int x = 0; x < 2; ++x)
#pragma unroll
            for (int g = 0; g < 4; ++g) { const int k0 = 32 * ki + 8 * g + 4 * hi;
                *(LAS u32x2*)(St + (32 * (vi0 + x) + r32) * PQ + k0) = (u32x2){cvtpk(S[x][4 * g], S[x][4 * g + 1]), cvtpk(S[x][4 * g + 2], S[x][4 * g + 3])}; }
    }
    __syncthreads();
#undef HG_LOAD
#undef HG_ROWBASE
}

__device__ __forceinline__ void transpose_item(const float* __restrict__ src, int ldn, int k0, int n0, bf16_t* __restrict__ dst, int Kd, int drow, LAS float* scr, int lane) {
    const int cl = (lane & 15) * 4, ks = lane >> 4;
    f32x4 v[16];
#pragma unroll
    for (int i = 0; i < 16; ++i) v[i] = __builtin_nontemporal_load((const f32x4*)(src + (size_t)(k0 + 4 * i + ks) * ldn + n0 + cl));
#pragma unroll
    for (int i = 0; i < 16; ++i) { LAS float* s = scr + (4 * i + ks) * 65 + cl; s[0] = v[i][0]; s[1] = v[i][1]; s[2] = v[i][2]; s[3] = v[i][3]; }
    asm volatile("s_waitcnt lgkmcnt(0)" ::: "memory");
    const int c = lane & 7;
#pragma unroll
    for (int j = 0; j < 8; ++j) { const int n = (lane >> 3) + 8 * j; const LAS float* s = scr + (8 * c) * 65 + n;
        u32x4 o; o.x = cvtpk(s[0 * 65], s[1 * 65]); o.y = cvtpk(s[2 * 65], s[3 * 65]); o.z = cvtpk(s[4 * 65], s[5 * 65]); o.w = cvtpk(s[6 * 65], s[7 * 65]);
        __builtin_nontemporal_store(o, (u32x4*)(dst + (size_t)(drow + n) * Kd + k0 + 8 * c)); }
    asm volatile("s_waitcnt lgkmcnt(0)" ::: "memory");
}
constexpr int T_FFN = 12 * 2752, T_MI = 4096, T_SQ = 1024, T_CI = 3072, T_ALL = T_FFN + T_MI + 2 * T_SQ + T_CI;
__device__ __forceinline__ void convert_item(const Args& a, int it, LAS float* scr, int lane) {
    bf16_t* WGU = (bf16_t*)(a.ws + WS_WGU); bf16_t* WD = (bf16_t*)(a.ws + WS_WD);
        const float* src; int ldn, k0, n0, Kd, drow; bf16_t* dst;
        if (it < T_FFN) { const int m = it / 2752, r = it % 2752, f = m / 3, kind = m % 3;
            if (kind < 2) { k0 = (r / 86) * 64; n0 = (r % 86) * 64; src = a.in[kind ? I_WU : I_WG] + (size_t)f * DM * DFF; ldn = DFF; Kd = DM; dst = WGU + (size_t)f * 2 * DFF * DM; drow = (n0 >> 7) * 256 + kind * 128 + (n0 & 127); }
            else { k0 = (r / 32) * 64; n0 = (r % 32) * 64; src = a.in[I_WDN] + (size_t)f * DFF * DM; ldn = DM; Kd = DFF; dst = WD + (size_t)f * DM * DFF; drow = n0; }
        } else if (it < T_FFN + T_MI) { const int r = it - T_FFN; k0 = (r / 128) * 64; n0 = (r % 128) * 64; src = a.in[I_MIXIN]; ldn = MIXIN; Kd = DM; dst = (bf16_t*)(a.ws + WS_WMI); drow = n0; }
        else if (it < T_FFN + T_MI + T_SQ) { const int r = it - T_FFN - T_MI; k0 = (r / 32) * 64; n0 = (r % 32) * 64; src = a.in[I_MIXOUT]; ldn = DM; Kd = DM; dst = (bf16_t*)(a.ws + WS_WMO); drow = n0; }
        else if (it < T_FFN + T_MI + 2 * T_SQ) { const int r = it - T_FFN - T_MI - T_SQ; k0 = (r / 32) * 64; n0 = (r % 32) * 64; src = a.in[I_CWOUT]; ldn = DM; Kd = DM; dst = (bf16_t*)(a.ws + WS_WCO); drow = n0; }
        else { const int r = it - T_FFN - T_MI - 2 * T_SQ; k0 = (r / 96) * 64; n0 = (r % 96) * 64; src = a.in[I_CWIN]; ldn = 3 * DM; Kd = DM; dst = (bf16_t*)(a.ws + WS_WCI);
            if (n0 < DM) drow = n0; else if (n0 < 2 * DM) { const int j = n0 - DM; drow = DM + (j >> 7) * 256 + (j & 127); } else { const int j = n0 - 2 * DM; drow = DM + (j >> 7) * 256 + 128 + (j & 127); } }
        transpose_item(src, ldn, k0, n0, dst, Kd, drow, scr, lane);
}
#ifndef NSTEAL
#define NSTEAL 4
#endif
__device__ __forceinline__ void convert_steal(const Args& a, LAS unsigned char* lds, unsigned* ctr, int lo1, int n1, int lo2, int n2) {
    const int tid = otid(), w = __builtin_amdgcn_readfirstlane(tid >> 6), lane = tid & 63;
    LAS float* scr = (LAS float*)lds + w * (64 * 65);
    volatile LAS int* bc = (volatile LAS int*)(lds + LDS_BYTES - 32);
    const int n = n1 + n2;
    for (;;) {
        __syncthreads();
        if (tid == 0) bc[0] = (int)__hip_atomic_fetch_add(ctr, (unsigned)NSTEAL, __ATOMIC_RELAXED, __HIP_MEMORY_SCOPE_AGENT);
        __syncthreads();
        const int base = bc[0];
        if (base >= n) break;
        const int j = base + w;
        if (w < NSTEAL && j < n) convert_item(a, j < n1 ? lo1 + j : lo2 + (j - n1), scr, lane);
    }
}
__device__ __forceinline__ void gemv_fill(const Args& a, LAS unsigned char* lds) {
    LAS float* sc = (LAS float*)lds;
    for (int i = otid(); i < 5 * 2048; i += 512) { const float v = i < 8192 ? a.in[I_C][i] : a.in[I_CCTX][i - 8192]; sc[i] = siluf_(v); }
    __syncthreads();
}
__device__ __forceinline__ void gemv_item(const Args& a, LAS unsigned char* lds, int it) {
    const int tid = otid(), w = __builtin_amdgcn_readfirstlane(tid >> 6), lane = tid & 63;
    LAS float* sc = (LAS float*)lds; LAS float* red = sc + 5 * 2048;
    float* MOD = (float*)(a.ws + WS_MOD);
    const int l = it / 288, n0 = (it % 288) * 64, cl = (lane & 15) * 4, ks = lane >> 4;
    const float* W = a.in[I_ADAW] + (size_t)l * DM * MODW + n0 + cl;
    f32x4 acc[5] = {};
#pragma unroll 8
    for (int kk = 0; kk < 256; kk += 4) { const int k = w * 256 + kk + ks; const f32x4 wv = __builtin_nontemporal_load((const f32x4*)(W + (size_t)k * MODW));
#pragma unroll
        for (int i = 0; i < 5; ++i) acc[i] += wv * sc[i * 2048 + k]; }
#pragma unroll
    for (int i = 0; i < 5; ++i)
#pragma unroll
        for (int e = 0; e < 4; ++e) { float v = acc[i][e]; v += __shfl_xor(v, 16); v += __shfl_xor(v, 32); acc[i][e] = v; }
    if (lane < 16) {
#pragma unroll
        for (int i = 0; i < 5; ++i) *(LAS f32x4*)(red + (w * 5 + i) * 64 + cl) = acc[i]; }
    __syncthreads();
    if (tid < 320) { const int i = tid >> 6, cc = tid & 63; float s = a.in[I_ADAB][l * MODW + n0 + cc];
#pragma unroll
        for (int x = 0; x < 8; ++x) s += red[(x * 5 + i) * 64 + cc];
        MOD[((size_t)l * 5 + i) * MODW + n0 + cc] = s; }
    __syncthreads();
}
__device__ __forceinline__ void gemv_steal(const Args& a, LAS unsigned char* lds, unsigned* ctr, int lo, int n) {
    volatile LAS int* bc = (volatile LAS int*)(lds + LDS_BYTES - 32);
    bool filled = false;
    for (;;) {
        __syncthreads();
        if (otid() == 0) bc[0] = (int)__hip_atomic_fetch_add(ctr, 1u, __ATOMIC_RELAXED, __HIP_MEMORY_SCOPE_AGENT);
        __syncthreads();
        const int j = bc[0];
        if (j >= n) break;
        if (!filled) { gemv_fill(a, lds); filled = true; }
        gemv_item(a, lds, lo + j);
    }
}
__device__ __forceinline__ void phase0(const Args& a, LAS unsigned char* lds, int G) {
    const int tid = otid(), w = __builtin_amdgcn_readfirstlane(tid >> 6), lane = tid & 63, bid = obid();
    { const int id = bid * 512 + tid; if (id < 1024) { const int pos = id >> 4, i = id & 15; const float fr = __builtin_amdgcn_exp2f(-(float)i * (13.287712379549449f / 16.f)); const float ang = (float)pos * fr;
        ((f32x2*)(a.ws + WS_ROPE))[id] = (f32x2){__cosf(ang), __sinf(ang)}; } }
    gemv_fill(a, lds);
    for (int it = bid; it < 288; it += G) gemv_item(a, lds, it);
    LAS float* scr = (LAS float*)lds + w * (64 * 65);
    for (int it = bid * 8 + w; it < 2 * 2752; it += G * 8) convert_item(a, it, scr, lane);
}

struct RowP { const bf16_t* xinb; bf16_t* xoutb; const bf16_t* y; const float* xin; const float* ctxin; float* xout; bf16_t* h; int modeR; float wgt; const float* modg; int gidx; const float* gpost; const float* modh; int sidx; const float* gpre; int has_y, has_h; };
__device__ __forceinline__ void row_phase(const RowP& p, int G) {
    const int tid = otid(), w = tid >> 6, lane = tid & 63;
    const int nrows = p.modeR ? MR : ML;
    for (int r0 = (obid() * 8 + w) * 2; r0 < nrows; r0 += G * 16) {
        int mi; const float* xrow; float* xo; size_t lrow = 0;
        if (p.modeR) { const int b = r0 / RS, s = r0 % RS; if (s < CTX) { mi = 4; xrow = p.ctxin + (size_t)(b * CTX + s) * DM; xo = nullptr; } else { mi = b; lrow = (size_t)(b * SEQ + s - CTX); xrow = p.xin + lrow * DM; xo = p.xout; } }
        else { mi = r0 / SEQ; lrow = (size_t)r0; xrow = p.xin + lrow * DM; xo = p.xout; }
        const bool isctx = p.modeR && mi == 4;
        f32x4 xv[2][4][2]; u32x4 yv[2][4];
        if (p.xinb && !isctx) {
#pragma unroll
            for (int q = 0; q < 2; ++q)
#pragma unroll
                for (int j = 0; j < 4; ++j) { const u32x4 xx = *(const u32x4*)(p.xinb + (lrow + q) * DM + 8 * lane + 512 * j);
                    xv[q][j][0] = (f32x4){bflo(xx[0]), bfhi(xx[0]), bflo(xx[1]), bfhi(xx[1])}; xv[q][j][1] = (f32x4){bflo(xx[2]), bfhi(xx[2]), bflo(xx[3]), bfhi(xx[3])}; }
        } else {
#pragma unroll
            for (int q = 0; q < 2; ++q)
#pragma unroll
                for (int j = 0; j < 4; ++j) { const float* xp = xrow + (size_t)q * DM + 8 * lane + 512 * j; xv[q][j][0] = *(const f32x4*)xp; xv[q][j][1] = *(const f32x4*)(xp + 4); }
        }
        if (p.has_y) {
#pragma unroll
            for (int q = 0; q < 2; ++q)
#pragma unroll
                for (int j = 0; j < 4; ++j) yv[q][j] = *(const u32x4*)(p.y + (size_t)(r0 + q) * DM + 8 * lane + 512 * j);
            float ss[2] = {0.f, 0.f};
#pragma unroll
            for (int q = 0; q < 2; ++q)
#pragma unroll
                for (int j = 0; j < 4; ++j)
#pragma unroll
                    for (int e = 0; e < 4; ++e) { const float a = bflo(yv[q][j][e]), b = bfhi(yv[q][j][e]); ss[q] += a * a + b * b; }
            const float ry0 = rsqrtf(wave_sum(ss[0]) * (1.f / DM) + EPS) * p.wgt, ry1 = rsqrtf(wave_sum(ss[1]) * (1.f / DM) + EPS) * p.wgt;
            const float* gate = p.modg + (size_t)mi * MODW + p.gidx * DM;
#pragma unroll
            for (int j = 0; j < 4; ++j) { const int c = 8 * lane + 512 * j;
                const f32x4 gt0 = *(const f32x4*)(gate + c) * *(const f32x4*)(p.gpost + c), gt1 = *(const f32x4*)(gate + c + 4) * *(const f32x4*)(p.gpost + c + 4);
#pragma unroll
                for (int q = 0; q < 2; ++q) { const float ry = q ? ry1 : ry0; const u32x4 yy = yv[q][j];
                    const f32x4 y0 = {bflo(yy[0]), bfhi(yy[0]), bflo(yy[1]), bfhi(yy[1])}, y1 = {bflo(yy[2]), bfhi(yy[2]), bflo(yy[3]), bfhi(yy[3])};
                    xv[q][j][0] = xv[q][j][0] + gt0 * (y0 * ry); xv[q][j][1] = xv[q][j][1] + gt1 * (y1 * ry);
                    if (!isctx) { if (p.xoutb) *(u32x4*)(p.xoutb + (lrow + q) * DM + c) = (u32x4){cvtpk(xv[q][j][0][0], xv[q][j][0][1]), cvtpk(xv[q][j][0][2], xv[q][j][0][3]), cvtpk(xv[q][j][1][0], xv[q][j][1][1]), cvtpk(xv[q][j][1][2], xv[q][j][1][3])};
                                  else { float* op = xo + (lrow + q) * DM + c; *(f32x4*)op = xv[q][j][0]; *(f32x4*)(op + 4) = xv[q][j][1]; } } } }
        }
        if (p.has_h) {
            float ss[2] = {0.f, 0.f};
#pragma unroll
            for (int q = 0; q < 2; ++q)
#pragma unroll
                for (int j = 0; j < 4; ++j)
#pragma unroll
                    for (int k = 0; k < 2; ++k) { const f32x4 v = xv[q][j][k]; ss[q] += (v[0] * v[0] + v[1] * v[1]) + (v[2] * v[2] + v[3] * v[3]); }
            const float rx0 = rsqrtf(wave_sum(ss[0]) * (1.f / DM) + EPS), rx1 = rsqrtf(wave_sum(ss[1]) * (1.f / DM) + EPS);
            const float* sh = p.modh + (size_t)mi * MODW + p.sidx * DM; const float* scl = sh + DM;
#pragma unroll
            for (int j = 0; j < 4; ++j) { const int c = 8 * lane + 512 * j;
                const f32x4 m0 = *(const f32x4*)(p.gpre + c) * (*(const f32x4*)(scl + c) + 1.f), m1 = *(const f32x4*)(p.gpre + c + 4) * (*(const f32x4*)(scl + c + 4) + 1.f);
                const f32x4 s0 = *(const f32x4*)(sh + c), s1 = *(const f32x4*)(sh + c + 4);
#pragma unroll
                for (int q = 0; q < 2; ++q) { const float rx = q ? rx1 : rx0;
                    const f32x4 h0 = (xv[q][j][0] * rx) * m0 + s0, h1 = (xv[q][j][1] * rx) * m1 + s1;
                    *(u32x4*)(p.h + (size_t)(r0 + q) * DM + c) = (u32x4){cvtpk(h0[0], h0[1]), cvtpk(h0[2], h0[3]), cvtpk(h1[0], h1[1]), cvtpk(h1[2], h1[3])}; } }
        }
    }
}

__device__ __forceinline__ float half_sum(float v) {
#pragma unroll
    for (int o = 1; o < 32; o <<= 1) v += __shfl_xor(v, o);
    return v;
}
__device__ __forceinline__ void merge_phase(const Args& a, int G) {
    const int tid = otid(), w = tid >> 6, lane = tid & 63, l32 = lane & 31, hsel = lane >> 5;
    const float* dl = a.in[I_DLAM];
    const float s01 = wave_sum(dl[lane] * dl[64 + lane]), s23 = wave_sum(dl[128 + lane] * dl[192 + lane]);
    const float lam = __expf(s01) - __expf(s23) + 0.2f;
    const float* OA = (const float*)(a.ws + WS_OATT); const float* OR = (const float*)(a.ws + WS_OREC); const bf16_t* MP = (const bf16_t*)(a.ws + WS_MP); bf16_t* MG = (bf16_t*)(a.ws + WS_MG);
    const f32x4 ga = *(const f32x4*)(a.in[I_DNG] + 4 * l32) * 0.8f, gr = *(const f32x4*)(a.in[I_RNG] + 4 * l32);
    for (int lr = obid() * 8 + w; lr < ML; lr += G * 8) {
        const int b = lr / SEQ; const size_t rrow = (size_t)(lr + 256 * (b + 1));
        f32x4 o1[4], o2[4], of[4], ob[4]; u32x2 gw[4];
#pragma unroll
        for (int hp = 0; hp < 4; ++hp) { const size_t c0 = (size_t)lr * 1024 + (2 * hp + hsel) * 128 + 4 * l32;
            o1[hp] = *(const f32x4*)(OA + c0); o2[hp] = *(const f32x4*)(OA + (size_t)ML * 1024 + c0);
            of[hp] = *(const f32x4*)(OR + c0); ob[hp] = *(const f32x4*)(OR + (size_t)ML * 1024 + c0);
            gw[hp] = *(const u32x2*)(MP + rrow * MIXIN + 7168 + (2 * hp + hsel) * 128 + 4 * l32); }
#pragma unroll
        for (int hp = 0; hp < 4; ++hp) { const int c0 = (2 * hp + hsel) * 128 + 4 * l32;
            const f32x4 d = o1[hp] - o2[hp] * lam; const float r = rsqrtf(half_sum((d[0] * d[0] + d[1] * d[1]) + (d[2] * d[2] + d[3] * d[3])) * (1.f / 128.f) + EPS);
            const f32x4 x = d * r * ga;
            *(u32x2*)(MG + (size_t)lr * DM + c0) = (u32x2){cvtpk(x[0], x[1]), cvtpk(x[2], x[3])};
            const f32x4 o = of[hp] + ob[hp]; const float rr = rsqrtf(half_sum((o[0] * o[0] + o[1] * o[1]) + (o[2] * o[2] + o[3] * o[3])) * (1.f / 128.f) + EPS);
            const f32x4 g = {siluf_(bflo(gw[hp][0])), siluf_(bfhi(gw[hp][0])), siluf_(bflo(gw[hp][1])), siluf_(bfhi(gw[hp][1]))};
            const f32x4 y = o * rr * gr * g;
            *(u32x2*)(MG + (size_t)lr * DM + 1024 + c0) = (u32x2){cvtpk(y[0], y[1]), cvtpk(y[2], y[3])}; }
    }
}

__device__ __forceinline__ void conv_phase(const Args& a, int G) {
    const bf16_t* BG = (const bf16_t*)(a.ws + WS_MP); const bf16_t* CV = BG + (size_t)ML * DM; bf16_t* MG = (bf16_t*)(a.ws + WS_MG); const float* cw = a.in[I_CW];
    const int tid = otid(), c = (tid & 255) * 8, rh = tid >> 8;
    f32x4 w0[2], w1[2], w2[2];
#pragma unroll
    for (int k = 0; k < 2; ++k) { w0[k] = *(const f32x4*)(cw + c + 4 * k); w1[k] = *(const f32x4*)(cw + DM + c + 4 * k); w2[k] = *(const f32x4*)(cw + 2 * DM + c + 4 * k); }
    const u32x4 z = {0u, 0u, 0u, 0u};
    for (int it = obid(); it < ML / 16; it += G) {
        const int r0 = it * 16 + rh * 8;
        const int t0 = r0 & (SEQ - 1);
        u32x4 prev = t0 > 0 ? *(const u32x4*)(CV + (size_t)(r0 - 1) * DM + c) : z;
        u32x4 cur = *(const u32x4*)(CV + (size_t)r0 * DM + c);
#pragma unroll
        for (int i = 0; i < 8; ++i) {
            const int lr = r0 + i;
            const u32x4 nxt = (t0 + i < SEQ - 1) ? *(const u32x4*)(CV + (size_t)(lr + 1) * DM + c) : z;
            const u32x4 bg = *(const u32x4*)(BG + (size_t)lr * DM + c);
            u32x4 o;
#pragma unroll
            for (int e = 0; e < 4; ++e) { const int k = e >> 1, q = (e & 1) * 2;
                const float lo = bflo(bg[e]) * (w0[k][q] * bflo(prev[e]) + w1[k][q] * bflo(cur[e]) + w2[k][q] * bflo(nxt[e]));
                const float hi = bfhi(bg[e]) * (w0[k][q + 1] * bfhi(prev[e]) + w1[k][q + 1] * bfhi(cur[e]) + w2[k][q + 1] * bfhi(nxt[e]));
                o[e] = cvtpk(lo, hi); }
            *(u32x4*)(MG + (size_t)lr * DM + c) = o;
            prev = cur; cur = nxt;
        }
    }
}

#define XB_TMO      128
#define XB_XCNT(j)  (256  + 64 * (j))
#define XB_XSUB(j)  (1280 + 64 * (j))
#define XB_XGEN(j)  (2304 + 64 * (j))
#define XB_TOP      3328
#define XB_TOPGEN   3392
#define XCD_BAR_WORDS 3456
#define XB_SPIN_CAP (1u << 18)

__device__ __forceinline__ unsigned xb_ld(unsigned* p)              { return __hip_atomic_load(p, __ATOMIC_RELAXED, __HIP_MEMORY_SCOPE_AGENT); }
__device__ __forceinline__ unsigned xb_add(unsigned* p, unsigned v) { return __hip_atomic_fetch_add(p, v, __ATOMIC_RELAXED, __HIP_MEMORY_SCOPE_AGENT); }
__device__ __forceinline__ unsigned xb_xcc_id() { return (unsigned)__builtin_amdgcn_s_getreg((3 << 11) | 20) & 0xFu; }
#define XB_SPIN(cond, bar) do { unsigned _sp = 0; while (cond) { __builtin_amdgcn_s_sleep(1); \
    if ((++_sp & 255u) == 0u) { if (xb_ld(&(bar)[XB_TMO])) break; if (_sp > XB_SPIN_CAP) { atomicAdd(&(bar)[XB_TMO], 1u); break; } } } } while (0)

struct XcdBarrier {
    unsigned* bar; unsigned x;
    volatile LAS unsigned* st;
};

__device__ __forceinline__ XcdBarrier xcd_barrier_post(unsigned* bar, volatile LAS unsigned* st) {
    XcdBarrier b; b.bar = bar; b.x = xb_xcc_id(); b.st = st;
    if (threadIdx.x == 0) (void)xb_add(&bar[XB_XCNT(b.x)], 1u);
    return b;
}
__device__ __forceinline__ void xcd_barrier_complete(unsigned* bar, unsigned x, unsigned& nloc, unsigned& nx) {
    const unsigned G = gridDim.x * gridDim.y * gridDim.z;
    unsigned sum, cnt, mine, sp = 0u;
    for (;;) {
        sum = 0u; cnt = 0u; mine = 0u;
#pragma unroll
        for (unsigned j = 0; j < 16; ++j) { const unsigned c = xb_ld(&bar[XB_XCNT(j)]); sum += c; cnt += (c > 0u) ? 1u : 0u; mine = (j == x) ? c : mine; }
        if (sum == G) break;
        __builtin_amdgcn_s_sleep(1);
        if ((++sp & 255u) == 0u) { if (xb_ld(&bar[XB_TMO])) break; if (sp > XB_SPIN_CAP) { atomicAdd(&bar[XB_TMO], 1u); break; } }
    }
    nloc = mine > 0u ? mine : 1u; nx = cnt > 0u ? cnt : 1u;
}

__device__ __forceinline__ void xcd_barrier(const XcdBarrier& b) {
    asm volatile("s_waitcnt vmcnt(0)" ::: "memory");
    __syncthreads();
    if (threadIdx.x == 0) {
        unsigned* bar = b.bar;
        __builtin_amdgcn_s_waitcnt(0);
        unsigned nloc = b.st[0], nx = b.st[1];
        if (nloc == 0u) { xcd_barrier_complete(bar, b.x, nloc, nx); b.st[0] = nloc; b.st[1] = nx; }
        const unsigned old = xb_add(&bar[XB_XSUB(b.x)], 1u);
        const unsigned gen = old / nloc;
        if (old + 1u == (gen + 1u) * nloc) {
            __builtin_amdgcn_fence(__ATOMIC_RELEASE, "agent");
            asm volatile("s_waitcnt vmcnt(0)" ::: "memory");
            const unsigned og = xb_add(&bar[XB_TOP], 1u);
            const unsigned tg = og / nx;
            if (og + 1u == (tg + 1u) * nx) xb_add(&bar[XB_TOPGEN], 1u);
            else XB_SPIN(xb_ld(&bar[XB_TOPGEN]) == tg, bar);
            __builtin_amdgcn_fence(__ATOMIC_ACQUIRE, "agent");
            xb_add(&bar[XB_XGEN(b.x)], 1u);
            asm volatile("s_waitcnt vmcnt(0)" ::: "memory");
        } else {
            XB_SPIN(xb_ld(&bar[XB_XGEN(b.x)]) == gen, bar);
            __builtin_amdgcn_fence(__ATOMIC_ACQUIRE, "agent");
            asm volatile("s_waitcnt vmcnt(0)" ::: "memory");
        }
    }
    __syncthreads();
}

#define CTR_WORD(k) (3520 + 64 * (k))
#ifndef PHMASK
#define PHMASK 0x1ff
#endif
#define PHM(x) (((PHMASK) >> (x)) & 1)
__global__ void __launch_bounds__(512, 2) mega(Args a) {
    extern __shared__ __attribute__((aligned(16))) unsigned char smem[];
    LAS unsigned char* lds = (LAS unsigned char*)smem;
    const int G = gridDim.x;
    unsigned char* ws = a.ws;
    bf16_t* H = (bf16_t*)(ws + WS_H); bf16_t* ACT = (bf16_t*)(ws + WS_ACT); bf16_t* Y = (bf16_t*)(ws + WS_Y); bf16_t* MP = (bf16_t*)(ws + WS_MP); bf16_t* MG = (bf16_t*)(ws + WS_MG);
    const float* MOD = (const float*)(ws + WS_MOD);
#if MK_DIAG_ZERO
    for (int i = otid(); i < LDS_BYTES / 4; i += 512) ((LAS unsigned*)lds)[i] = 0u;
    __syncthreads();
#endif
    XcdBarrier bar; bar.bar = (unsigned*)(ws + WS_BAR); bar.x = 0; bar.st = (volatile LAS unsigned*)(lds + LDS_BYTES - 16);
    unsigned* const ctrs = (unsigned*)(ws + WS_BAR);
    if (a.ph_lo < 0) cg::this_grid().sync();
    if (otid() < 4) ((LAS unsigned*)(lds + LDS_BYTES - 16))[otid()] = 0u;
    __syncthreads();
    if (a.ph_hi - a.ph_lo > 1) bar = xcd_barrier_post((unsigned*)(ws + WS_BAR), (volatile LAS unsigned*)(lds + LDS_BYTES - 16));
    for (int ph = a.ph_lo; ph < a.ph_hi; ++ph) {
      for (int rep = 0; rep < (((MK_PROBE >> ph) & 1) ? 2 : 1); ++rep) {
        const int bid = obid();
        if (PHM(0) && ph == 0) { phase0(a, lds, G); }
        else if (PHM(1) && (ph == 1 || ph == 4 || ph == 9 || ph == 12 || ph == 15 || ph == 19 || ph == 22)) {
            RowP p; p.y = Y; p.ctxin = a.in[I_CTX]; p.xout = a.out; p.h = H;
            bf16_t* XB = (bf16_t*)(ws + WS_XB);
            p.modeR = (ph <= 4); p.xin = a.in[I_X]; p.xinb = (ph <= 4) ? nullptr : XB; p.xoutb = (ph == 22) ? nullptr : XB; p.has_y = (ph != 1); p.has_h = (ph != 22);
            const int lg = (ph <= 12) ? 0 : 1;
            const int lh = (ph <= 9) ? 0 : 1;
            const int sub = (ph == 4 || ph == 15) ? 0 : (ph == 9 || ph == 19) ? 1 : 2;
            const int nxt = (ph == 1 || ph == 12) ? 0 : (ph == 4 || ph == 15) ? 1 : 2;
            p.wgt = (sub == 1) ? 1.f : 0.5f;
            p.modg = MOD + (size_t)lg * 5 * MODW; p.gidx = 3 * sub + 2; p.gpost = a.in[I_NORMG] + (size_t)(lg * 6 + 2 * sub + 1) * DM;
            p.modh = MOD + (size_t)lh * 5 * MODW; p.sidx = 3 * nxt; p.gpre = a.in[I_NORMG] + (size_t)(lh * 6 + 2 * nxt) * DM;
            row_phase(p, G);
        }
        else if (PHM(2) && (ph == 2 || ph == 10 || ph == 13 || ph == 20)) {
            const int f = (ph == 2) ? 0 : (ph == 10) ? 1 : (ph == 13) ? 2 : 3; const int M = (ph == 2) ? MR : ML;
            pg8::Gemm g{H, (const bf16_t*)(ws + WS_WGU + (size_t)f * SZ_WGU), M, 2 * DFF, DM}; pg8::StaticOrder S; S.init(M, 2 * DFF, G, bid);
            pg8::EpiPair E{ACT, DFF, nullptr, 0, 0, 1};
            pg8::gemm_phase<pg8::EpiPair, pg8::StaticOrder, true, true>(lds, g, S, E);
            if (ph == 2) convert_steal(a, lds, ctrs + CTR_WORD(0), 2 * 2752, 2752, T_FFN, T_MI + T_SQ);
            else if (ph == 10) convert_steal(a, lds, ctrs + CTR_WORD(2), 9 * 2752, 2 * 2752, 0, 0);
            else if (ph == 13) convert_steal(a, lds, ctrs + CTR_WORD(3), 11 * 2752, 2752, 0, 0);
        }
        else if (PHM(2) && ph == 16) {
            pg8::Gemm g{H, (const bf16_t*)(ws + WS_WCI), ML, 3 * DM, DM}; pg8::StaticOrder S; S.init(ML, 3 * DM, G, bid);
            pg8::EpiPair E{MP + (size_t)ML * DM, DM, MP, DM, 8, 0};
            pg8::gemm_phase<pg8::EpiPair, pg8::StaticOrder, true, true>(lds, g, S, E);
        }
        else if (PHM(3) && (ph == 3 || ph == 11 || ph == 14 || ph == 21 || ph == 8 || ph == 18)) {
            const bool down = !(ph == 8 || ph == 18);
            const int f = (ph == 3) ? 0 : (ph == 11) ? 1 : (ph == 14) ? 2 : 3; const int M = (ph == 3) ? MR : ML;
            const bf16_t* A = down ? ACT : MG; const bf16_t* Bt = down ? (const bf16_t*)(ws + WS_WD + (size_t)f * SZ_WD) : (const bf16_t*)(ws + (ph == 8 ? WS_WMO : WS_WCO));
            pg8::Gemm g{A, Bt, M, DM, down ? DFF : DM}; pg8::StaticOrder S; S.init(M, DM, G, bid);
            pg8::EpiB16 E{Y, DM};
            pg8::gemm_phase<pg8::EpiB16, pg8::StaticOrder, true, true>(lds, g, S, E);
            if (ph == 3) { convert_steal(a, lds, ctrs + CTR_WORD(1), 3 * 2752, 6 * 2752, 0, 0);
                           gemv_steal(a, lds, ctrs + CTR_WORD(5), 288, 288); }
        }
        else if (PHM(4) && ph == 5) {
            pg8::Gemm g{H, (const bf16_t*)(ws + WS_WMI), MR, MIXIN, DM}; pg8::StaticOrder S; S.init(MR, MIXIN, G, bid);
            pg8::EpiMix E{MP, MIXIN, (const f32x2*)(ws + WS_ROPE)};
            pg8::gemm_phase<pg8::EpiMix, pg8::StaticOrder, true, true>(lds, g, S, E);
            convert_steal(a, lds, ctrs + CTR_WORD(6), T_FFN + T_MI + T_SQ, T_SQ + T_CI, 0, 0);
        }
        else if (ph == 6) {
            float* OATT = (float*)(ws + WS_OATT);
            if (G >= 128) { if (bid < 64 && PHM(5)) hgrn_unit(a, lds, bid); }
            else { for (int u = bid; u < 64; u += G) if (PHM(5)) hgrn_unit(a, lds, u); }
            volatile LAS int* bc = (volatile LAS int*)(lds + LDS_BYTES - 32);
            for (;;) {
                __syncthreads();
                if (otid() == 0) bc[0] = (int)__hip_atomic_fetch_add(ctrs + CTR_WORD(4), 1u, __ATOMIC_RELAXED, __HIP_MEMORY_SCOPE_AGENT);
                __syncthreads();
                const int u = bc[0];
                if (u >= 512) break;
                const int qb = u & 7, mp = (u >> 3) & 1, h = (u >> 4) & 7, b = u >> 7;
                const bf16_t* base = MP + (size_t)(b * RS) * MIXIN;
                if (PHM(6)) att::attn_body(base + (size_t)(CTX + qb * 256) * MIXIN + h * 128 + mp * 64, base + 1024 + h * 128 + mp * 64, base + 2048 + h * 128,
                               OATT + (size_t)mp * ML * 1024 + (size_t)(b * SEQ + qb * 256) * 1024 + h * 128, RS, (char*)smem);
            }
        }
        else if (PHM(7) && ph == 7) { merge_phase(a, G); }
        else if (PHM(8) && ph == 17) { conv_phase(a, G); }
        if (ph + 1 < a.ph_hi) xcd_barrier(bar);
      }
    }

}

extern "C" void kernel_launch(void* const* d_in, const int* in_sizes, int n_in, void* d_out, int out_size, void* d_ws, size_t ws_size, hipStream_t stream) {
    static int grid = 0;
    if (grid == 0) {
        if (n_in != 19 || out_size != ML * DM || ws_size < WS_END) { fprintf(stderr, "kernel_launch: unexpected shapes: n_in %d out %d ws %zu (need %zu)\n", n_in, out_size, ws_size, (size_t)WS_END); grid = -1; return; }
        int dev = 0, cus = 0, per_cu = 0;
        hipGetDevice(&dev); hipDeviceGetAttribute(&cus, hipDeviceAttributeMultiprocessorCount, dev);
        if (hipFuncSetAttribute((const void*)mega, hipFuncAttributeMaxDynamicSharedMemorySize, LDS_BYTES) != hipSuccess) { fprintf(stderr, "kernel_launch: hipFuncSetAttribute failed\n"); grid = -1; return; }
        if (hipOccupancyMaxActiveBlocksPerMultiprocessor(&per_cu, (const void*)mega, 512, LDS_BYTES) != hipSuccess || per_cu < 1) { fprintf(stderr, "kernel_launch: occupancy query gave %d\n", per_cu); per_cu = 1; }
        (void)hipGetLastError();
        grid = cus * per_cu;
        fprintf(stderr, "kernel_launch: grid %d (cus %d x %d)\n", grid, cus, per_cu);
    }
    if (grid < 0) return;
#if MK_DIAG_ZERO
    (void)hipMemsetAsync(d_ws, 0, WS_END, stream);
    (void)hipMemsetAsync(d_out, 0, (size_t)ML * DM * 4, stream);
#endif
    (void)hipMemsetAsync((unsigned char*)d_ws + WS_BAR, 0, 16384, stream);
    Args a{};
    for (int i = 0; i < 19; ++i) a.in[i] = (const float*)d_in[i];
    a.out = (float*)d_out; a.ws = (unsigned char*)d_ws;
#if MK_MULTI
    for (int ph = 0; ph < NPHASE; ++ph) { a.ph_lo = ph; a.ph_hi = ph + 1; hipLaunchKernelGGL(mega, dim3(grid), dim3(512), LDS_BYTES, stream, a); }
#else
    a.ph_lo = 0; a.ph_hi = NPHASE;
    void* args[] = {&a};
    hipError_t e = hipLaunchCooperativeKernel((const void*)mega, dim3(grid), dim3(512), args, LDS_BYTES, stream);
    if (e != hipSuccess) fprintf(stderr, "kernel_launch: cooperative launch failed: %s (grid %d)\n", hipGetErrorString(e), grid);
#endif
}
```

```cpp
#include <hip/hip_runtime.h>
#include <hip/hip_cooperative_groups.h>
#include <cstdio>
#include <cstdint>
namespace cg = cooperative_groups;

#ifndef MK_MULTI
#define MK_MULTI 0
#endif

#ifndef MK_PROBE
#define MK_PROBE 0
#endif
#ifndef MK_DIAG_ZERO
#define MK_DIAG_ZERO 0
#endif
#define LAS __attribute__((address_space(3)))
typedef unsigned short bf16_t;
typedef short bf16x8 __attribute__((ext_vector_type(8)));
typedef short s16x4 __attribute__((ext_vector_type(4)));
typedef float f32x2 __attribute__((ext_vector_type(2)));
typedef float f32x4 __attribute__((ext_vector_type(4)));
typedef float f32x16 __attribute__((ext_vector_type(16)));
typedef unsigned u32x2 __attribute__((ext_vector_type(2)));
typedef unsigned u32x4 __attribute__((ext_vector_type(4)));

constexpr int DM = 2048, NB = 4, SEQ = 2048, CTX = 256, RS = SEQ + CTX, MR = NB * RS, ML = NB * SEQ, DFF = 5504, MODW = 9 * DM, MIXIN = 8192;
constexpr float EPS = 1e-6f;
constexpr int NPHASE = 23;
constexpr int LDS_BYTES = 147456;

struct Args { const float* in[19]; float* out; unsigned char* ws; int ph_lo, ph_hi; };
enum { I_X = 0, I_C, I_CTX, I_CCTX, I_ADAW, I_ADAB, I_NORMG, I_WG, I_WU, I_WDN, I_MIXIN, I_MIXOUT, I_DLAM, I_DNG, I_RNG, I_RLB, I_CWIN, I_CW, I_CWOUT };

constexpr size_t WS_MOD = 0;
constexpr size_t WS_ROPE = WS_MOD + (size_t)2 * 5 * MODW * 4;
constexpr size_t SZ_WGU = (size_t)2 * DFF * DM * 2, SZ_WD = (size_t)DM * DFF * 2;
constexpr size_t WS_BAR = WS_ROPE + 8192;
constexpr size_t WS_WGU = WS_BAR + 16384;
constexpr size_t WS_WD = WS_WGU + 4 * SZ_WGU;
constexpr size_t WS_WMI = WS_WD + 4 * SZ_WD;
constexpr size_t WS_WMO = WS_WMI + (size_t)MIXIN * DM * 2;
constexpr size_t WS_WCI = WS_WMO + (size_t)DM * DM * 2;
constexpr size_t WS_WCO = WS_WCI + (size_t)3 * DM * DM * 2;
constexpr size_t WS_H = WS_WCO + (size_t)DM * DM * 2;
constexpr size_t WS_ACT = WS_H + (size_t)MR * DM * 2;
constexpr size_t WS_Y = WS_ACT + (size_t)MR * DFF * 2;
constexpr size_t WS_MP = WS_Y + (size_t)MR * DM * 4;
constexpr size_t WS_OATT = WS_MP + (size_t)MR * MIXIN * 2;
constexpr size_t WS_OREC = WS_OATT + (size_t)2 * ML * 1024 * 4;
constexpr size_t WS_MG = WS_OREC + (size_t)2 * ML * 1024 * 4;
constexpr size_t WS_XB = WS_MG + (size_t)ML * DM * 2;
constexpr size_t WS_END = WS_XB + (size_t)ML * DM * 2;

typedef __bf16 bf16x2_t __attribute__((ext_vector_type(2)));
__device__ __forceinline__ unsigned cvtpk(float lo, float hi) { const f32x2 v = {lo, hi}; const bf16x2_t b = __builtin_convertvector(v, bf16x2_t); return __builtin_bit_cast(unsigned, b); }
__device__ __forceinline__ float bflo(unsigned w) { return __uint_as_float(w << 16); }
__device__ __forceinline__ float bfhi(unsigned w) { return __uint_as_float(w & 0xffff0000u); }
__device__ __forceinline__ float wave_sum(float v) {
#pragma unroll
    for (int o = 1; o < 64; o <<= 1) v += __shfl_xor(v, o);
    return v;
}
__device__ __forceinline__ int otid() { int t = threadIdx.x; asm volatile("" : "+v"(t)); return t; }
__device__ __forceinline__ int obid() { int t = blockIdx.x; asm volatile("" : "+s"(t)); return t; }
__device__ __forceinline__ float sigmoidf_(float x) { return __builtin_amdgcn_rcpf(1.f + __expf(-x)); }
__device__ __forceinline__ float siluf_(float x) { return x * sigmoidf_(x); }

namespace pg8 {
#define PG8_LAS __attribute__((address_space(3)))
typedef unsigned short bf16_t;
typedef short bf16x8 __attribute__((ext_vector_type(8)));
typedef float f32x4 __attribute__((ext_vector_type(4)));
typedef unsigned u32x4 __attribute__((ext_vector_type(4)));
constexpr int BM = 256, BK = 64, HALF = 128, HTB = HALF * BK * 2  , STAGE_BYTES = 8 * HTB, NXCD = 8, WGM = 8;

__host__ __device__ __forceinline__ int lds_byte(int r, int c) { const int st = (r >> 4) * 2 + (c >> 5), rr = r & 15, cc = c & 31, ob = rr * 64 + cc * 2; return st * 1024 + (ob ^ (((ob >> 9) & 1) << 5)); }
__host__ __device__ __forceinline__ void stage_rc(int b, int& R, int& C) { const int st = b / 1024, sb = b % 1024, swz = sb ^ (((sb >> 9) & 1) << 5); R = (st >> 1) * 16 + swz / 64; C = (st & 1) * 32 + (swz % 64) / 2; }
__host__ __device__ __forceinline__ int perm32(int rho) { const int n = rho >> 4, i = rho & 15; return 8 * (i >> 2) + 4 * n + (i & 3); }

struct Unit { int pm, pn; };
struct Gemm { const bf16_t* A; const bf16_t* Bt; int M, N, K; };

struct StaticOrder {
    int nM, nN, nwg, G, c;
    __host__ __device__ void init(int M, int N, int G_, int c_) { nM = M / BM; nN = N / BM; nwg = nM * nN; G = G_; c = c_; }
    __host__ __device__ bool next(int i, Unit& u) const {
        const long L = (long)i * G + c; if (L >= nwg) return false;
        int wgid = (int)L; { const int q = nwg / NXCD, r = nwg % NXCD, xcd = wgid % NXCD, off = wgid / NXCD; wgid = (xcd < r ? xcd * (q + 1) : r * (q + 1) + (xcd - r) * q) + off; }
        const int nig = WGM * nN, gid = wgid / nig, fm = gid * WGM, gsz = (nM - fm) < WGM ? (nM - fm) : WGM;
        u.pm = fm + ((wgid % nig) % gsz); u.pn = (wgid % nig) / gsz; return true;
    }
    __device__ __forceinline__ void a_ready(const Unit&) const {}
    __device__ __forceinline__ void done(const Unit&) const {}
};

__device__ __forceinline__ unsigned cvt_pk_bf16(float lo, float hi) { return ::cvtpk(lo, hi); }
typedef float f32x2 __attribute__((ext_vector_type(2)));

__device__ __forceinline__ void st8_bf16(bf16_t* p, const f32x4 v0, const f32x4 v1) {
    u32x4 w; w.x = cvt_pk_bf16(v0[0], v0[1]); w.y = cvt_pk_bf16(v0[2], v0[3]); w.z = cvt_pk_bf16(v1[0], v1[1]); w.w = cvt_pk_bf16(v1[2], v1[3]); *(u32x4*)p = w;
}
__device__ __forceinline__ float silu_e(float g) { return g * __builtin_amdgcn_rcpf(1.f + __expf(-g)); }
struct EpiPair {
    static constexpr bool PERM = true, AFTER_DRAIN = false;
    bf16_t* O1; int ld1; bf16_t* O0; int ld0; int nplain; int silu;
    __device__ __forceinline__ void operator()(const f32x4 (&acc)[2][2][4][2], const Unit& u, int wr, int wc, int fr, int fq) const {
        const int row0 = u.pm * BM + wr * 64 + fr;
        if (u.pn < nplain) {
            const int col0 = u.pn * BM + wc * 32 + 8 * fq;
#pragma unroll
            for (int ai = 0; ai < 2; ++ai)
#pragma unroll
                for (int m = 0; m < 4; ++m) { bf16_t* rowp = O0 + (size_t)(row0 + ai * HALF + m * 16) * ld0 + col0;
#pragma unroll
                    for (int bj = 0; bj < 2; ++bj) st8_bf16(rowp + bj * HALF, acc[ai][bj][m][0], acc[ai][bj][m][1]); }
        } else {
            const int col0 = (u.pn - nplain) * HALF + wc * 32 + 8 * fq;
#pragma unroll
            for (int ai = 0; ai < 2; ++ai)
#pragma unroll
                for (int m = 0; m < 4; ++m) { bf16_t* rowp = O1 + (size_t)(row0 + ai * HALF + m * 16) * ld1 + col0;
                    f32x4 g0 = acc[ai][0][m][0], g1 = acc[ai][0][m][1]; const f32x4 u0 = acc[ai][1][m][0], u1 = acc[ai][1][m][1];
                    if (silu) {
#pragma unroll
                        for (int e = 0; e < 4; ++e) { g0[e] = silu_e(g0[e]); g1[e] = silu_e(g1[e]); } }
                    st8_bf16(rowp, g0 * u0, g1 * u1); }
        }
    }
};
struct EpiB16 {
    static constexpr bool PERM = true, AFTER_DRAIN = false;
    bf16_t* O; int ld;
    __device__ __forceinline__ void operator()(const f32x4 (&acc)[2][2][4][2], const Unit& u, int wr, int wc, int fr, int fq) const {
        const int row0 = u.pm * BM + wr * 64 + fr, col0 = u.pn * BM + wc * 32 + 8 * fq;
#pragma unroll
        for (int ai = 0; ai < 2; ++ai)
#pragma unroll
            for (int m = 0; m < 4; ++m) { bf16_t* rowp = O + (size_t)(row0 + ai * HALF + m * 16) * ld + col0;
#pragma unroll
                for (int bj = 0; bj < 2; ++bj) st8_bf16(rowp + bj * HALF, acc[ai][bj][m][0], acc[ai][bj][m][1]); }
    }
};
struct EpiMix {
    static constexpr bool PERM = true, AFTER_DRAIN = false;
    bf16_t* O; int ld; const f32x2* rope;
    __device__ __forceinline__ void operator()(const f32x4 (&acc)[2][2][4][2], const Unit& u, int wr, int wc, int fr, int fq) const {
        const int row0 = u.pm * BM + wr * 64 + fr, col0 = u.pn * BM + wc * 32 + 8 * fq;
        const int pmod = u.pm % 9;
        if (u.pn >= 8 || pmod == 0) {
#pragma unroll
            for (int ai = 0; ai < 2; ++ai)
#pragma unroll
                for (int m = 0; m < 4; ++m) { bf16_t* rowp = O + (size_t)(row0 + ai * HALF + m * 16) * ld + col0;
#pragma unroll
                    for (int bj = 0; bj < 2; ++bj) st8_bf16(rowp + bj * HALF, acc[ai][bj][m][0], acc[ai][bj][m][1]); }
        } else {
            const int half = wc & 1, i0 = 8 * (fq & 1); const float sgn = fq < 2 ? -1.f : 1.f;
#pragma unroll
            for (int ai = 0; ai < 2; ++ai) {
                const int tb = (pmod - 1) * 256 + ai * HALF + wr * 64;
#pragma unroll
                for (int m = 0; m < 4; ++m) {
                    const int pos = half ? (m * 16 + fr) : (tb >> 6);
                    const f32x4* rp = (const f32x4*)(rope + pos * 16 + i0);
                    const f32x4 c01 = rp[0], c23 = rp[1], c45 = rp[2], c67 = rp[3];
                    const float cs[8] = {c01[0], c01[2], c23[0], c23[2], c45[0], c45[2], c67[0], c67[2]};
                    const float sn[8] = {c01[1], c01[3], c23[1], c23[3], c45[1], c45[3], c67[1], c67[3]};
                    bf16_t* rowp = O + (size_t)(row0 + ai * HALF + m * 16) * ld + col0;
#pragma unroll
                    for (int bj = 0; bj < 2; ++bj) {
                        f32x4 v0 = acc[ai][bj][m][0], v1 = acc[ai][bj][m][1], o0, o1;
#pragma unroll
                        for (int e = 0; e < 4; ++e) { const float p0 = __shfl_xor(v0[e], 32), p1 = __shfl_xor(v1[e], 32);
                            o0[e] = v0[e] * cs[e] + sgn * p0 * sn[e]; o1[e] = v1[e] * cs[4 + e] + sgn * p1 * sn[4 + e]; }
                        st8_bf16(rowp + bj * HALF, o0, o1);
                    }
                }
            }
        }
    }
};

template <class Epi, class Sched, bool ALIGN_EPI = false, bool SP2 = false>
__device__ __forceinline__ void gemm_phase(PG8_LAS unsigned char* lds, const Gemm g, const Sched& S, const Epi& E) {
    const int tid = otid(), wid = __builtin_amdgcn_readfirstlane(tid >> 6), lane = tid & 63, wr = wid >> 2, wc = wid & 3, fr = lane & 15, fq = lane >> 4;
    const int K = g.K, nt = K / BK;
    unsigned voffA[2], voffB[2];
#pragma unroll
    for (int i = 0; i < 2; ++i) { int R, C; stage_rc(tid * 16 + i * 8192, R, C); const int Rb = Epi::PERM ? ((R & ~31) + perm32(R & 31)) : R;
        voffA[i] = (unsigned)(R * K + C) * 2u; voffB[i] = (unsigned)(Rb * K + C) * 2u; }
    const size_t kstep = (size_t)(BK * 2);
    const size_t hstep = (size_t)HALF * K * 2;
    const size_t tstep = 2 * hstep;
    const unsigned ldsw = (unsigned)wid * 1024u;
    const int aoff = lds_byte(wr * 64 + fr, fq * 8), boff = lds_byte(wc * 32 + fr, fq * 8);
#define PG8_SA(b, h) (((b) * 2 + (h)) * HTB)
#define PG8_SB(b, h) ((4 + (b) * 2 + (h)) * HTB)
#define PG8_STAGE(bufoff, gbase, voff) do { _Pragma("unroll") for (int _i = 0; _i < 2; ++_i) \
        __builtin_amdgcn_global_load_lds((const unsigned*)((const char*)(gbase) + (voff)[_i]), (PG8_LAS unsigned*)(lds + (bufoff) + ldsw + _i * 8192), 16, 0, 0); } while (0)
#define PG8_LDA(dst, b, h) do { _Pragma("unroll") for (int m = 0; m < 4; ++m) _Pragma("unroll") for (int k = 0; k < 2; ++k) dst[m][k] = *(const PG8_LAS bf16x8*)(lds + PG8_SA(b, h) + aoff + m * 2048 + k * 1024); } while (0)
#define PG8_LDB(dst, b, h) do { _Pragma("unroll") for (int n = 0; n < 2; ++n) _Pragma("unroll") for (int k = 0; k < 2; ++k) dst[n][k] = *(const PG8_LAS bf16x8*)(lds + PG8_SB(b, h) + boff + n * 2048 + k * 1024); } while (0)
#define PG8_MMA(ai, bj, At, Bt) do { __builtin_amdgcn_s_setprio(1); _Pragma("unroll") for (int m = 0; m < 4; ++m) _Pragma("unroll") for (int n = 0; n < 2; ++n) _Pragma("unroll") for (int k = 0; k < 2; ++k) \
        acc[ai][bj][m][n] = __builtin_amdgcn_mfma_f32_16x16x32_bf16(Bt[n][k], At[m][k], acc[ai][bj][m][n], 0, 0, 0); __builtin_amdgcn_s_setprio(0); } while (0)
#define PG8_WAIT_V(n) asm volatile("s_waitcnt vmcnt(" #n ")" ::: "memory")
#define PG8_WAIT_L(n) asm volatile("s_waitcnt lgkmcnt(" #n ")" ::: "memory")
#define PG8_BAR __builtin_amdgcn_s_barrier()
#define PG8_SCHED __builtin_amdgcn_sched_barrier(0)
    Unit cur, nxt; int ui = 0;
    if (!S.next(0, cur)) return;
    f32x4 acc[2][2][4][2];
#pragma unroll
    for (int a = 0; a < 2; ++a)
#pragma unroll
        for (int b = 0; b < 2; ++b)
#pragma unroll
            for (int m = 0; m < 4; ++m)
#pragma unroll
                for (int n = 0; n < 2; ++n) acc[a][b][m][n] = (f32x4){0.f, 0.f, 0.f, 0.f};
    bf16x8 At[4][2], B0[2][2], B1[2][2];
    const char* cA = (const char*)g.A + (size_t)cur.pm * tstep; const char* cB = (const char*)g.Bt + (size_t)cur.pn * tstep;
    S.a_ready(cur);
    if constexpr (SP2) {
        PG8_STAGE(PG8_SB(0, 0), cB, voffB); PG8_STAGE(PG8_SB(0, 1), cB + hstep, voffB); PG8_STAGE(PG8_SA(0, 0), cA, voffA); PG8_STAGE(PG8_SA(0, 1), cA + hstep, voffA);
        if (wr == 1) PG8_BAR;
        PG8_WAIT_V(2); PG8_BAR;
        PG8_STAGE(PG8_SB(1, 0), cB + kstep, voffB); PG8_STAGE(PG8_SA(1, 0), cA + kstep, voffA); PG8_STAGE(PG8_SB(1, 1), cB + hstep + kstep, voffB);
        PG8_WAIT_V(6); PG8_BAR;
    } else {
        PG8_STAGE(PG8_SB(0, 0), cB, voffB); PG8_STAGE(PG8_SA(0, 0), cA, voffA); PG8_STAGE(PG8_SB(0, 1), cB + hstep, voffB); PG8_STAGE(PG8_SA(0, 1), cA + hstep, voffA);
        if (wr == 1) PG8_BAR;
        PG8_WAIT_V(4); PG8_BAR;
        PG8_STAGE(PG8_SB(1, 0), cB + kstep, voffB); PG8_STAGE(PG8_SA(1, 0), cA + kstep, voffA); PG8_STAGE(PG8_SB(1, 1), cB + hstep + kstep, voffB);
        PG8_WAIT_V(6); PG8_BAR;
    }
    for (;;) {
        const bool has_next = S.next(ui + 1, nxt);
        const char* nA = has_next ? (const char*)g.A + (size_t)nxt.pm * tstep : cA; const char* nB = has_next ? (const char*)g.Bt + (size_t)nxt.pn * tstep : cB;
        for (int t = 0; t < nt; t += 2) {
            const bool last = (t == nt - 2);
            const char* a1 = cA + (size_t)(t + 1) * kstep;
            const char* a2 = last ? nA : cA + (size_t)(t + 2) * kstep; const char* b2 = last ? nB : cB + (size_t)(t + 2) * kstep;
            const char* a3 = a2 + kstep; const char* b3 = b2 + kstep;
            if (last && has_next) S.a_ready(nxt);
            if constexpr (SP2) {
            PG8_LDB(B0, 0, 0); PG8_LDB(B1, 0, 1); PG8_SCHED; PG8_LDA(At, 0, 0); PG8_STAGE(PG8_SA(1, 1), a1 + hstep, voffA);
            PG8_WAIT_V(8); PG8_WAIT_L(0); PG8_BAR; PG8_MMA(0, 0, At, B0); PG8_MMA(0, 1, At, B1); PG8_BAR; PG8_SCHED;
            PG8_LDA(At, 0, 1); PG8_STAGE(PG8_SB(0, 0), b2, voffB); PG8_STAGE(PG8_SB(0, 1), b2 + hstep, voffB); PG8_STAGE(PG8_SA(0, 0), a2, voffA);
            PG8_WAIT_V(8); PG8_WAIT_L(0); PG8_BAR; PG8_MMA(1, 0, At, B0); PG8_MMA(1, 1, At, B1); PG8_BAR; PG8_SCHED;
            PG8_LDB(B0, 1, 0); PG8_LDB(B1, 1, 1); PG8_SCHED; PG8_LDA(At, 1, 0); PG8_STAGE(PG8_SA(0, 1), a2 + hstep, voffA);
            PG8_WAIT_V(8); PG8_WAIT_L(0); PG8_BAR; PG8_MMA(0, 0, At, B0); PG8_MMA(0, 1, At, B1); PG8_BAR; PG8_SCHED;
            PG8_LDA(At, 1, 1); PG8_STAGE(PG8_SB(1, 0), b3, voffB); PG8_STAGE(PG8_SB(1, 1), b3 + hstep, voffB); PG8_STAGE(PG8_SA(1, 0), a3, voffA);
            PG8_WAIT_V(8); PG8_WAIT_L(0); PG8_BAR; PG8_MMA(1, 0, At, B0); PG8_MMA(1, 1, At, B1); PG8_BAR; PG8_SCHED;
            } else {
            PG8_LDB(B0, 0, 0); PG8_SCHED; PG8_LDA(At, 0, 0); PG8_STAGE(PG8_SA(1, 1), a1 + hstep, voffA);
            PG8_WAIT_L(8); PG8_BAR; PG8_WAIT_L(0); PG8_MMA(0, 0, At, B0); PG8_BAR; PG8_SCHED;
            PG8_LDB(B1, 0, 1); PG8_STAGE(PG8_SB(0, 0), b2, voffB);
            PG8_BAR; PG8_WAIT_L(0); PG8_MMA(0, 1, At, B1); PG8_BAR;
            PG8_LDA(At, 0, 1); PG8_STAGE(PG8_SA(0, 0), a2, voffA);
            PG8_BAR; PG8_WAIT_L(0); PG8_MMA(1, 0, At, B0); PG8_BAR; PG8_SCHED;
            PG8_STAGE(PG8_SB(0, 1), b2 + hstep, voffB);
            PG8_WAIT_V(6); PG8_BAR; PG8_MMA(1, 1, At, B1); PG8_BAR;
            PG8_LDB(B0, 1, 0); PG8_SCHED; PG8_LDA(At, 1, 0); PG8_STAGE(PG8_SA(0, 1), a2 + hstep, voffA);
            PG8_WAIT_L(8); PG8_BAR; PG8_WAIT_L(0); PG8_MMA(0, 0, At, B0); PG8_BAR; PG8_SCHED;
            PG8_LDB(B1, 1, 1); PG8_STAGE(PG8_SB(1, 0), b3, voffB);
            PG8_BAR; PG8_WAIT_L(0); PG8_MMA(0, 1, At, B1); PG8_BAR;
            PG8_LDA(At, 1, 1); PG8_STAGE(PG8_SA(1, 0), a3, voffA);
            PG8_BAR; PG8_WAIT_L(0); PG8_MMA(1, 0, At, B0); PG8_BAR; PG8_SCHED;
            PG8_STAGE(PG8_SB(1, 1), b3 + hstep, voffB);
            PG8_WAIT_V(6); PG8_BAR; PG8_MMA(1, 1, At, B1); PG8_BAR;
            }
        }
        if constexpr (ALIGN_EPI) { if (wr == 0) PG8_BAR; }
        if constexpr (!Epi::AFTER_DRAIN) { E(acc, cur, wr, wc, fr, fq); S.done(cur); }
        if (!has_next) break;
#pragma unroll
        for (int a = 0; a < 2; ++a)
#pragma unroll
            for (int b = 0; b < 2; ++b)
#pragma unroll
                for (int m = 0; m < 4; ++m)
#pragma unroll
                    for (int n = 0; n < 2; ++n) acc[a][b][m][n] = (f32x4){0.f, 0.f, 0.f, 0.f};
        cur = nxt; cA = nA; cB = nB; ++ui;
        if constexpr (ALIGN_EPI) { if (wr == 1) PG8_BAR; }
    }
    PG8_WAIT_V(0);
    if constexpr (!ALIGN_EPI) { if (wr == 0) PG8_BAR; }
    PG8_BAR;
    if constexpr (Epi::AFTER_DRAIN) { E.fused(acc, cur, wr, wc, fr, fq, lds, wid, lane); S.done(cur); }
#undef PG8_SA
#undef PG8_SB
#undef PG8_STAGE
#undef PG8_LDA
#undef PG8_LDB
#undef PG8_MMA
#undef PG8_WAIT_V
#undef PG8_WAIT_L
#undef PG8_BAR
#undef PG8_SCHED
}
}

namespace att {
constexpr int NW = 8, QBLK = 32, KVBLK = 64, DV = 128, DQ = 64;
constexpr float SCALE = 0.125f, THR = 8.f;
constexpr int LDQ = MIXIN, LDK = MIXIN, LDO = 1024;
constexpr int SHM_V = KVBLK * DV * 2, SHM_K = KVBLK * DQ * 2, SHM_ATTN = 2 * SHM_V + 2 * SHM_K + NW * 64 * 4;
#define KSWZ(row, colB) ((row) * 128 + ((colB) ^ (((row) & 7) << 4)))
#define SBAR() __builtin_amdgcn_sched_barrier(0)
__device__ __forceinline__ int crow(int r, int hi) { return (r & 3) + 8 * (r >> 2) + 4 * hi; }
__device__ __forceinline__ unsigned cvtpkv(float lo, float hi) { unsigned r; asm volatile("v_cvt_pk_bf16_f32 %0, %1, %2" : "=v"(r) : "v"(lo), "v"(hi)); return r; }
__device__ __forceinline__ void partialSM(f32x16& p0, f32x16& p1, float& m_reg, float& mn, float& alpha) {
  constexpr float C = SCALE * 1.4426950408889634f;
  float pmax = p0[0]; for (int r = 1; r < 16; ++r) pmax = fmaxf(pmax, p0[r]); for (int r = 0; r < 16; ++r) pmax = fmaxf(pmax, p1[r]);
  { auto rr = __builtin_amdgcn_permlane32_swap(__float_as_uint(pmax), __float_as_uint(pmax), false, false);
    pmax = fmaxf(__uint_as_float(rr[0]), __uint_as_float(rr[1])); }
  if (__builtin_expect(__all(pmax - m_reg <= THR / SCALE), 1)) { mn = m_reg; alpha = 1.f; }
  else { mn = fmaxf(m_reg, pmax); alpha = __builtin_amdgcn_exp2f((m_reg - mn) * C); m_reg = mn; }
  float mnC = -mn * C;
  for (int r = 0; r < 16; ++r) p0[r] = fmaf(p0[r], C, mnC); for (int r = 0; r < 16; ++r) p1[r] = fmaf(p1[r], C, mnC);
  for (int r = 0; r < 16; ++r) p0[r] = __builtin_amdgcn_exp2f(p0[r]);
}
__device__ __forceinline__ void finishSM(f32x16& p0, f32x16& p1, float alpha, float& l_reg, bf16x8& pa0, bf16x8& pa1, bf16x8& pa2, bf16x8& pa3) {
  for (int r = 0; r < 16; ++r) p1[r] = __builtin_amdgcn_exp2f(p1[r]);
  float ps = 0; for (int r = 0; r < 16; ++r) ps += p0[r]; for (int r = 0; r < 16; ++r) ps += p1[r];
  { auto rr = __builtin_amdgcn_permlane32_swap(__float_as_uint(ps), __float_as_uint(ps), false, false);
    ps = __uint_as_float(rr[0]) + __uint_as_float(rr[1]); }
  l_reg = l_reg * alpha + ps;
#define PK4(P, BASE, OUT) do { unsigned a0 = cvtpkv(P[BASE + 0], P[BASE + 1]), a1 = cvtpkv(P[BASE + 2], P[BASE + 3]);   \
    unsigned b0 = cvtpkv(P[BASE + 4], P[BASE + 5]), b1 = cvtpkv(P[BASE + 6], P[BASE + 7]);                              \
    auto r0 = __builtin_amdgcn_permlane32_swap(a0, b0, false, false); auto r1 = __builtin_amdgcn_permlane32_swap(a1, b1, false, false); \
    u32x4 w = {r0[0], r1[0], r0[1], r1[1]}; OUT = *reinterpret_cast<bf16x8*>(&w); } while (0)
  PK4(p0, 0, pa0); PK4(p0, 8, pa1); PK4(p1, 0, pa2); PK4(p1, 8, pa3);
#undef PK4
}
__device__ __forceinline__ void qkt(f32x16& p0, f32x16& p1, const bf16_t* Ks, const bf16x8* qr, int r32, int hi) {
  p0 = f32x16{}; p1 = f32x16{};
#pragma unroll
  for (int d0 = 0; d0 < 4; ++d0) { int cb = (d0 * 16 + hi * 8) * 2;
    bf16x8 b0 = *reinterpret_cast<const bf16x8*>((const char*)Ks + KSWZ(r32, cb));
    bf16x8 b1 = *reinterpret_cast<const bf16x8*>((const char*)Ks + KSWZ(32 + r32, cb));
    p0 = __builtin_amdgcn_mfma_f32_32x32x16_bf16(b0, qr[d0], p0, 0, 0, 0);
    p1 = __builtin_amdgcn_mfma_f32_32x32x16_bf16(b1, qr[d0], p1, 0, 0, 0); }
}
__device__ __forceinline__ int v_st(int k, int c) { const int kk = (k & ~0xC) | ((k & 4) << 1) | ((k & 8) >> 1); return ((kk >> 3) * 4 + (c >> 5)) * 512 + ((kk & 7) * 32 + (c & 31)) * 2; }
__device__ __forceinline__ int v_rd_base(int lane) { return ((lane & 3) << 3) | (((lane >> 2) & 3) << 6) | (((lane >> 4) & 1) << 5) | (((lane >> 5) & 1) << 8); }
constexpr int v_rd_off(int d0, int ks, int half) { return d0 * 512 + ks * 4096 + half * 2048; }
template <int OFF> __device__ __forceinline__ s16x4 tr_read(int vb) {
  s16x4 r; asm volatile("ds_read_b64_tr_b16 %0, %1 offset:%2" : "=&v"(r) : "v"(vb), "i"(OFF) : "memory"); return r;
}
template <int D0> __device__ __forceinline__ void pv_one(f32x16& od, int vb, bf16x8 pa0, bf16x8 pa1, bf16x8 pa2, bf16x8 pa3) {
  const s16x4 l0 = tr_read<v_rd_off(D0, 0, 0)>(vb), h0 = tr_read<v_rd_off(D0, 0, 1)>(vb), l1 = tr_read<v_rd_off(D0, 1, 0)>(vb), h1 = tr_read<v_rd_off(D0, 1, 1)>(vb);
  const s16x4 l2 = tr_read<v_rd_off(D0, 2, 0)>(vb), h2 = tr_read<v_rd_off(D0, 2, 1)>(vb), l3 = tr_read<v_rd_off(D0, 3, 0)>(vb), h3 = tr_read<v_rd_off(D0, 3, 1)>(vb);
  asm volatile("s_waitcnt lgkmcnt(0)" ::: "memory"); SBAR();
#define PK(L, H) (bf16x8){L[0], L[1], L[2], L[3], H[0], H[1], H[2], H[3]}
  od = __builtin_amdgcn_mfma_f32_32x32x16_bf16(pa0, PK(l0, h0), od, 0, 0, 0);
  od = __builtin_amdgcn_mfma_f32_32x32x16_bf16(pa1, PK(l1, h1), od, 0, 0, 0);
  od = __builtin_amdgcn_mfma_f32_32x32x16_bf16(pa2, PK(l2, h2), od, 0, 0, 0);
  od = __builtin_amdgcn_mfma_f32_32x32x16_bf16(pa3, PK(l3, h3), od, 0, 0, 0);
#undef PK
}
__device__ __forceinline__ void pv_d0(f32x16* o, int vb, bf16x8 pa0, bf16x8 pa1, bf16x8 pa2, bf16x8 pa3) {
  pv_one<0>(o[0], vb, pa0, pa1, pa2, pa3); pv_one<1>(o[1], vb, pa0, pa1, pa2, pa3); pv_one<2>(o[2], vb, pa0, pa1, pa2, pa3); pv_one<3>(o[3], vb, pa0, pa1, pa2, pa3);
}
__device__ __forceinline__ void attn_body(const bf16_t* __restrict__ Qb, const bf16_t* __restrict__ Kh, const bf16_t* __restrict__ Vh, float* __restrict__ Ob, int seq, char* lds) {
  const int tid = otid(), wid = tid >> 6, lane = tid & 63, r32 = lane & 31, hi = lane >> 5;
  bf16_t* V_lds = (bf16_t*)lds; bf16_t* K_lds = (bf16_t*)(lds + 2 * SHM_V);
  float* ws = (float*)(lds + 2 * SHM_V + 2 * SHM_K) + wid * 64; float* li_l = ws; float* al_l = ws + 32;
  float m_reg = -1e30f, l_reg = 0; f32x16 o[4] = {}; bf16x8 qr[4];
  const bf16_t* Qw = Qb + (long)(wid * QBLK + r32) * LDQ + hi * 8;
#pragma unroll
  for (int d0 = 0; d0 < 4; ++d0) qr[d0] = *reinterpret_cast<const bf16x8*>(Qw + d0 * 16);
  const int sr = tid >> 4, sc = (tid & 15) * 8, vst0 = v_st(sr, sc), vst1 = v_st(32 + sr, sc);
  const int kr = tid >> 3, kc = (tid & 7) * 8, kst = KSWZ(kr, kc * 2);
  const int vb0 = (int)(uintptr_t)V_lds + v_rd_base(lane);
  struct { bf16x8 vs0, vs1, ks0; } sr_[2];
#define SLOAD(i, k0) do { sr_[i].vs0 = *reinterpret_cast<const bf16x8*>(&Vh[(long)((k0) + sr) * LDK + sc]); sr_[i].vs1 = *reinterpret_cast<const bf16x8*>(&Vh[(long)((k0) + 32 + sr) * LDK + sc]); \
    sr_[i].ks0 = *reinterpret_cast<const bf16x8*>(&Kh[(long)((k0) + kr) * LDK + kc]); } while (0)
#define SWRITE(b, i) do { *(bf16x8*)((char*)V_lds + (b) * SHM_V + vst0) = sr_[i].vs0;          \
    *(bf16x8*)((char*)V_lds + (b) * SHM_V + vst1) = sr_[i].vs1;                                  \
    *(bf16x8*)((char*)K_lds + (b) * SHM_K + kst) = sr_[i].ks0; } while (0)
#define SWAIT() asm volatile("s_waitcnt vmcnt(3)" ::: "memory")
#define RESC(a) do { if (__any((a) < 1.f)) { if (hi == 0) al_l[r32] = (a); asm volatile("s_waitcnt lgkmcnt(0)" ::: "memory"); \
    for (int d = 0; d < 4; ++d) for (int r = 0; r < 16; ++r) o[d][r] *= al_l[crow(r, hi)]; } } while (0)
  f32x16 pA0, pA1, pB0, pB1; float mnA, mnB, alA, alB; bf16x8 pa0, pa1, pa2, pa3; const int NT = seq / KVBLK;
  constexpr int SE = 0, SO = 1;
  SLOAD(SE, 0); asm volatile("s_waitcnt vmcnt(0)" ::: "memory"); SWRITE(0, SE); __syncthreads();
  qkt(pA0, pA1, K_lds, qr, r32, hi); partialSM(pA0, pA1, m_reg, mnA, alA);
  SLOAD(SO, KVBLK); if (2 < NT) SLOAD(SE, 2 * KVBLK);
  SWAIT(); SWRITE(1, SO); __syncthreads();
  for (int j = 1; j + 1 < NT; j += 2) {
    SBAR(); qkt(pB0, pB1, (bf16_t*)((char*)K_lds + SHM_K), qr, r32, hi);
    finishSM(pA0, pA1, alA, l_reg, pa0, pa1, pa2, pa3); SBAR();
    SLOAD(SO, (j + 2) * KVBLK); SBAR();
    pv_d0(o, vb0, pa0, pa1, pa2, pa3); partialSM(pB0, pB1, m_reg, mnB, alB);
    __syncthreads(); SWAIT(); SWRITE(0, SE);
    RESC(alB); __syncthreads();
    SBAR(); qkt(pA0, pA1, K_lds, qr, r32, hi);
    finishSM(pB0, pB1, alB, l_reg, pa0, pa1, pa2, pa3); SBAR();
    if (j + 3 < NT) SLOAD(SE, (j + 3) * KVBLK); SBAR();
    pv_d0(o, vb0 + (int)SHM_V, pa0, pa1, pa2, pa3); partialSM(pA0, pA1, m_reg, mnA, alA);
    __syncthreads(); SWAIT(); SWRITE(1, SO);
    RESC(alA); __syncthreads();
  }
  SBAR(); qkt(pB0, pB1, (bf16_t*)((char*)K_lds + SHM_K), qr, r32, hi);
  finishSM(pA0, pA1, alA, l_reg, pa0, pa1, pa2, pa3); SBAR();
  pv_d0(o, vb0, pa0, pa1, pa2, pa3); partialSM(pB0, pB1, m_reg, mnB, alB);
  __syncthreads(); RESC(alB);
  finishSM(pB0, pB1, alB, l_reg, pa0, pa1, pa2, pa3); SBAR();
  pv_d0(o, vb0 + (int)SHM_V, pa0, pa1, pa2, pa3);
  if (hi == 0) li_l[r32] = l_reg; asm volatile("s_waitcnt lgkmcnt(0)" ::: "memory");
  float rli[16];
#pragma unroll
  for (int r = 0; r < 16; ++r) rli[r] = __builtin_amdgcn_rcpf(li_l[crow(r, hi)]);
  float* Ow = Ob + (long)(wid * QBLK) * LDO;
#pragma unroll
  for (int r = 0; r < 16; ++r) { int orow = crow(r, hi);
    for (int d0 = 0; d0 < 4; ++d0) Ow[(long)orow * LDO + d0 * 32 + r32] = o[d0][r] * rli[r]; }
#undef SLOAD
#undef SWRITE
#undef SWAIT
#undef RESC
}
}

__device__ __forceinline__ int hcrow(int r, int hi) { return (r & 3) + 8 * (r >> 2) + 4 * hi; }
__device__ __forceinline__ void hgrn_unit(const Args& a, LAS unsigned char* lds, int unit) {
    const int tid = otid(), w = __builtin_amdgcn_readfirstlane(tid >> 6), lane = tid & 63, r32 = lane & 31, hi = lane >> 5;
    const int dir = unit & 1, h = (unit >> 1) & 7, b = unit >> 4;
    constexpr int PQ = 136, PS = 72;
    LAS bf16_t* Qt = (LAS bf16_t*)lds;
    LAS bf16_t* Kt = Qt + 64 * PQ;
    LAS bf16_t* KhT = Kt + 64 * PQ;
    LAS bf16_t* Vt = KhT + 128 * PS;
    LAS bf16_t* At = Vt + 128 * PS;
    LAS bf16_t* St = At + 64 * PS;
    LAS float* part = (LAS float*)(St + 128 * PQ);
    LAS float* dec = part + 8 * 128;
    const bf16_t* MP = (const bf16_t*)(a.ws + WS_MP);
    float* OREC = (float*)(a.ws + WS_OREC) + (size_t)dir * ML * 1024;
    const int kp = lane;
    float lb[2];
#pragma unroll
    for (int j = 0; j < 2; ++j) { const float a0 = a.in[I_RLB][(dir * 2 + 0) * 1024 + h * 128 + 2 * kp + j], a1 = a.in[I_RLB][(dir * 2 + 1) * 1024 + h * 128 + 2 * kp + j];
        lb[j] = 1.f / (1.f + __expf(a1 - a0)); }
    __syncthreads();
    for (int i = tid; i < 128 * PQ / 2; i += 512) ((LAS unsigned*)St)[i] = 0u;
    f32x16 S[2] = {};
    unsigned q2[8], z2[8], v2[8];
    const int zcol = (dir ? 5120 : 4096) + h * 128 + 2 * kp, qcol = 3072 + h * 128 + 2 * kp, vcol = 6144 + h * 128 + 2 * kp;
#define HG_ROWBASE(c) (b * RS + (dir ? ((c) < 4 ? 192 - 64 * (c) : RS - 64 * ((c) - 3)) : 64 * (c)))
#define HG_LOAD(c) do { const int rb_ = HG_ROWBASE(c); _Pragma("unroll") for (int e = 0; e < 8; ++e) { const int tau = 8 * w + e, rr = dir ? 63 - tau : tau; \
        const bf16_t* rp = MP + (size_t)(rb_ + rr) * MIXIN; q2[e] = *(const unsigned*)(rp + qcol); z2[e] = *(const unsigned*)(rp + zcol); v2[e] = *(const unsigned*)(rp + vcol); } } while (0)
    HG_LOAD(0);
    const int ti = w >> 2, vi = w & 3, ki = w >> 1, vi0 = 2 * (w & 1);
    for (int c = 0; c < 36; ++c) {
        const int rowbase = HG_ROWBASE(c);
        float Pl[8][2], fk[8][2]; float p0 = 1.f, p1 = 1.f;
#pragma unroll
        for (int e = 0; e < 8; ++e) {
            const float f0 = lb[0] + (1.f - lb[0]) * sigmoidf_(bflo(z2[e])), f1 = lb[1] + (1.f - lb[1]) * sigmoidf_(bfhi(z2[e]));
            p0 *= f0; p1 *= f1; Pl[e][0] = p0; Pl[e][1] = p1; fk[e][0] = 1.f - f0; fk[e][1] = 1.f - f1;
        }
        *(LAS f32x2*)(part + w * 128 + 2 * kp) = (f32x2){p0, p1};
        __syncthreads();
        float off0 = 1.f, off1 = 1.f, tot0 = 1.f, tot1 = 1.f;
#pragma unroll
        for (int x = 0; x < 8; ++x) { const f32x2 pp = *(LAS f32x2*)(part + x * 128 + 2 * kp); tot0 *= pp[0]; tot1 *= pp[1]; if (x < w) { off0 *= pp[0]; off1 *= pp[1]; } }
        unsigned kh0[4], kh1[4], vt0[4], vt1[4];
        float kha[8][2];
#pragma unroll
        for (int e = 0; e < 8; ++e) {
            const int tau = 8 * w + e;
            const float P0 = fmaxf(off0 * Pl[e][0], 1e-35f), P1 = fmaxf(off1 * Pl[e][1], 1e-35f);
            const float i0 = __builtin_amdgcn_rcpf(P0), i1 = __builtin_amdgcn_rcpf(P1);
            const float qs0 = bflo(q2[e]) * 0.08838834764831845f * P0, qs1 = bfhi(q2[e]) * 0.08838834764831845f * P1;
            const float kt0 = fk[e][0] * i0, kt1 = fk[e][1] * i1;
            kha[e][0] = kt0 * tot0; kha[e][1] = kt1 * tot1;
            *(LAS unsigned*)(Qt + tau * PQ + 2 * kp) = cvtpk(qs0, qs1);
            *(LAS unsigned*)(Kt + tau * PQ + 2 * kp) = cvtpk(kt0, kt1);
        }
#pragma unroll
        for (int e = 0; e < 4; ++e) { kh0[e] = cvtpk(kha[2 * e][0], kha[2 * e + 1][0]); kh1[e] = cvtpk(kha[2 * e][1], kha[2 * e + 1][1]);
            vt0[e] = (v2[2 * e] & 0xffffu) | (v2[2 * e + 1] << 16); vt1[e] = (v2[2 * e] >> 16) | (v2[2 * e + 1] & 0xffff0000u); }
        *(LAS u32x4*)(KhT + (2 * kp) * PS + 8 * w) = (u32x4){kh0[0], kh0[1], kh0[2], kh0[3]};
        *(LAS u32x4*)(KhT + (2 * kp + 1) * PS + 8 * w) = (u32x4){kh1[0], kh1[1], kh1[2], kh1[3]};
        *(LAS u32x4*)(Vt + (2 * kp) * PS + 8 * w) = (u32x4){vt0[0], vt0[1], vt0[2], vt0[3]};
        *(LAS u32x4*)(Vt + (2 * kp + 1) * PS + 8 * w) = (u32x4){vt1[0], vt1[1], vt1[2], vt1[3]};
        if (w == 0) *(LAS f32x2*)(dec + 2 * kp) = (f32x2){tot0, tot1};
        if (c + 1 < 36) HG_LOAD(c + 1);
        __syncthreads();
        const bool outc = c >= 4;
        f32x16 o = {};
        if (outc) {
#pragma unroll
            for (int j = 0; j < 8; ++j) { const bf16x8 A = *(const LAS bf16x8*)(Qt + (32 * ti + r32) * PQ + 16 * j + 8 * hi), B = *(const LAS bf16x8*)(St + (32 * vi + r32) * PQ + 16 * j + 8 * hi);
                o = __builtin_amdgcn_mfma_f32_32x32x16_bf16(A, B, o, 0, 0, 0); }
            if (w < 4) {
                const int ta = w >> 1, sa = w & 1;
                f32x16 acc = {};
                if (sa <= ta) {
#pragma unroll
                    for (int j = 0; j < 8; ++j) { const bf16x8 A = *(const LAS bf16x8*)(Qt + (32 * ta + r32) * PQ + 16 * j + 8 * hi), B = *(const LAS bf16x8*)(Kt + (32 * sa + r32) * PQ + 16 * j + 8 * hi);
                        acc = __builtin_amdgcn_mfma_f32_32x32x16_bf16(A, B, acc, 0, 0, 0); }
                }
#pragma unroll
                for (int i = 0; i < 16; ++i) { const int t = 32 * ta + hcrow(i, hi), s = 32 * sa + r32; const float v = (s <= t) ? acc[i] : 0.f;
                    At[t * PS + s] = (bf16_t)(cvtpk(v, 0.f) & 0xffffu); }
            }
        }
#pragma unroll
        for (int x = 0; x < 2; ++x) {
#pragma unroll
            for (int i = 0; i < 16; ++i) S[x][i] *= dec[32 * ki + hcrow(i, hi)];
#pragma unroll
            for (int j = 0; j < 4; ++j) { const bf16x8 A = *(const LAS bf16x8*)(KhT + (32 * ki + r32) * PS + 16 * j + 8 * hi), B = *(const LAS bf16x8*)(Vt + (32 * (vi0 + x) + r32) * PS + 16 * j + 8 * hi);
                S[x] = __builtin_amdgcn_mfma_f32_32x32x16_bf16(A, B, S[x], 0, 0, 0); }
        }
        __syncthreads();
        if (outc) {
#pragma unroll
            for (int j = 0; j < 4; ++j) { const bf16x8 A = *(const LAS bf16x8*)(At + (32 * ti + r32) * PS + 16 * j + 8 * hi), B = *(const LAS bf16x8*)(Vt + (32 * vi + r32) * PS + 16 * j + 8 * hi);
                o = __builtin_amdgcn_mfma_f32_32x32x16_bf16(A, B, o, 0, 0, 0); }
#pragma unroll
            for (int i = 0; i < 16; ++i) { const int tau = 32 * ti + hcrow(i, hi), rr = dir ? 63 - tau : tau; const int lrow = rowbase + rr - 256 * (b + 1);
                OREC[(size_t)lrow * 1024 + h * 128 + 32 * vi + r32] = o[i]; }
        }
#pragma unroll
        for (int x = 0; x < 2; ++x)
#pragma unroll
            for (int g = 0; g < 4; ++g) { const int k0 = 32 * ki + 8 * g + 4 * hi;
                *(LAS u32x2*)(St + (32 * (vi0 + x) + r32) * PQ + k0) = (u32x2){cvtpk(S[x][4 * g], S[x][4 * g + 1]), cvtpk(S[x][4 * g + 2], S[x][4 * g + 3])}; }
    }
    __syncthreads();
#undef HG_LOAD
#undef HG_ROWBASE
}

__device__ __forceinline__ void transpose_item(const float* __restrict__ src, int ldn, int k0, int n0, bf16_t* __restrict__ dst, int Kd, int drow, LAS float* scr, int lane) {
    const int cl = (lane & 15) * 4, ks = lane >> 4;
    f32x4 v[16];
#pragma unroll
    for (int i = 0; i < 16; ++i) v[i] = __builtin_nontemporal_load((const f32x4*)(src + (size_t)(k0 + 4 * i + ks) * ldn + n0 + cl));
#pragma unroll
    for (int i = 0; i < 16; ++i) { LAS float* s = scr + (4 * i + ks) * 65 + cl; s[0] = v[i][0]; s[1] = v[i][1]; s[2] = v[i][2]; s[3] = v[i][3]; }
    asm volatile("s_waitcnt lgkmcnt(0)" ::: "memory");
    const int c = lane & 7;
#pragma unroll
    for (int j = 0; j < 8; ++j) { const int n = (lane >> 3) + 8 * j; const LAS float* s = scr + (8 * c) * 65 + n;
        u32x4 o; o.x = cvtpk(s[0 * 65], s[1 * 65]); o.y = cvtpk(s[2 * 65], s[3 * 65]); o.z = cvtpk(s[4 * 65], s[5 * 65]); o.w = cvtpk(s[6 * 65], s[7 * 65]);
        __builtin_nontemporal_store(o, (u32x4*)(dst + (size_t)(drow + n) * Kd + k0 + 8 * c)); }
    asm volatile("s_waitcnt lgkmcnt(0)" ::: "memory");
}
constexpr int T_FFN = 12 * 2752, T_MI = 4096, T_SQ = 1024, T_CI = 3072, T_ALL = T_FFN + T_MI + 2 * T_SQ + T_CI;
__device__ __forceinline__ void convert_item(const Args& a, int it, LAS float* scr, int lane) {
    bf16_t* WGU = (bf16_t*)(a.ws + WS_WGU); bf16_t* WD = (bf16_t*)(a.ws + WS_WD);
        const float* src; int ldn, k0, n0, Kd, drow; bf16_t* dst;
        if (it < T_FFN) { const int m = it / 2752, r = it % 2752, f = m / 3, kind = m % 3;
            if (kind < 2) { k0 = (r / 86) * 64; n0 = (r % 86) * 64; src = a.in[kind ? I_WU : I_WG] + (size_t)f * DM * DFF; ldn = DFF; Kd = DM; dst = WGU + (size_t)f * 2 * DFF * DM; drow = (n0 >> 7) * 256 + kind * 128 + (n0 & 127); }
            else { k0 = (r / 32) * 64; n0 = (r % 32) * 64; src = a.in[I_WDN] + (size_t)f * DFF * DM; ldn = DM; Kd = DFF; dst = WD + (size_t)f * DM * DFF; drow = n0; }
        } else if (it < T_FFN + T_MI) { const int r = it - T_FFN; k0 = (r / 128) * 64; n0 = (r % 128) * 64; src = a.in[I_MIXIN]; ldn = MIXIN; Kd = DM; dst = (bf16_t*)(a.ws + WS_WMI); drow = n0; }
        else if (it < T_FFN + T_MI + T_SQ) { const int r = it - T_FFN - T_MI; k0 = (r / 32) * 64; n0 = (r % 32) * 64; src = a.in[I_MIXOUT]; ldn = DM; Kd = DM; dst = (bf16_t*)(a.ws + WS_WMO); drow = n0; }
        else if (it < T_FFN + T_MI + 2 * T_SQ) { const int r = it - T_FFN - T_MI - T_SQ; k0 = (r / 32) * 64; n0 = (r % 32) * 64; src = a.in[I_CWOUT]; ldn = DM; Kd = DM; dst = (bf16_t*)(a.ws + WS_WCO); drow = n0; }
        else { const int r = it - T_FFN - T_MI - 2 * T_SQ; k0 = (r / 96) * 64; n0 = (r % 96) * 64; src = a.in[I_CWIN]; ldn = 3 * DM; Kd = DM; dst = (bf16_t*)(a.ws + WS_WCI);
            if (n0 < DM) drow = n0; else if (n0 < 2 * DM) { const int j = n0 - DM; drow = DM + (j >> 7) * 256 + (j & 127); } else { const int j = n0 - 2 * DM; drow = DM + (j >> 7) * 256 + 128 + (j & 127); } }
        transpose_item(src, ldn, k0, n0, dst, Kd, drow, scr, lane);
}
#ifndef NSTEAL
#define NSTEAL 4
#endif
__device__ __forceinline__ void convert_steal(const Args& a, LAS unsigned char* lds, unsigned* ctr, int lo1, int n1, int lo2, int n2) {
    const int tid = otid(), w = __builtin_amdgcn_readfirstlane(tid >> 6), lane = tid & 63;
    LAS float* scr = (LAS float*)lds + w * (64 * 65);
    volatile LAS int* bc = (volatile LAS int*)(lds + LDS_BYTES - 32);
    const int n = n1 + n2;
    for (;;) {
        __syncthreads();
        if (tid == 0) bc[0] = (int)__hip_atomic_fetch_add(ctr, (unsigned)NSTEAL, __ATOMIC_RELAXED, __HIP_MEMORY_SCOPE_AGENT);
        __syncthreads();
        const int base = bc[0];
        if (base >= n) break;
        const int j = base + w;
        if (w < NSTEAL && j < n) convert_item(a, j < n1 ? lo1 + j : lo2 + (j - n1), scr, lane);
    }
}
__device__ __forceinline__ void gemv_fill(const Args& a, LAS unsigned char* lds) {
    LAS float* sc = (LAS float*)lds;
    for (int i = otid(); i < 5 * 2048; i += 512) { const float v = i < 8192 ? a.in[I_C][i] : a.in[I_CCTX][i - 8192]; sc[i] = siluf_(v); }
    __syncthreads();
}
__device__ __forceinline__ void gemv_item(const Args& a, LAS unsigned char* lds, int it) {
    const int tid = otid(), w = __builtin_amdgcn_readfirstlane(tid >> 6), lane = tid & 63;
    LAS float* sc = (LAS float*)lds; LAS float* red = sc + 5 * 2048;
    float* MOD = (float*)(a.ws + WS_MOD);
    const int l = it / 288, n0 = (it % 288) * 64, cl = (lane & 15) * 4, ks = lane >> 4;
    const float* W = a.in[I_ADAW] + (size_t)l * DM * MODW + n0 + cl;
    f32x4 acc[5] = {};
#pragma unroll 8
    for (int kk = 0; kk < 256; kk += 4) { const int k = w * 256 + kk + ks; const f32x4 wv = __builtin_nontemporal_load((const f32x4*)(W + (size_t)k * MODW));
#pragma unroll
        for (int i = 0; i < 5; ++i) acc[i] += wv * sc[i * 2048 + k]; }
#pragma unroll
    for (int i = 0; i < 5; ++i)
#pragma unroll
        for (int e = 0; e < 4; ++e) { float v = acc[i][e]; v += __shfl_xor(v, 16); v += __shfl_xor(v, 32); acc[i][e] = v; }
    if (lane < 16) {
#pragma unroll
        for (int i = 0; i < 5; ++i) *(LAS f32x4*)(red + (w * 5 + i) * 64 + cl) = acc[i]; }
    __syncthreads();
    if (tid < 320) { const int i = tid >> 6, cc = tid & 63; float s = a.in[I_ADAB][l * MODW + n0 + cc];
#pragma unroll
        for (int x = 0; x < 8; ++x) s += red[(x * 5 + i) * 64 + cc];
        MOD[((size_t)l * 5 + i) * MODW + n0 + cc] = s; }
    __syncthreads();
}
__device__ __forceinline__ void gemv_steal(const Args& a, LAS unsigned char* lds, unsigned* ctr, int lo, int n) {
    volatile LAS int* bc = (volatile LAS int*)(lds + LDS_BYTES - 32);
    bool filled = false;
    for (;;) {
        __syncthreads();
        if (otid() == 0) bc[0] = (int)__hip_atomic_fetch_add(ctr, 1u, __ATOMIC_RELAXED, __HIP_MEMORY_SCOPE_AGENT);
        __syncthreads();
        const int j = bc[0];
        if (j >= n) break;
        if (!filled) { gemv_fill(a, lds); filled = true; }
        gemv_item(a, lds, lo + j);
    }
}
__device__ __forceinline__ void phase0(const Args& a, LAS unsigned char* lds, int G) {
    const int tid = otid(), w = __builtin_amdgcn_readfirstlane(tid >> 6), lane = tid & 63, bid = obid();
    { const int id = bid * 512 + tid; if (id < 1024) { const int pos = id >> 4, i = id & 15; const float fr = __builtin_amdgcn_exp2f(-(float)i * (13.287712379549449f / 16.f)); const float ang = (float)pos * fr;
        ((f32x2*)(a.ws + WS_ROPE))[id] = (f32x2){__cosf(ang), __sinf(ang)}; } }
    gemv_fill(a, lds);
    for (int it = bid; it < 64; it += G) gemv_item(a, lds, it);
    LAS float* scr = (LAS float*)lds + w * (64 * 65);
    for (int it = bid * 8 + w; it < 2 * 2752; it += G * 8) convert_item(a, it, scr, lane);
}

struct RowP { const bf16_t* xinb; bf16_t* xoutb; const bf16_t* y; const float* xin; const float* ctxin; float* xout; bf16_t* h; int modeR; float wgt; const float* modg; int gidx; const float* gpost; const float* modh; int sidx; const float* gpre; int has_y, has_h; };
__device__ __forceinline__ void row_phase(const RowP& p, int G) {
    const int tid = otid(), w = tid >> 6, lane = tid & 63;
    const int nrows = p.modeR ? MR : ML;
    for (int r0 = (obid() * 8 + w) * 2; r0 < nrows; r0 += G * 16) {
        int mi; const float* xrow; float* xo; size_t lrow = 0;
        if (p.modeR) { const int b = r0 / RS, s = r0 % RS; if (s < CTX) { mi = 4; xrow = p.ctxin + (size_t)(b * CTX + s) * DM; xo = nullptr; } else { mi = b; lrow = (size_t)(b * SEQ + s - CTX); xrow = p.xin + lrow * DM; xo = p.xout; } }
        else { mi = r0 / SEQ; lrow = (size_t)r0; xrow = p.xin + lrow * DM; xo = p.xout; }
        const bool isctx = p.modeR && mi == 4;
        f32x4 xv[2][4][2]; u32x4 yv[2][4];
        if (p.xinb && !isctx) {
#pragma unroll
            for (int q = 0; q < 2; ++q)
#pragma unroll
                for (int j = 0; j < 4; ++j) { const u32x4 xx = *(const u32x4*)(p.xinb + (lrow + q) * DM + 8 * lane + 512 * j);
                    xv[q][j][0] = (f32x4){bflo(xx[0]), bfhi(xx[0]), bflo(xx[1]), bfhi(xx[1])}; xv[q][j][1] = (f32x4){bflo(xx[2]), bfhi(xx[2]), bflo(xx[3]), bfhi(xx[3])}; }
        } else {
#pragma unroll
            for (int q = 0; q < 2; ++q)
#pragma unroll
                for (int j = 0; j < 4; ++j) { const float* xp = xrow + (size_t)q * DM + 8 * lane + 512 * j; xv[q][j][0] = *(const f32x4*)xp; xv[q][j][1] = *(const f32x4*)(xp + 4); }
        }
        if (p.has_y) {
#pragma unroll
            for (int q = 0; q < 2; ++q)
#pragma unroll
                for (int j = 0; j < 4; ++j) yv[q][j] = *(const u32x4*)(p.y + (size_t)(r0 + q) * DM + 8 * lane + 512 * j);
            float ss[2] = {0.f, 0.f};
#pragma unroll
            for (int q = 0; q < 2; ++q)
#pragma unroll
                for (int j = 0; j < 4; ++j)
#pragma unroll
                    for (int e = 0; e < 4; ++e) { const float a = bflo(yv[q][j][e]), b = bfhi(yv[q][j][e]); ss[q] += a * a + b * b; }
            const float ry0 = rsqrtf(wave_sum(ss[0]) * (1.f / DM) + EPS) * p.wgt, ry1 = rsqrtf(wave_sum(ss[1]) * (1.f / DM) + EPS) * p.wgt;
            const float* gate = p.modg + (size_t)mi * MODW + p.gidx * DM;
#pragma unroll
            for (int j = 0; j < 4; ++j) { const int c = 8 * lane + 512 * j;
                const f32x4 gt0 = *(const f32x4*)(gate + c) * *(const f32x4*)(p.gpost + c), gt1 = *(const f32x4*)(gate + c + 4) * *(const f32x4*)(p.gpost + c + 4);
#pragma unroll
                for (int q = 0; q < 2; ++q) { const float ry = q ? ry1 : ry0; const u32x4 yy = yv[q][j];
                    const f32x4 y0 = {bflo(yy[0]), bfhi(yy[0]), bflo(yy[1]), bfhi(yy[1])}, y1 = {bflo(yy[2]), bfhi(yy[2]), bflo(yy[3]), bfhi(yy[3])};
                    xv[q][j][0] = xv[q][j][0] + gt0 * (y0 * ry); xv[q][j][1] = xv[q][j][1] + gt1 * (y1 * ry);
                    if (!isctx) { if (p.xoutb) *(u32x4*)(p.xoutb + (lrow + q) * DM + c) = (u32x4){cvtpk(xv[q][j][0][0], xv[q][j][0][1]), cvtpk(xv[q][j][0][2], xv[q][j][0][3]), cvtpk(xv[q][j][1][0], xv[q][j][1][1]), cvtpk(xv[q][j][1][2], xv[q][j][1][3])};
                                  else { float* op = xo + (lrow + q) * DM + c; *(f32x4*)op = xv[q][j][0]; *(f32x4*)(op + 4) = xv[q][j][1]; } } } }
        }
        if (p.has_h) {
            float ss[2] = {0.f, 0.f};
#pragma unroll
            for (int q = 0; q < 2; ++q)
#pragma unroll
                for (int j = 0; j < 4; ++j)
#pragma unroll
                    for (int k = 0; k < 2; ++k) { const f32x4 v = xv[q][j][k]; ss[q] += (v[0] * v[0] + v[1] * v[1]) + (v[2] * v[2] + v[3] * v[3]); }
            const float rx0 = rsqrtf(wave_sum(ss[0]) * (1.f / DM) + EPS), rx1 = rsqrtf(wave_sum(ss[1]) * (1.f / DM) + EPS);
            const float* sh = p.modh + (size_t)mi * MODW + p.sidx * DM; const float* scl = sh + DM;
#pragma unroll
            for (int j = 0; j < 4; ++j) { const int c = 8 * lane + 512 * j;
                const f32x4 m0 = *(const f32x4*)(p.gpre + c) * (*(const f32x4*)(scl + c) + 1.f), m1 = *(const f32x4*)(p.gpre + c + 4) * (*(const f32x4*)(scl + c + 4) + 1.f);
                const f32x4 s0 = *(const f32x4*)(sh + c), s1 = *(const f32x4*)(sh + c + 4);
#pragma unroll
                for (int q = 0; q < 2; ++q) { const float rx = q ? rx1 : rx0;
                    const f32x4 h0 = (xv[q][j][0] * rx) * m0 + s0, h1 = (xv[q][j][1] * rx) * m1 + s1;
                    *(u32x4*)(p.h + (size_t)(r0 + q) * DM + c) = (u32x4){cvtpk(h0[0], h0[1]), cvtpk(h0[2], h0[3]), cvtpk(h1[0], h1[1]), cvtpk(h1[2], h1[3])}; } }
        }
    }
}

__device__ __forceinline__ float half_sum(float v) {
#pragma unroll
    for (int o = 1; o < 32; o <<= 1) v += __shfl_xor(v, o);
    return v;
}
__device__ __forceinline__ void merge_phase(const Args& a, int G) {
    const int tid = otid(), w = tid >> 6, lane = tid & 63, l32 = lane & 31, hsel = lane >> 5;
    const float* dl = a.in[I_DLAM];
    const float s01 = wave_sum(dl[lane] * dl[64 + lane]), s23 = wave_sum(dl[128 + lane] * dl[192 + lane]);
    const float lam = __expf(s01) - __expf(s23) + 0.2f;
    const float* OA = (const float*)(a.ws + WS_OATT); const float* OR = (const float*)(a.ws + WS_OREC); const bf16_t* MP = (const bf16_t*)(a.ws + WS_MP); bf16_t* MG = (bf16_t*)(a.ws + WS_MG);
    const f32x4 ga = *(const f32x4*)(a.in[I_DNG] + 4 * l32) * 0.8f, gr = *(const f32x4*)(a.in[I_RNG] + 4 * l32);
    for (int lr = obid() * 8 + w; lr < ML; lr += G * 8) {
        const int b = lr / SEQ; const size_t rrow = (size_t)(lr + 256 * (b + 1));
        f32x4 o1[4], o2[4], of[4], ob[4]; u32x2 gw[4];
#pragma unroll
        for (int hp = 0; hp < 4; ++hp) { const size_t c0 = (size_t)lr * 1024 + (2 * hp + hsel) * 128 + 4 * l32;
            o1[hp] = *(const f32x4*)(OA + c0); o2[hp] = *(const f32x4*)(OA + (size_t)ML * 1024 + c0);
            of[hp] = *(const f32x4*)(OR + c0); ob[hp] = *(const f32x4*)(OR + (size_t)ML * 1024 + c0);
            gw[hp] = *(const u32x2*)(MP + rrow * MIXIN + 7168 + (2 * hp + hsel) * 128 + 4 * l32); }
#pragma unroll
        for (int hp = 0; hp < 4; ++hp) { const int c0 = (2 * hp + hsel) * 128 + 4 * l32;
            const f32x4 d = o1[hp] - o2[hp] * lam; const float r = rsqrtf(half_sum((d[0] * d[0] + d[1] * d[1]) + (d[2] * d[2] + d[3] * d[3])) * (1.f / 128.f) + EPS);
            const f32x4 x = d * r * ga;
            *(u32x2*)(MG + (size_t)lr * DM + c0) = (u32x2){cvtpk(x[0], x[1]), cvtpk(x[2], x[3])};
            const f32x4 o = of[hp] + ob[hp]; const float rr = rsqrtf(half_sum((o[0] * o[0] + o[1] * o[1]) + (o[2] * o[2] + o[3] * o[3])) * (1.f / 128.f) + EPS);
            const f32x4 g = {siluf_(bflo(gw[hp][0])), siluf_(bfhi(gw[hp][0])), siluf_(bflo(gw[hp][1])), siluf_(bfhi(gw[hp][1]))};
            const f32x4 y = o * rr * gr * g;
            *(u32x2*)(MG + (size_t)lr * DM + 1024 + c0) = (u32x2){cvtpk(y[0], y[1]), cvtpk(y[2], y[3])}; }
    }
}

__device__ __forceinline__ void conv_phase(const Args& a, int G) {
    const bf16_t* BG = (const bf16_t*)(a.ws + WS_MP); const bf16_t* CV = BG + (size_t)ML * DM; bf16_t* MG = (bf16_t*)(a.ws + WS_MG); const float* cw = a.in[I_CW];
    const int tid = otid(), c = (tid & 255) * 8, rh = tid >> 8;
    f32x4 w0[2], w1[2], w2[2];
#pragma unroll
    for (int k = 0; k < 2; ++k) { w0[k] = *(const f32x4*)(cw + c + 4 * k); w1[k] = *(const f32x4*)(cw + DM + c + 4 * k); w2[k] = *(const f32x4*)(cw + 2 * DM + c + 4 * k); }
    const u32x4 z = {0u, 0u, 0u, 0u};
    for (int it = obid(); it < ML / 16; it += G) {
        const int r0 = it * 16 + rh * 8;
        const int t0 = r0 & (SEQ - 1);
        u32x4 prev = t0 > 0 ? *(const u32x4*)(CV + (size_t)(r0 - 1) * DM + c) : z;
        u32x4 cur = *(const u32x4*)(CV + (size_t)r0 * DM + c);
#pragma unroll
        for (int i = 0; i < 8; ++i) {
            const int lr = r0 + i;
            const u32x4 nxt = (t0 + i < SEQ - 1) ? *(const u32x4*)(CV + (size_t)(lr + 1) * DM + c) : z;
            const u32x4 bg = *(const u32x4*)(BG + (size_t)lr * DM + c);
            u32x4 o;
#pragma unroll
            for (int e = 0; e < 4; ++e) { const int k = e >> 1, q = (e & 1) * 2;
                const float lo = bflo(bg[e]) * (w0[k][q] * bflo(prev[e]) + w1[k][q] * bflo(cur[e]) + w2[k][q] * bflo(nxt[e]));
                const float hi = bfhi(bg[e]) * (w0[k][q + 1] * bfhi(prev[e]) + w1[k][q + 1] * bfhi(cur[e]) + w2[k][q + 1] * bfhi(nxt[e]));
                o[e] = cvtpk(lo, hi); }
            *(u32x4*)(MG + (size_t)lr * DM + c) = o;
            prev = cur; cur = nxt;
        }
    }
}

#define XB_TMO      128
#define XB_XCNT(j)  (256  + 64 * (j))
#define XB_XSUB(j)  (1280 + 64 * (j))
#define XB_XGEN(j)  (2304 + 64 * (j))
#define XB_TOP      3328
#define XB_TOPGEN   3392
#define XCD_BAR_WORDS 3456
#define XB_SPIN_CAP (1u << 18)

__device__ __forceinline__ unsigned xb_ld(unsigned* p)              { return __hip_atomic_load(p, __ATOMIC_RELAXED, __HIP_MEMORY_SCOPE_AGENT); }
__device__ __forceinline__ unsigned xb_add(unsigned* p, unsigned v) { return __hip_atomic_fetch_add(p, v, __ATOMIC_RELAXED, __HIP_MEMORY_SCOPE_AGENT); }
__device__ __forceinline__ unsigned xb_xcc_id() { return (unsigned)__builtin_amdgcn_s_getreg((3 << 11) | 20) & 0xFu; }
#define XB_SPIN(cond, bar) do { unsigned _sp = 0; while (cond) { __builtin_amdgcn_s_sleep(1); \
    if ((++_sp & 255u) == 0u) { if (xb_ld(&(bar)[XB_TMO])) break; if (_sp > XB_SPIN_CAP) { atomicAdd(&(bar)[XB_TMO], 1u); break; } } } } while (0)

struct XcdBarrier {
    unsigned* bar; unsigned x;
    volatile LAS unsigned* st;
};

__device__ __forceinline__ XcdBarrier xcd_barrier_post(unsigned* bar, volatile LAS unsigned* st) {
    XcdBarrier b; b.bar = bar; b.x = xb_xcc_id(); b.st = st;
    if (threadIdx.x == 0) (void)xb_add(&bar[XB_XCNT(b.x)], 1u);
    return b;
}
__device__ __forceinline__ void xcd_barrier_complete(unsigned* bar, unsigned x, unsigned& nloc, unsigned& nx) {
    const unsigned G = gridDim.x * gridDim.y * gridDim.z;
    unsigned sum, cnt, mine, sp = 0u;
    for (;;) {
        sum = 0u; cnt = 0u; mine = 0u;
#pragma unroll
        for (unsigned j = 0; j < 16; ++j) { const unsigned c = xb_ld(&bar[XB_XCNT(j)]); sum += c; cnt += (c > 0u) ? 1u : 0u; mine = (j == x) ? c : mine; }
        if (sum == G) break;
        __builtin_amdgcn_s_sleep(1);
        if ((++sp & 255u) == 0u) { if (xb_ld(&bar[XB_TMO])) break; if (sp > XB_SPIN_CAP) { atomicAdd(&bar[XB_TMO], 1u); break; } }
    }
    nloc = mine > 0u ? mine : 1u; nx = cnt > 0u ? cnt : 1u;
}

__device__ __forceinline__ void xcd_barrier(const XcdBarrier& b) {
    asm volatile("s_waitcnt vmcnt(0)" ::: "memory");
    __syncthreads();
    if (threadIdx.x == 0) {
        unsigned* bar = b.bar;
        __builtin_amdgcn_s_waitcnt(0);
        unsigned nloc = b.st[0], nx = b.st[1];
        if (nloc == 0u) { xcd_barrier_complete(bar, b.x, nloc, nx); b.st[0] = nloc; b.st[1] = nx; }
        const unsigned old = xb_add(&bar[XB_XSUB(b.x)], 1u);
        const unsigned gen = old / nloc;
        if (old + 1u == (gen + 1u) * nloc) {
            __builtin_amdgcn_fence(__ATOMIC_RELEASE, "agent");
            asm volatile("s_waitcnt vmcnt(0)" ::: "memory");
            const unsigned og = xb_add(&bar[XB_TOP], 1u);
            const unsigned tg = og / nx;
            if (og + 1u == (tg + 1u) * nx) xb_add(&bar[XB_TOPGEN], 1u);
            else XB_SPIN(xb_ld(&bar[XB_TOPGEN]) == tg, bar);
            __builtin_amdgcn_fence(__ATOMIC_ACQUIRE, "agent");
            xb_add(&bar[XB_XGEN(b.x)], 1u);
            asm volatile("s_waitcnt vmcnt(0)" ::: "memory");
        } else {
            XB_SPIN(xb_ld(&bar[XB_XGEN(b.x)]) == gen, bar);
            __builtin_amdgcn_fence(__ATOMIC_ACQUIRE, "agent");
            asm volatile("s_waitcnt vmcnt(0)" ::: "memory");
        }
    }
    __syncthreads();
}

#define CTR_WORD(k) (3520 + 64 * (k))
#ifndef PHMASK
#define PHMASK 0x1ff
#endif
#define PHM(x) (((PHMASK) >> (x)) & 1)
__global__ void __launch_bounds__(512, 2) mega(Args a) {
    extern __shared__ __attribute__((aligned(16))) unsigned char smem[];
    LAS unsigned char* lds = (LAS unsigned char*)smem;
    const int G = gridDim.x;
    unsigned char* ws = a.ws;
    bf16_t* H = (bf16_t*)(ws + WS_H); bf16_t* ACT = (bf16_t*)(ws + WS_ACT); bf16_t* Y = (bf16_t*)(ws + WS_Y); bf16_t* MP = (bf16_t*)(ws + WS_MP); bf16_t* MG = (bf16_t*)(ws + WS_MG);
    const float* MOD = (const float*)(ws + WS_MOD);
#if MK_DIAG_ZERO
    for (int i = otid(); i < LDS_BYTES / 4; i += 512) ((LAS unsigned*)lds)[i] = 0u;
    __syncthreads();
#endif
    XcdBarrier bar; bar.bar = (unsigned*)(ws + WS_BAR); bar.x = 0; bar.st = (volatile LAS unsigned*)(lds + LDS_BYTES - 16);
    unsigned* const ctrs = (unsigned*)(ws + WS_BAR);
    if (a.ph_lo < 0) cg::this_grid().sync();
    if (otid() < 4) ((LAS unsigned*)(lds + LDS_BYTES - 16))[otid()] = 0u;
    __syncthreads();
    if (a.ph_hi - a.ph_lo > 1) bar = xcd_barrier_post((unsigned*)(ws + WS_BAR), (volatile LAS unsigned*)(lds + LDS_BYTES - 16));
    for (int ph = a.ph_lo; ph < a.ph_hi; ++ph) {
      for (int rep = 0; rep < (((MK_PROBE >> ph) & 1) ? 2 : 1); ++rep) {
        const int bid = obid();
        if (PHM(0) && ph == 0) { phase0(a, lds, G); }
        else if (PHM(1) && (ph == 1 || ph == 4 || ph == 9 || ph == 12 || ph == 15 || ph == 19 || ph == 22)) {
            RowP p; p.y = Y; p.ctxin = a.in[I_CTX]; p.xout = a.out; p.h = H;
            bf16_t* XB = (bf16_t*)(ws + WS_XB);
            p.modeR = (ph <= 4); p.xin = a.in[I_X]; p.xinb = (ph <= 4) ? nullptr : XB; p.xoutb = (ph == 22) ? nullptr : XB; p.has_y = (ph != 1); p.has_h = (ph != 22);
            const int lg = (ph <= 12) ? 0 : 1;
            const int lh = (ph <= 9) ? 0 : 1;
            const int sub = (ph == 4 || ph == 15) ? 0 : (ph == 9 || ph == 19) ? 1 : 2;
            const int nxt = (ph == 1 || ph == 12) ? 0 : (ph == 4 || ph == 15) ? 1 : 2;
            p.wgt = (sub == 1) ? 1.f : 0.5f;
            p.modg = MOD + (size_t)lg * 5 * MODW; p.gidx = 3 * sub + 2; p.gpost = a.in[I_NORMG] + (size_t)(lg * 6 + 2 * sub + 1) * DM;
            p.modh = MOD + (size_t)lh * 5 * MODW; p.sidx = 3 * nxt; p.gpre = a.in[I_NORMG] + (size_t)(lh * 6 + 2 * nxt) * DM;
            row_phase(p, G);
        }
        else if (PHM(2) && (ph == 2 || ph == 10 || ph == 13 || ph == 20)) {
            const int f = (ph == 2) ? 0 : (ph == 10) ? 1 : (ph == 13) ? 2 : 3; const int M = (ph == 2) ? MR : ML;
            pg8::Gemm g{H, (const bf16_t*)(ws + WS_WGU + (size_t)f * SZ_WGU), M, 2 * DFF, DM}; pg8::StaticOrder S; S.init(M, 2 * DFF, G, bid);
            pg8::EpiPair E{ACT, DFF, nullptr, 0, 0, 1};
            pg8::gemm_phase<pg8::EpiPair, pg8::StaticOrder, true, true>(lds, g, S, E);
            if (ph == 2) { convert_steal(a, lds, ctrs + CTR_WORD(0), 2 * 2752, 2752, T_FFN, T_MI + T_SQ);
                           gemv_steal(a, lds, ctrs + CTR_WORD(7), 64, 96); }
            else if (ph == 10) convert_steal(a, lds, ctrs + CTR_WORD(2), 9 * 2752, 2 * 2752, 0, 0);
            else if (ph == 13) convert_steal(a, lds, ctrs + CTR_WORD(3), 11 * 2752, 2752, 0, 0);
        }
        else if (PHM(2) && ph == 16) {
            pg8::Gemm g{H, (const bf16_t*)(ws + WS_WCI), ML, 3 * DM, DM}; pg8::StaticOrder S; S.init(ML, 3 * DM, G, bid);
            pg8::EpiPair E{MP + (size_t)ML * DM, DM, MP, DM, 8, 0};
            pg8::gemm_phase<pg8::EpiPair, pg8::StaticOrder, true, true>(lds, g, S, E);
        }
        else if (PHM(3) && (ph == 3 || ph == 11 || ph == 14 || ph == 21 || ph == 8 || ph == 18)) {
            const bool down = !(ph == 8 || ph == 18);
            const int f = (ph == 3) ? 0 : (ph == 11) ? 1 : (ph == 14) ? 2 : 3; const int M = (ph == 3) ? MR : ML;
            const bf16_t* A = down ? ACT : MG; const bf16_t* Bt = down ? (const bf16_t*)(ws + WS_WD + (size_t)f * SZ_WD) : (const bf16_t*)(ws + (ph == 8 ? WS_WMO : WS_WCO));
            pg8::Gemm g{A, Bt, M, DM, down ? DFF : DM}; pg8::StaticOrder S; S.init(M, DM, G, bid);
            pg8::EpiB16 E{Y, DM};
            pg8::gemm_phase<pg8::EpiB16, pg8::StaticOrder, true, true>(lds, g, S, E);
            if (ph == 3) { convert_steal(a, lds, ctrs + CTR_WORD(1), 3 * 2752, 6 * 2752, 0, 0);
                           gemv_steal(a, lds, ctrs + CTR_WORD(5), 160, 416); }
        }
        else if (PHM(4) && ph == 5) {
            pg8::Gemm g{H, (const bf16_t*)(ws + WS_WMI), MR, MIXIN, DM}; pg8::StaticOrder S; S.init(MR, MIXIN, G, bid);
            pg8::EpiMix E{MP, MIXIN, (const f32x2*)(ws + WS_ROPE)};
            pg8::gemm_phase<pg8::EpiMix, pg8::StaticOrder, true, true>(lds, g, S, E);
            convert_steal(a, lds, ctrs + CTR_WORD(6), T_FFN + T_MI + T_SQ, T_SQ + T_CI, 0, 0);
        }
        else if (ph == 6) {
            float* OATT = (float*)(ws + WS_OATT);
            if (G >= 128) { if (bid < 64 && PHM(5)) hgrn_unit(a, lds, bid); }
            else { for (int u = bid; u < 64; u += G) if (PHM(5)) hgrn_unit(a, lds, u); }
            volatile LAS int* bc = (volatile LAS int*)(lds + LDS_BYTES - 32);
            for (;;) {
                __syncthreads();
                if (otid() == 0) bc[0] = (int)__hip_atomic_fetch_add(ctrs + CTR_WORD(4), 1u, __ATOMIC_RELAXED, __HIP_MEMORY_SCOPE_AGENT);
                __syncthreads();
                const int u = bc[0];
                if (u >= 512) break;
                const int qb = u & 7, mp = (u >> 3) & 1, h = (u >> 4) & 7, b = u >> 7;
                const bf16_t* base = MP + (size_t)(b * RS) * MIXIN;
                if (PHM(6)) att::attn_body(base + (size_t)(CTX + qb * 256) * MIXIN + h * 128 + mp * 64, base + 1024 + h * 128 + mp * 64, base + 2048 + h * 128,
                               OATT + (size_t)mp * ML * 1024 + (size_t)(b * SEQ + qb * 256) * 1024 + h * 128, RS, (char*)smem);
            }
        }
        else if (PHM(7) && ph == 7) { merge_phase(a, G); }
        else if (PHM(8) && ph == 17) { conv_phase(a, G); }
        if (ph + 1 < a.ph_hi) xcd_barrier(bar);
      }
    }

}

extern "C" void kernel_launch(void* const* d_in, const int* in_sizes, int n_in, void* d_out, int out_size, void* d_ws, size_t ws_size, hipStream_t stream) {
    static int grid = 0;
    if (grid == 0) {
        if (n_in != 19 || out_size != ML * DM || ws_size < WS_END) { fprintf(stderr, "kernel_launch: unexpected shapes: n_in %d out %d ws %zu (need %zu)\n", n_in, out_size, ws_size, (size_t)WS_END); grid = -1; return; }
        int dev = 0, cus = 0, per_cu = 0;
        hipGetDevice(&dev); hipDeviceGetAttribute(&cus, hipDeviceAttributeMultiprocessorCount, dev);
        if (hipFuncSetAttribute((const void*)mega, hipFuncAttributeMaxDynamicSharedMemorySize, LDS_BYTES) != hipSuccess) { fprintf(stderr, "kernel_launch: hipFuncSetAttribute failed\n"); grid = -1; return; }
        if (hipOccupancyMaxActiveBlocksPerMultiprocessor(&per_cu, (const void*)mega, 512, LDS_BYTES) != hipSuccess || per_cu < 1) { fprintf(stderr, "kernel_launch: occupancy query gave %d\n", per_cu); per_cu = 1; }
        (void)hipGetLastError();
        grid = cus * per_cu;
        fprintf(stderr, "kernel_launch: grid %d (cus %d x %d)\n", grid, cus, per_cu);
    }
    if (grid < 0) return;
#if MK_DIAG_ZERO
    (void)hipMemsetAsync(d_ws, 0, WS_END, stream);
    (void)hipMemsetAsync(d_out, 0, (size_t)ML * DM * 4, stream);
#endif
    (void)hipMemsetAsync((unsigned char*)d_ws + WS_BAR, 0, 16384, stream);
    Args a{};
    for (int i = 0; i < 19; ++i) a.in[i] = (const float*)d_in[i];
    a.out = (float*)d_out; a.ws = (unsigned char*)d_ws;
#if MK_MULTI
    for (int ph = 0; ph < NPHASE; ++ph) { a.ph_lo = ph; a.ph_hi = ph + 1; hipLaunchKernelGGL(mega, dim3(grid), dim3(512), LDS_BYTES, stream, a); }
#else
    a.ph_lo = 0; a.ph_hi = NPHASE;
    void* args[] = {&a};
    hipError_t e = hipLaunchCooperativeKernel((const void*)mega, dim3(grid), dim3(512), args, LDS_BYTES, stream);
    if (e != hipSuccess) fprintf(stderr, "kernel_launch: cooperative launch failed: %s (grid %d)\n", hipGetErrorString(e), grid);
#endif
}
```

```cpp
#include <hip/hip_runtime.h>
#include <hip/hip_cooperative_groups.h>
#include <cstdio>
#include <cstdint>
namespace cg = cooperative_groups;

#ifndef MK_MULTI
#define MK_MULTI 0
#endif

#ifndef MK_PROBE
#define MK_PROBE 0
#endif
#ifndef MK_DIAG_ZERO
#define MK_DIAG_ZERO 0
#endif
#define LAS __attribute__((address_space(3)))
typedef unsigned short bf16_t;
typedef short bf16x8 __attribute__((ext_vector_type(8)));
typedef short s16x4 __attribute__((ext_vector_type(4)));
typedef float f32x2 __attribute__((ext_vector_type(2)));
typedef float f32x4 __attribute__((ext_vector_type(4)));
typedef float f32x16 __attribute__((ext_vector_type(16)));
typedef unsigned u32x2 __attribute__((ext_vector_type(2)));
typedef unsigned u32x4 __attribute__((ext_vector_type(4)));

constexpr int DM = 2048, NB = 4, SEQ = 2048, CTX = 256, RS = SEQ + CTX, MR = NB * RS, ML = NB * SEQ, DFF = 5504, MODW = 9 * DM, MIXIN = 8192;
constexpr float EPS = 1e-6f;
constexpr int NPHASE = 23;
constexpr int LDS_BYTES = 147456;

struct Args { const float* in[19]; float* out; unsigned char* ws; int ph_lo, ph_hi; };
enum { I_X = 0, I_C, I_CTX, I_CCTX, I_ADAW, I_ADAB, I_NORMG, I_WG, I_WU, I_WDN, I_MIXIN, I_MIXOUT, I_DLAM, I_DNG, I_RNG, I_RLB, I_CWIN, I_CW, I_CWOUT };

constexpr size_t WS_MOD = 0;
constexpr size_t WS_ROPE = WS_MOD + (size_t)2 * 5 * MODW * 4;
constexpr size_t SZ_WGU = (size_t)2 * DFF * DM * 2, SZ_WD = (size_t)DM * DFF * 2;
constexpr size_t WS_BAR = WS_ROPE + 8192;
constexpr size_t WS_WGU = WS_BAR + 16384;
constexpr size_t WS_WD = WS_WGU + 4 * SZ_WGU;
constexpr size_t WS_WMI = WS_WD + 4 * SZ_WD;
constexpr size_t WS_WMO = WS_WMI + (size_t)MIXIN * DM * 2;
constexpr size_t WS_WCI = WS_WMO + (size_t)DM * DM * 2;
constexpr size_t WS_WCO = WS_WCI + (size_t)3 * DM * DM * 2;
constexpr size_t WS_H = WS_WCO + (size_t)DM * DM * 2;
constexpr size_t WS_ACT = WS_H + (size_t)MR * DM * 2;
constexpr size_t WS_Y = WS_ACT + (size_t)MR * DFF * 2;
constexpr size_t WS_MP = WS_Y + (size_t)MR * DM * 4;
constexpr size_t WS_OATT = WS_MP + (size_t)MR * MIXIN * 2;
constexpr size_t WS_OREC = WS_OATT + (size_t)2 * ML * 1024 * 4;
constexpr size_t WS_MG = WS_OREC + (size_t)2 * ML * 1024 * 4;
constexpr size_t WS_XB = WS_MG + (size_t)ML * DM * 2;
constexpr size_t WS_END = WS_XB + (size_t)ML * DM * 2;

typedef __bf16 bf16x2_t __attribute__((ext_vector_type(2)));
__device__ __forceinline__ unsigned cvtpk(float lo, float hi) { const f32x2 v = {lo, hi}; const bf16x2_t b = __builtin_convertvector(v, bf16x2_t); return __builtin_bit_cast(unsigned, b); }
__device__ __forceinline__ float bflo(unsigned w) { return __uint_as_float(w << 16); }
__device__ __forceinline__ float bfhi(unsigned w) { return __uint_as_float(w & 0xffff0000u); }
__device__ __forceinline__ float wave_sum(float v) {
#pragma unroll
    for (int o = 1; o < 64; o <<= 1) v += __shfl_xor(v, o);
    return v;
}
__device__ __forceinline__ int otid() { int t = threadIdx.x; asm volatile("" : "+v"(t)); return t; }
__device__ __forceinline__ int obid() { int t = blockIdx.x; asm volatile("" : "+s"(t)); return t; }
__device__ __forceinline__ float sigmoidf_(float x) { return __builtin_amdgcn_rcpf(1.f + __expf(-x)); }
__device__ __forceinline__ float siluf_(float x) { return x * sigmoidf_(x); }

namespace pg8 {
#define PG8_LAS __attribute__((address_space(3)))
typedef unsigned short bf16_t;
typedef short bf16x8 __attribute__((ext_vector_type(8)));
typedef float f32x4 __attribute__((ext_vector_type(4)));
typedef unsigned u32x4 __attribute__((ext_vector_type(4)));
constexpr int BM = 256, BK = 64, HALF = 128, HTB = HALF * BK * 2  , STAGE_BYTES = 8 * HTB, NXCD = 8, WGM = 8;

__host__ __device__ __forceinline__ int lds_byte(int r, int c) { const int st = (r >> 4) * 2 + (c >> 5), rr = r & 15, cc = c & 31, ob = rr * 64 + cc * 2; return st * 1024 + (ob ^ (((ob >> 9) & 1) << 5)); }
__host__ __device__ __forceinline__ void stage_rc(int b, int& R, int& C) { const int st = b / 1024, sb = b % 1024, swz = sb ^ (((sb >> 9) & 1) << 5); R = (st >> 1) * 16 + swz / 64; C = (st & 1) * 32 + (swz % 64) / 2; }
__host__ __device__ __forceinline__ int perm32(int rho) { const int n = rho >> 4, i = rho & 15; return 8 * (i >> 2) + 4 * n + (i & 3); }

struct Unit { int pm, pn; };
struct Gemm { const bf16_t* A; const bf16_t* Bt; int M, N, K; };

struct StaticOrder {
    int nM, nN, nwg, G, c;
    __host__ __device__ void init(int M, int N, int G_, int c_) { nM = M / BM; nN = N / BM; nwg = nM * nN; G = G_; c = c_; }
    __host__ __device__ bool next(int i, Unit& u) const {
        const long L = (long)i * G + c; if (L >= nwg) return false;
        int wgid = (int)L; { const int q = nwg / NXCD, r = nwg % NXCD, xcd = wgid % NXCD, off = wgid / NXCD; wgid = (xcd < r ? xcd * (q + 1) : r * (q + 1) + (xcd - r) * q) + off; }
        const int nig = WGM * nN, gid = wgid / nig, fm = gid * WGM, gsz = (nM - fm) < WGM ? (nM - fm) : WGM;
        u.pm = fm + ((wgid % nig) % gsz); u.pn = (wgid % nig) / gsz; return true;
    }
    __device__ __forceinline__ void a_ready(const Unit&) const {}
    __device__ __forceinline__ void done(const Unit&) const {}
};

__device__ __forceinline__ unsigned cvt_pk_bf16(float lo, float hi) { return ::cvtpk(lo, hi); }
typedef float f32x2 __attribute__((ext_vector_type(2)));

__device__ __forceinline__ void st8_bf16(bf16_t* p, const f32x4 v0, const f32x4 v1) {
    u32x4 w; w.x = cvt_pk_bf16(v0[0], v0[1]); w.y = cvt_pk_bf16(v0[2], v0[3]); w.z = cvt_pk_bf16(v1[0], v1[1]); w.w = cvt_pk_bf16(v1[2], v1[3]); *(u32x4*)p = w;
}
__device__ __forceinline__ float silu_e(float g) { return g * __builtin_amdgcn_rcpf(1.f + __expf(-g)); }
struct EpiPair {
    static constexpr bool PERM = true, AFTER_DRAIN = false;
    bf16_t* O1; int ld1; bf16_t* O0; int ld0; int nplain; int silu;
    __device__ __forceinline__ void operator()(const f32x4 (&acc)[2][2][4][2], const Unit& u, int wr, int wc, int fr, int fq) const {
        const int row0 = u.pm * BM + wr * 64 + fr;
        if (u.pn < nplain) {
            const int col0 = u.pn * BM + wc * 32 + 8 * fq;
#pragma unroll
            for (int ai = 0; ai < 2; ++ai)
#pragma unroll
                for (int m = 0; m < 4; ++m) { bf16_t* rowp = O0 + (size_t)(row0 + ai * HALF + m * 16) * ld0 + col0;
#pragma unroll
                    for (int bj = 0; bj < 2; ++bj) st8_bf16(rowp + bj * HALF, acc[ai][bj][m][0], acc[ai][bj][m][1]); }
        } else {
            const int col0 = (u.pn - nplain) * HALF + wc * 32 + 8 * fq;
#pragma unroll
            for (int ai = 0; ai < 2; ++ai)
#pragma unroll
                for (int m = 0; m < 4; ++m) { bf16_t* rowp = O1 + (size_t)(row0 + ai * HALF + m * 16) * ld1 + col0;
                    f32x4 g0 = acc[ai][0][m][0], g1 = acc[ai][0][m][1]; const f32x4 u0 = acc[ai][1][m][0], u1 = acc[ai][1][m][1];
                    if (silu) {
#pragma unroll
                        for (int e = 0; e < 4; ++e) { g0[e] = silu_e(g0[e]); g1[e] = silu_e(g1[e]); } }
                    st8_bf16(rowp, g0 * u0, g1 * u1); }
        }
    }
};
struct EpiB16 {
    static constexpr bool PERM = true, AFTER_DRAIN = false;
    bf16_t* O; int ld;
    __device__ __forceinline__ void operator()(const f32x4 (&acc)[2][2][4][2], const Unit& u, int wr, int wc, int fr, int fq) const {
        const int row0 = u.pm * BM + wr * 64 + fr, col0 = u.pn * BM + wc * 32 + 8 * fq;
#pragma unroll
        for (int ai = 0; ai < 2; ++ai)
#pragma unroll
            for (int m = 0; m < 4; ++m) { bf16_t* rowp = O + (size_t)(row0 + ai * HALF + m * 16) * ld + col0;
#pragma unroll
                for (int bj = 0; bj < 2; ++bj) st8_bf16(rowp + bj * HALF, acc[ai][bj][m][0], acc[ai][bj][m][1]); }
    }
};
struct EpiMix {
    static constexpr bool PERM = true, AFTER_DRAIN = false;
    bf16_t* O; int ld; const f32x2* rope;
    __device__ __forceinline__ void operator()(const f32x4 (&acc)[2][2][4][2], const Unit& u, int wr, int wc, int fr, int fq) const {
        const int row0 = u.pm * BM + wr * 64 + fr, col0 = u.pn * BM + wc * 32 + 8 * fq;
        const int pmod = u.pm % 9;
        if (u.pn >= 8 || pmod == 0) {
#pragma unroll
            for (int ai = 0; ai < 2; ++ai)
#pragma unroll
                for (int m = 0; m < 4; ++m) { bf16_t* rowp = O + (size_t)(row0 + ai * HALF + m * 16) * ld + col0;
#pragma unroll
                    for (int bj = 0; bj < 2; ++bj) st8_bf16(rowp + bj * HALF, acc[ai][bj][m][0], acc[ai][bj][m][1]); }
        } else {
            const int half = wc & 1, i0 = 8 * (fq & 1); const float sgn = fq < 2 ? -1.f : 1.f;
#pragma unroll
            for (int ai = 0; ai < 2; ++ai) {
                const int tb = (pmod - 1) * 256 + ai * HALF + wr * 64;
#pragma unroll
                for (int m = 0; m < 4; ++m) {
                    const int pos = half ? (m * 16 + fr) : (tb >> 6);
                    const f32x4* rp = (const f32x4*)(rope + pos * 16 + i0);
                    const f32x4 c01 = rp[0], c23 = rp[1], c45 = rp[2], c67 = rp[3];
                    const float cs[8] = {c01[0], c01[2], c23[0], c23[2], c45[0], c45[2], c67[0], c67[2]};
                    const float sn[8] = {c01[1], c01[3], c23[1], c23[3], c45[1], c45[3], c67[1], c67[3]};
                    bf16_t* rowp = O + (size_t)(row0 + ai * HALF + m * 16) * ld + col0;
#pragma unroll
                    for (int bj = 0; bj < 2; ++bj) {
                        f32x4 v0 = acc[ai][bj][m][0], v1 = acc[ai][bj][m][1], o0, o1;
#pragma unroll
                        for (int e = 0; e < 4; ++e) { const float p0 = __shfl_xor(v0[e], 32), p1 = __shfl_xor(v1[e], 32);
                            o0[e] = v0[e] * cs[e] + sgn * p0 * sn[e]; o1[e] = v1[e] * cs[4 + e] + sgn * p1 * sn[4 + e]; }
                        st8_bf16(rowp + bj * HALF, o0, o1);
                    }
                }
            }
        }
    }
};

template <class Epi, class Sched, bool ALIGN_EPI = false, bool SP2 = false>
__device__ __forceinline__ void gemm_phase(PG8_LAS unsigned char* lds, const Gemm g, const Sched& S, const Epi& E) {
    const int tid = otid(), wid = __builtin_amdgcn_readfirstlane(tid >> 6), lane = tid & 63, wr = wid >> 2, wc = wid & 3, fr = lane & 15, fq = lane >> 4;
    const int K = g.K, nt = K / BK;
    unsigned voffA[2], voffB[2];
#pragma unroll
    for (int i = 0; i < 2; ++i) { int R, C; stage_rc(tid * 16 + i * 8192, R, C); const int Rb = Epi::PERM ? ((R & ~31) + perm32(R & 31)) : R;
        voffA[i] = (unsigned)(R * K + C) * 2u; voffB[i] = (unsigned)(Rb * K + C) * 2u; }
    const size_t kstep = (size_t)(BK * 2);
    const size_t hstep = (size_t)HALF * K * 2;
    const size_t tstep = 2 * hstep;
    const unsigned ldsw = (unsigned)wid * 1024u;
    const int aoff = lds_byte(wr * 64 + fr, fq * 8), boff = lds_byte(wc * 32 + fr, fq * 8);
#define PG8_SA(b, h) (((b) * 2 + (h)) * HTB)
#define PG8_SB(b, h) ((4 + (b) * 2 + (h)) * HTB)
#define PG8_STAGE(bufoff, gbase, voff) do { _Pragma("unroll") for (int _i = 0; _i < 2; ++_i) \
        __builtin_amdgcn_global_load_lds((const unsigned*)((const char*)(gbase) + (voff)[_i]), (PG8_LAS unsigned*)(lds + (bufoff) + ldsw + _i * 8192), 16, 0, 0); } while (0)
#define PG8_LDA(dst, b, h) do { _Pragma("unroll") for (int m = 0; m < 4; ++m) _Pragma("unroll") for (int k = 0; k < 2; ++k) dst[m][k] = *(const PG8_LAS bf16x8*)(lds + PG8_SA(b, h) + aoff + m * 2048 + k * 1024); } while (0)
#define PG8_LDB(dst, b, h) do { _Pragma("unroll") for (int n = 0; n < 2; ++n) _Pragma("unroll") for (int k = 0; k < 2; ++k) dst[n][k] = *(const PG8_LAS bf16x8*)(lds + PG8_SB(b, h) + boff + n * 2048 + k * 1024); } while (0)
#define PG8_MMA(ai, bj, At, Bt) do { __builtin_amdgcn_s_setprio(1); _Pragma("unroll") for (int m = 0; m < 4; ++m) _Pragma("unroll") for (int n = 0; n < 2; ++n) _Pragma("unroll") for (int k = 0; k < 2; ++k) \
        acc[ai][bj][m][n] = __builtin_amdgcn_mfma_f32_16x16x32_bf16(Bt[n][k], At[m][k], acc[ai][bj][m][n], 0, 0, 0); __builtin_amdgcn_s_setprio(0); } while (0)
#define PG8_WAIT_V(n) asm volatile("s_waitcnt vmcnt(" #n ")" ::: "memory")
#define PG8_WAIT_L(n) asm volatile("s_waitcnt lgkmcnt(" #n ")" ::: "memory")
#define PG8_BAR __builtin_amdgcn_s_barrier()
#define PG8_SCHED __builtin_amdgcn_sched_barrier(0)
    Unit cur, nxt; int ui = 0;
    if (!S.next(0, cur)) return;
    f32x4 acc[2][2][4][2];
#pragma unroll
    for (int a = 0; a < 2; ++a)
#pragma unroll
        for (int b = 0; b < 2; ++b)
#pragma unroll
            for (int m = 0; m < 4; ++m)
#pragma unroll
                for (int n = 0; n < 2; ++n) acc[a][b][m][n] = (f32x4){0.f, 0.f, 0.f, 0.f};
    bf16x8 At[4][2], B0[2][2], B1[2][2];
    const char* cA = (const char*)g.A + (size_t)cur.pm * tstep; const char* cB = (const char*)g.Bt + (size_t)cur.pn * tstep;
    S.a_ready(cur);
    if constexpr (SP2) {
        PG8_STAGE(PG8_SB(0, 0), cB, voffB); PG8_STAGE(PG8_SB(0, 1), cB + hstep, voffB); PG8_STAGE(PG8_SA(0, 0), cA, voffA); PG8_STAGE(PG8_SA(0, 1), cA + hstep, voffA);
        if (wr == 1) PG8_BAR;
        PG8_WAIT_V(2); PG8_BAR;
        PG8_STAGE(PG8_SB(1, 0), cB + kstep, voffB); PG8_STAGE(PG8_SA(1, 0), cA + kstep, voffA); PG8_STAGE(PG8_SB(1, 1), cB + hstep + kstep, voffB);
        PG8_WAIT_V(6); PG8_BAR;
    } else {
        PG8_STAGE(PG8_SB(0, 0), cB, voffB); PG8_STAGE(PG8_SA(0, 0), cA, voffA); PG8_STAGE(PG8_SB(0, 1), cB + hstep, voffB); PG8_STAGE(PG8_SA(0, 1), cA + hstep, voffA);
        if (wr == 1) PG8_BAR;
        PG8_WAIT_V(4); PG8_BAR;
        PG8_STAGE(PG8_SB(1, 0), cB + kstep, voffB); PG8_STAGE(PG8_SA(1, 0), cA + kstep, voffA); PG8_STAGE(PG8_SB(1, 1), cB + hstep + kstep, voffB);
        PG8_WAIT_V(6); PG8_BAR;
    }
    for (;;) {
        const bool has_next = S.next(ui + 1, nxt);
        const char* nA = has_next ? (const char*)g.A + (size_t)nxt.pm * tstep : cA; const char* nB = has_next ? (const char*)g.Bt + (size_t)nxt.pn * tstep : cB;
        for (int t = 0; t < nt; t += 2) {
            const bool last = (t == nt - 2);
            const char* a1 = cA + (size_t)(t + 1) * kstep;
            const char* a2 = last ? nA : cA + (size_t)(t + 2) * kstep; const char* b2 = last ? nB : cB + (size_t)(t + 2) * kstep;
            const char* a3 = a2 + kstep; const char* b3 = b2 + kstep;
            if (last && has_next) S.a_ready(nxt);
            if constexpr (SP2) {
            PG8_LDB(B0, 0, 0); PG8_LDB(B1, 0, 1); PG8_SCHED; PG8_LDA(At, 0, 0); PG8_STAGE(PG8_SA(1, 1), a1 + hstep, voffA);
            PG8_WAIT_V(8); PG8_WAIT_L(0); PG8_BAR; PG8_MMA(0, 0, At, B0); PG8_MMA(0, 1, At, B1); PG8_BAR; PG8_SCHED;
            PG8_LDA(At, 0, 1); PG8_STAGE(PG8_SB(0, 0), b2, voffB); PG8_STAGE(PG8_SB(0, 1), b2 + hstep, voffB); PG8_STAGE(PG8_SA(0, 0), a2, voffA);
            PG8_WAIT_V(8); PG8_WAIT_L(0); PG8_BAR; PG8_MMA(1, 0, At, B0); PG8_MMA(1, 1, At, B1); PG8_BAR; PG8_SCHED;
            PG8_LDB(B0, 1, 0); PG8_LDB(B1, 1, 1); PG8_SCHED; PG8_LDA(At, 1, 0); PG8_STAGE(PG8_SA(0, 1), a2 + hstep, voffA);
            PG8_WAIT_V(8); PG8_WAIT_L(0); PG8_BAR; PG8_MMA(0, 0, At, B0); PG8_MMA(0, 1, At, B1); PG8_BAR; PG8_SCHED;
            PG8_LDA(At, 1, 1); PG8_STAGE(PG8_SB(1, 0), b3, voffB); PG8_STAGE(PG8_SB(1, 1), b3 + hstep, voffB); PG8_STAGE(PG8_SA(1, 0), a3, voffA);
            PG8_WAIT_V(8); PG8_WAIT_L(0); PG8_BAR; PG8_MMA(1, 0, At, B0); PG8_MMA(1, 1, At, B1); PG8_BAR; PG8_SCHED;
            } else {
            PG8_LDB(B0, 0, 0); PG8_SCHED; PG8_LDA(At, 0, 0); PG8_STAGE(PG8_SA(1, 1), a1 + hstep, voffA);
            PG8_WAIT_L(8); PG8_BAR; PG8_WAIT_L(0); PG8_MMA(0, 0, At, B0); PG8_BAR; PG8_SCHED;
            PG8_LDB(B1, 0, 1); PG8_STAGE(PG8_SB(0, 0), b2, voffB);
            PG8_BAR; PG8_WAIT_L(0); PG8_MMA(0, 1, At, B1); PG8_BAR;
            PG8_LDA(At, 0, 1); PG8_STAGE(PG8_SA(0, 0), a2, voffA);
            PG8_BAR; PG8_WAIT_L(0); PG8_MMA(1, 0, At, B0); PG8_BAR; PG8_SCHED;
            PG8_STAGE(PG8_SB(0, 1), b2 + hstep, voffB);
            PG8_WAIT_V(6); PG8_BAR; PG8_MMA(1, 1, At, B1); PG8_BAR;
            PG8_LDB(B0, 1, 0); PG8_SCHED; PG8_LDA(At, 1, 0); PG8_STAGE(PG8_SA(0, 1), a2 + hstep, voffA);
            PG8_WAIT_L(8); PG8_BAR; PG8_WAIT_L(0); PG8_MMA(0, 0, At, B0); PG8_BAR; PG8_SCHED;
            PG8_LDB(B1, 1, 1); PG8_STAGE(PG8_SB(1, 0), b3, voffB);
            PG8_BAR; PG8_WAIT_L(0); PG8_MMA(0, 1, At, B1); PG8_BAR;
            PG8_LDA(At, 1, 1); PG8_STAGE(PG8_SA(1, 0), a3, voffA);
            PG8_BAR; PG8_WAIT_L(0); PG8_MMA(1, 0, At, B0); PG8_BAR; PG8_SCHED;
            PG8_STAGE(PG8_SB(1, 1), b3 + hstep, voffB);
            PG8_WAIT_V(6); PG8_BAR; PG8_MMA(1, 1, At, B1); PG8_BAR;
            }
        }
        if constexpr (ALIGN_EPI) { if (wr == 0) PG8_BAR; }
        if constexpr (!Epi::AFTER_DRAIN) { E(acc, cur, wr, wc, fr, fq); S.done(cur); }
        if (!has_next) break;
#pragma unroll
        for (int a = 0; a < 2; ++a)
#pragma unroll
            for (int b = 0; b < 2; ++b)
#pragma unroll
                for (int m = 0; m < 4; ++m)
#pragma unroll
                    for (int n = 0; n < 2; ++n) acc[a][b][m][n] = (f32x4){0.f, 0.f, 0.f, 0.f};
        cur = nxt; cA = nA; cB = nB; ++ui;
        if constexpr (ALIGN_EPI) { if (wr == 1) PG8_BAR; }
    }
    PG8_WAIT_V(0);
    if constexpr (!ALIGN_EPI) { if (wr == 0) PG8_BAR; }
    PG8_BAR;
    if constexpr (Epi::AFTER_DRAIN) { E.fused(acc, cur, wr, wc, fr, fq, lds, wid, lane); S.done(cur); }
#undef PG8_SA
#undef PG8_SB
#undef PG8_STAGE
#undef PG8_LDA
#undef PG8_LDB
#undef PG8_MMA
#undef PG8_WAIT_V
#undef PG8_WAIT_L
#undef PG8_BAR
#undef PG8_SCHED
}
}

namespace att {
constexpr int NW = 8, QBLK = 32, KVBLK = 64, DV = 128, DQ = 64;
constexpr float SCALE = 0.125f, THR = 8.f;
constexpr int LDQ = MIXIN, LDK = MIXIN, LDO = 1024;
constexpr int SHM_V = KVBLK * DV * 2, SHM_K = KVBLK * DQ * 2, SHM_ATTN = 2 * SHM_V + 2 * SHM_K + NW * 64 * 4;
#define KSWZ(row, colB) ((row) * 128 + ((colB) ^ (((row) & 7) << 4)))
#define SBAR() __builtin_amdgcn_sched_barrier(0)
__device__ __forceinline__ int crow(int r, int hi) { return (r & 3) + 8 * (r >> 2) + 4 * hi; }
__device__ __forceinline__ unsigned cvtpkv(float lo, float hi) { unsigned r; asm volatile("v_cvt_pk_bf16_f32 %0, %1, %2" : "=v"(r) : "v"(lo), "v"(hi)); return r; }
__device__ __forceinline__ void partialSM(f32x16& p0, f32x16& p1, float& m_reg, float& mn, float& alpha) {
  constexpr float C = SCALE * 1.4426950408889634f;
  float pmax = p0[0]; for (int r = 1; r < 16; ++r) pmax = fmaxf(pmax, p0[r]); for (int r = 0; r < 16; ++r) pmax = fmaxf(pmax, p1[r]);
  { auto rr = __builtin_amdgcn_permlane32_swap(__float_as_uint(pmax), __float_as_uint(pmax), false, false);
    pmax = fmaxf(__uint_as_float(rr[0]), __uint_as_float(rr[1])); }
  if (__builtin_expect(__all(pmax - m_reg <= THR / SCALE), 1)) { mn = m_reg; alpha = 1.f; }
  else { mn = fmaxf(m_reg, pmax); alpha = __builtin_amdgcn_exp2f((m_reg - mn) * C); m_reg = mn; }
  float mnC = -mn * C;
  for (int r = 0; r < 16; ++r) p0[r] = fmaf(p0[r], C, mnC); for (int r = 0; r < 16; ++r) p1[r] = fmaf(p1[r], C, mnC);
  for (int r = 0; r < 16; ++r) p0[r] = __builtin_amdgcn_exp2f(p0[r]);
}
__device__ __forceinline__ void finishSM(f32x16& p0, f32x16& p1, float alpha, float& l_reg, bf16x8& pa0, bf16x8& pa1, bf16x8& pa2, bf16x8& pa3) {
  for (int r = 0; r < 16; ++r) p1[r] = __builtin_amdgcn_exp2f(p1[r]);
  float ps = 0; for (int r = 0; r < 16; ++r) ps += p0[r]; for (int r = 0; r < 16; ++r) ps += p1[r];
  { auto rr = __builtin_amdgcn_permlane32_swap(__float_as_uint(ps), __float_as_uint(ps), false, false);
    ps = __uint_as_float(rr[0]) + __uint_as_float(rr[1]); }
  l_reg = l_reg * alpha + ps;
#define PK4(P, BASE, OUT) do { unsigned a0 = cvtpkv(P[BASE + 0], P[BASE + 1]), a1 = cvtpkv(P[BASE + 2], P[BASE + 3]);   \
    unsigned b0 = cvtpkv(P[BASE + 4], P[BASE + 5]), b1 = cvtpkv(P[BASE + 6], P[BASE + 7]);                              \
    auto r0 = __builtin_amdgcn_permlane32_swap(a0, b0, false, false); auto r1 = __builtin_amdgcn_permlane32_swap(a1, b1, false, false); \
    u32x4 w = {r0[0], r1[0], r0[1], r1[1]}; OUT = *reinterpret_cast<bf16x8*>(&w); } while (0)
  PK4(p0, 0, pa0); PK4(p0, 8, pa1); PK4(p1, 0, pa2); PK4(p1, 8, pa3);
#undef PK4
}
__device__ __forceinline__ void qkt(f32x16& p0, f32x16& p1, const bf16_t* Ks, const bf16x8* qr, int r32, int hi) {
  p0 = f32x16{}; p1 = f32x16{};
#pragma unroll
  for (int d0 = 0; d0 < 4; ++d0) { int cb = (d0 * 16 + hi * 8) * 2;
    bf16x8 b0 = *reinterpret_cast<const bf16x8*>((const char*)Ks + KSWZ(r32, cb));
    bf16x8 b1 = *reinterpret_cast<const bf16x8*>((const char*)Ks + KSWZ(32 + r32, cb));
    p0 = __builtin_amdgcn_mfma_f32_32x32x16_bf16(b0, qr[d0], p0, 0, 0, 0);
    p1 = __builtin_amdgcn_mfma_f32_32x32x16_bf16(b1, qr[d0], p1, 0, 0, 0); }
}
__device__ __forceinline__ int v_st(int k, int c) { const int kk = (k & ~0xC) | ((k & 4) << 1) | ((k & 8) >> 1); return ((kk >> 3) * 4 + (c >> 5)) * 512 + ((kk & 7) * 32 + (c & 31)) * 2; }
__device__ __forceinline__ int v_rd_base(int lane) { return ((lane & 3) << 3) | (((lane >> 2) & 3) << 6) | (((lane >> 4) & 1) << 5) | (((lane >> 5) & 1) << 8); }
constexpr int v_rd_off(int d0, int ks, int half) { return d0 * 512 + ks * 4096 + half * 2048; }
template <int OFF> __device__ __forceinline__ s16x4 tr_read(int vb) {
  s16x4 r; asm volatile("ds_read_b64_tr_b16 %0, %1 offset:%2" : "=&v"(r) : "v"(vb), "i"(OFF) : "memory"); return r;
}
template <int D0> __device__ __forceinline__ void pv_one(f32x16& od, int vb, bf16x8 pa0, bf16x8 pa1, bf16x8 pa2, bf16x8 pa3) {
  const s16x4 l0 = tr_read<v_rd_off(D0, 0, 0)>(vb), h0 = tr_read<v_rd_off(D0, 0, 1)>(vb), l1 = tr_read<v_rd_off(D0, 1, 0)>(vb), h1 = tr_read<v_rd_off(D0, 1, 1)>(vb);
  const s16x4 l2 = tr_read<v_rd_off(D0, 2, 0)>(vb), h2 = tr_read<v_rd_off(D0, 2, 1)>(vb), l3 = tr_read<v_rd_off(D0, 3, 0)>(vb), h3 = tr_read<v_rd_off(D0, 3, 1)>(vb);
  asm volatile("s_waitcnt lgkmcnt(0)" ::: "memory"); SBAR();
#define PK(L, H) (bf16x8){L[0], L[1], L[2], L[3], H[0], H[1], H[2], H[3]}
  od = __builtin_amdgcn_mfma_f32_32x32x16_bf16(pa0, PK(l0, h0), od, 0, 0, 0);
  od = __builtin_amdgcn_mfma_f32_32x32x16_bf16(pa1, PK(l1, h1), od, 0, 0, 0);
  od = __builtin_amdgcn_mfma_f32_32x32x16_bf16(pa2, PK(l2, h2), od, 0, 0, 0);
  od = __builtin_amdgcn_mfma_f32_32x32x16_bf16(pa3, PK(l3, h3), od, 0, 0, 0);
#undef PK
}
__device__ __forceinline__ void pv_d0(f32x16* o, int vb, bf16x8 pa0, bf16x8 pa1, bf16x8 pa2, bf16x8 pa3) {
  pv_one<0>(o[0], vb, pa0, pa1, pa2, pa3); pv_one<1>(o[1], vb, pa0, pa1, pa2, pa3); pv_one<2>(o[2], vb, pa0, pa1, pa2, pa3); pv_one<3>(o[3], vb, pa0, pa1, pa2, pa3);
}
__device__ __forceinline__ void attn_body(const bf16_t* __restrict__ Qb, const bf16_t* __restrict__ Kh, const bf16_t* __restrict__ Vh, float* __restrict__ Ob, int seq, char* lds) {
  const int tid = otid(), wid = tid >> 6, lane = tid & 63, r32 = lane & 31, hi = lane >> 5;
  bf16_t* V_lds = (bf16_t*)lds; bf16_t* K_lds = (bf16_t*)(lds + 2 * SHM_V);
  float* ws = (float*)(lds + 2 * SHM_V + 2 * SHM_K) + wid * 64; float* li_l = ws; float* al_l = ws + 32;
  float m_reg = -1e30f, l_reg = 0; f32x16 o[4] = {}; bf16x8 qr[4];
  const bf16_t* Qw = Qb + (long)(wid * QBLK + r32) * LDQ + hi * 8;
#pragma unroll
  for (int d0 = 0; d0 < 4; ++d0) qr[d0] = *reinterpret_cast<const bf16x8*>(Qw + d0 * 16);
  const int sr = tid >> 4, sc = (tid & 15) * 8, vst0 = v_st(sr, sc), vst1 = v_st(32 + sr, sc);
  const int kr = tid >> 3, kc = (tid & 7) * 8, kst = KSWZ(kr, kc * 2);
  const int vb0 = (int)(uintptr_t)V_lds + v_rd_base(lane);
  struct { bf16x8 vs0, vs1, ks0; } sr_[2];
#define SLOAD(i, k0) do { sr_[i].vs0 = *reinterpret_cast<const bf16x8*>(&Vh[(long)((k0) + sr) * LDK + sc]); sr_[i].vs1 = *reinterpret_cast<const bf16x8*>(&Vh[(long)((k0) + 32 + sr) * LDK + sc]); \
    sr_[i].ks0 = *reinterpret_cast<const bf16x8*>(&Kh[(long)((k0) + kr) * LDK + kc]); } while (0)
#define SWRITE(b, i) do { *(bf16x8*)((char*)V_lds + (b) * SHM_V + vst0) = sr_[i].vs0;          \
    *(bf16x8*)((char*)V_lds + (b) * SHM_V + vst1) = sr_[i].vs1;                                  \
    *(bf16x8*)((char*)K_lds + (b) * SHM_K + kst) = sr_[i].ks0; } while (0)
#define SWAIT() asm volatile("s_waitcnt vmcnt(3)" ::: "memory")
#define RESC(a) do { if (__any((a) < 1.f)) { if (hi == 0) al_l[r32] = (a); asm volatile("s_waitcnt lgkmcnt(0)" ::: "memory"); \
    for (int d = 0; d < 4; ++d) for (int r = 0; r < 16; ++r) o[d][r] *= al_l[crow(r, hi)]; } } while (0)
  f32x16 pA0, pA1, pB0, pB1; float mnA, mnB, alA, alB; bf16x8 pa0, pa1, pa2, pa3; const int NT = seq / KVBLK;
  constexpr int SE = 0, SO = 1;
  SLOAD(SE, 0); asm volatile("s_waitcnt vmcnt(0)" ::: "memory"); SWRITE(0, SE); __syncthreads();
  qkt(pA0, pA1, K_lds, qr, r32, hi); partialSM(pA0, pA1, m_reg, mnA, alA);
  SLOAD(SO, KVBLK); if (2 < NT) SLOAD(SE, 2 * KVBLK);
  SWAIT(); SWRITE(1, SO); __syncthreads();
  for (int j = 1; j + 1 < NT; j += 2) {
    SBAR(); qkt(pB0, pB1, (bf16_t*)((char*)K_lds + SHM_K), qr, r32, hi);
    finishSM(pA0, pA1, alA, l_reg, pa0, pa1, pa2, pa3); SBAR();
    SLOAD(SO, (j + 2) * KVBLK); SBAR();
    pv_d0(o, vb0, pa0, pa1, pa2, pa3); partialSM(pB0, pB1, m_reg, mnB, alB);
    __syncthreads(); SWAIT(); SWRITE(0, SE);
    RESC(alB); __syncthreads();
    SBAR(); qkt(pA0, pA1, K_lds, qr, r32, hi);
    finishSM(pB0, pB1, alB, l_reg, pa0, pa1, pa2, pa3); SBAR();
    if (j + 3 < NT) SLOAD(SE, (j + 3) * KVBLK); SBAR();
    pv_d0(o, vb0 + (int)SHM_V, pa0, pa1, pa2, pa3); partialSM(pA0, pA1, m_reg, mnA, alA);
    __syncthreads(); SWAIT(); SWRITE(1, SO);
    RESC(alA); __syncthreads();
  }
  SBAR(); qkt(pB0, pB1, (bf16_t*)((char*)K_lds + SHM_K), qr, r32, hi);
  finishSM(pA0, pA1, alA, l_reg, pa0, pa1, pa2, pa3); SBAR();
  pv_d0(o, vb0, pa0, pa1, pa2, pa3); partialSM(pB0, pB1, m_reg, mnB, alB);
  __syncthreads(); RESC(alB);
  finishSM(pB0, pB1, alB, l_reg, pa0, pa1, pa2, pa3); SBAR();
  pv_d0(o, vb0 + (int)SHM_V, pa0, pa1, pa2, pa3);
  if (hi == 0) li_l[r32] = l_reg; asm volatile("s_waitcnt lgkmcnt(0)" ::: "memory");
  float rli[16];
#pragma unroll
  for (int r = 0; r < 16; ++r) rli[r] = __builtin_amdgcn_rcpf(li_l[crow(r, hi)]);
  float* Ow = Ob + (long)(wid * QBLK) * LDO;
#pragma unroll
  for (int r = 0; r < 16; ++r) { int orow = crow(r, hi);
    for (int d0 = 0; d0 < 4; ++d0) Ow[(long)orow * LDO + d0 * 32 + r32] = o[d0][r] * rli[r]; }
#undef SLOAD
#undef SWRITE
#undef SWAIT
#undef RESC
}
}

__device__ __forceinline__ int hcrow(int r, int hi) { return (r & 3) + 8 * (r >> 2) + 4 * hi; }
__device__ __forceinline__ void hgrn_unit(const Args& a, LAS unsigned char* lds, int unit) {
    const int tid = otid(), w = __builtin_amdgcn_readfirstlane(tid >> 6), lane = tid & 63, r32 = lane & 31, hi = lane >> 5;
    const int dir = unit & 1, h = (unit >> 1) & 7, b = unit >> 4;
    constexpr int PQ = 136, PS = 72;
    LAS bf16_t* Qt = (LAS bf16_t*)lds;
    LAS bf16_t* Kt = Qt + 64 * PQ;
    LAS bf16_t* KhT = Kt + 64 * PQ;
    LAS bf16_t* Vt = KhT + 128 * PS;
    LAS bf16_t* At = Vt + 128 * PS;
    LAS bf16_t* St = At + 64 * PS;
    LAS float* part = (LAS float*)(St + 128 * PQ);
    LAS float* dec = part + 8 * 128;
    const bf16_t* MP = (const bf16_t*)(a.ws + WS_MP);
    float* OREC = (float*)(a.ws + WS_OREC) + (size_t)dir * ML * 1024;
    const int kp = lane;
    float lb[2];
#pragma unroll
    for (int j = 0; j < 2; ++j) { const float a0 = a.in[I_RLB][(dir * 2 + 0) * 1024 + h * 128 + 2 * kp + j], a1 = a.in[I_RLB][(dir * 2 + 1) * 1024 + h * 128 + 2 * kp + j];
        lb[j] = 1.f / (1.f + __expf(a1 - a0)); }
    __syncthreads();
    for (int i = tid; i < 128 * PQ / 2; i += 512) ((LAS unsigned*)St)[i] = 0u;
    f32x16 S[2] = {};
    unsigned q2[8], z2[8], v2[8];
    const int zcol = (dir ? 5120 : 4096) + h * 128 + 2 * kp, qcol = 3072 + h * 128 + 2 * kp, vcol = 6144 + h * 128 + 2 * kp;
#define HG_ROWBASE(c) (b * RS + (dir ? ((c) < 4 ? 192 - 64 * (c) : RS - 64 * ((c) - 3)) : 64 * (c)))
#define HG_LOAD(c) do { const int rb_ = HG_ROWBASE(c); _Pragma("unroll") for (int e = 0; e < 8; ++e) { const int tau = 8 * w + e, rr = dir ? 63 - tau : tau; \
        const bf16_t* rp = MP + (size_t)(rb_ + rr) * MIXIN; q2[e] = *(const unsigned*)(rp + qcol); z2[e] = *(const unsigned*)(rp + zcol); v2[e] = *(const unsigned*)(rp + vcol); } } while (0)
    HG_LOAD(0);
    const int ti = w >> 2, vi = w & 3, ki = w >> 1, vi0 = 2 * (w & 1);
    for (int c = 0; c < 36; ++c) {
        const int rowbase = HG_ROWBASE(c);
        float Pl[8][2], fk[8][2]; float p0 = 1.f, p1 = 1.f;
#pragma unroll
        for (int e = 0; e < 8; ++e) {
            const float f0 = lb[0] + (1.f - lb[0]) * sigmoidf_(bflo(z2[e])), f1 = lb[1] + (1.f - lb[1]) * sigmoidf_(bfhi(z2[e]));
            p0 *= f0; p1 *= f1; Pl[e][0] = p0; Pl[e][1] = p1; fk[e][0] = 1.f - f0; fk[e][1] = 1.f - f1;
        }
        *(LAS f32x2*)(part + w * 128 + 2 * kp) = (f32x2){p0, p1};
        __syncthreads();
        float off0 = 1.f, off1 = 1.f, tot0 = 1.f, tot1 = 1.f;
#pragma unroll
        for (int x = 0; x < 8; ++x) { const f32x2 pp = *(LAS f32x2*)(part + x * 128 + 2 * kp); tot0 *= pp[0]; tot1 *= pp[1]; if (x < w) { off0 *= pp[0]; off1 *= pp[1]; } }
        unsigned kh0[4], kh1[4], vt0[4], vt1[4];
        float kha[8][2];
#pragma unroll
        for (int e = 0; e < 8; ++e) {
            const int tau = 8 * w + e;
            const float P0 = fmaxf(off0 * Pl[e][0], 1e-35f), P1 = fmaxf(off1 * Pl[e][1], 1e-35f);
            const float i0 = __builtin_amdgcn_rcpf(P0), i1 = __builtin_amdgcn_rcpf(P1);
            const float qs0 = bflo(q2[e]) * 0.08838834764831845f * P0, qs1 = bfhi(q2[e]) * 0.08838834764831845f * P1;
            const float kt0 = fk[e][0] * i0, kt1 = fk[e][1] * i1;
            kha[e][0] = kt0 * tot0; kha[e][1] = kt1 * tot1;
            *(LAS unsigned*)(Qt + tau * PQ + 2 * kp) = cvtpk(qs0, qs1);
            *(LAS unsigned*)(Kt + tau * PQ + 2 * kp) = cvtpk(kt0, kt1);
        }
#pragma unroll
        for (int e = 0; e < 4; ++e) { kh0[e] = cvtpk(kha[2 * e][0], kha[2 * e + 1][0]); kh1[e] = cvtpk(kha[2 * e][1], kha[2 * e + 1][1]);
            vt0[e] = (v2[2 * e] & 0xffffu) | (v2[2 * e + 1] << 16); vt1[e] = (v2[2 * e] >> 16) | (v2[2 * e + 1] & 0xffff0000u); }
        *(LAS u32x4*)(KhT + (2 * kp) * PS + 8 * w) = (u32x4){kh0[0], kh0[1], kh0[2], kh0[3]};
        *(LAS u32x4*)(KhT + (2 * kp + 1) * PS + 8 * w) = (u32x4){kh1[0], kh1[1], kh1[2], kh1[3]};
        *(LAS u32x4*)(Vt + (2 * kp) * PS + 8 * w) = (u32x4){vt0[0], vt0[1], vt0[2], vt0[3]};
        *(LAS u32x4*)(Vt + (2 * kp + 1) * PS + 8 * w) = (u32x4){vt1[0], vt1[1], vt1[2], vt1[3]};
        if (w == 0) *(LAS f32x2*)(dec + 2 * kp) = (f32x2){tot0, tot1};
        if (c + 1 < 36) HG_LOAD(c + 1);
        __syncthreads();
        const bool outc = c >= 4;
        f32x16 o = {};
        if (outc) {
#pragma unroll
            for (int j = 0; j < 8; ++j) { const bf16x8 A = *(const LAS bf16x8*)(Qt + (32 * ti + r32) * PQ + 16 * j + 8 * hi), B = *(const LAS bf16x8*)(St + (32 * vi + r32) * PQ + 16 * j + 8 * hi);
                o = __builtin_amdgcn_mfma_f32_32x32x16_bf16(A, B, o, 0, 0, 0); }
            if (w < 4) {
                const int ta = w >> 1, sa = w & 1;
                f32x16 acc = {};
                if (sa <= ta) {
#pragma unroll
                    for (int j = 0; j < 8; ++j) { const bf16x8 A = *(const LAS bf16x8*)(Qt + (32 * ta + r32) * PQ + 16 * j + 8 * hi), B = *(const LAS bf16x8*)(Kt + (32 * sa + r32) * PQ + 16 * j + 8 * hi);
                        acc = __builtin_amdgcn_mfma_f32_32x32x16_bf16(A, B, acc, 0, 0, 0); }
                }
#pragma unroll
                for (int i = 0; i < 16; ++i) { const int t = 32 * ta + hcrow(i, hi), s = 32 * sa + r32; const float v = (s <= t) ? acc[i] : 0.f;
                    At[t * PS + s] = (bf16_t)(cvtpk(v, 0.f) & 0xffffu); }
            }
        }
#pragma unroll
        for (int x = 0; x < 2; ++x) {
#pragma unroll
            for (int i = 0; i < 16; ++i) S[x][i] *= dec[32 * ki + hcrow(i, hi)];
#pragma unroll
            for (int j = 0; j < 4; ++j) { const bf16x8 A = *(const LAS bf16x8*)(KhT + (32 * ki + r32) * PS + 16 * j + 8 * hi), B = *(const LAS bf16x8*)(Vt + (32 * (vi0 + x) + r32) * PS + 16 * j + 8 * hi);
                S[x] = __builtin_amdgcn_mfma_f32_32x32x16_bf16(A, B, S[x], 0, 0, 0); }
        }
        __syncthreads();
        if (outc) {
#pragma unroll
            for (int j = 0; j < 4; ++j) { const bf16x8 A = *(const LAS bf16x8*)(At + (32 * ti + r32) * PS + 16 * j + 8 * hi), B = *(const LAS bf16x8*)(Vt + (32 * vi + r32) * PS + 16 * j + 8 * hi);
                o = __builtin_amdgcn_mfma_f32_32x32x16_bf16(A, B, o, 0, 0, 0); }
#pragma unroll
            for (int i = 0; i < 16; ++i) { const int tau = 32 * ti + hcrow(i, hi), rr = dir ? 63 - tau : tau; const int lrow = rowbase + rr - 256 * (b + 1);
                OREC[(size_t)lrow * 1024 + h * 128 + 32 * vi + r32] = o[i]; }
        }
#pragma unroll
        for (int x = 0; x < 2; ++x)
#pragma unroll
            for (int g = 0; g < 4; ++g) { const int k0 = 32 * ki + 8 * g + 4 * hi;
                *(LAS u32x2*)(St + (32 * (vi0 + x) + r32) * PQ + k0) = (u32x2){cvtpk(S[x][4 * g], S[x][4 * g + 1]), cvtpk(S[x][4 * g + 2], S[x][4 * g + 3])}; }
    }
    __syncthreads();
#undef HG_LOAD
#undef HG_ROWBASE
}

__device__ __forceinline__ void transpose_item(const float* __restrict__ src, int ldn, int k0, int n0, bf16_t* __restrict__ dst, int Kd, int drow, LAS float* scr, int lane) {
    const int cl = (lane & 15) * 4, ks = lane >> 4;
    f32x4 v[16];
#pragma unroll
    for (int i = 0; i < 16; ++i) v[i] = __builtin_nontemporal_load((const f32x4*)(src + (size_t)(k0 + 4 * i + ks) * ldn + n0 + cl));
#pragma unroll
    for (int i = 0; i < 16; ++i) { LAS float* s = scr + (4 * i + ks) * 65 + cl; s[0] = v[i][0]; s[1] = v[i][1]; s[2] = v[i][2]; s[3] = v[i][3]; }
    asm volatile("s_waitcnt lgkmcnt(0)" ::: "memory");
    const int c = lane & 7;
#pragma unroll
    for (int j = 0; j < 8; ++j) { const int n = (lane >> 3) + 8 * j; const LAS float* s = scr + (8 * c) * 65 + n;
        u32x4 o; o.x = cvtpk(s[0 * 65], s[1 * 65]); o.y = cvtpk(s[2 * 65], s[3 * 65]); o.z = cvtpk(s[4 * 65], s[5 * 65]); o.w = cvtpk(s[6 * 65], s[7 * 65]);
        __builtin_nontemporal_store(o, (u32x4*)(dst + (size_t)(drow + n) * Kd + k0 + 8 * c)); }
    asm volatile("s_waitcnt lgkmcnt(0)" ::: "memory");
}
constexpr int T_FFN = 12 * 2752, T_MI = 4096, T_SQ = 1024, T_CI = 3072, T_ALL = T_FFN + T_MI + 2 * T_SQ + T_CI;
__device__ __forceinline__ void convert_item(const Args& a, int it, LAS float* scr, int lane) {
    bf16_t* WGU = (bf16_t*)(a.ws + WS_WGU); bf16_t* WD = (bf16_t*)(a.ws + WS_WD);
        const float* src; int ldn, k0, n0, Kd, drow; bf16_t* dst;
        if (it < T_FFN) { const int m = it / 2752, r = it % 2752, f = m / 3, kind = m % 3;
            if (kind < 2) { k0 = (r / 86) * 64; n0 = (r % 86) * 64; src = a.in[kind ? I_WU : I_WG] + (size_t)f * DM * DFF; ldn = DFF; Kd = DM; dst = WGU + (size_t)f * 2 * DFF * DM; drow = (n0 >> 7) * 256 + kind * 128 + (n0 & 127); }
            else { k0 = (r / 32) * 64; n0 = (r % 32) * 64; src = a.in[I_WDN] + (size_t)f * DFF * DM; ldn = DM; Kd = DFF; dst = WD + (size_t)f * DM * DFF; drow = n0; }
        } else if (it < T_FFN + T_MI) { const int r = it - T_FFN; k0 = (r / 128) * 64; n0 = (r % 128) * 64; src = a.in[I_MIXIN]; ldn = MIXIN; Kd = DM; dst = (bf16_t*)(a.ws + WS_WMI); drow = n0; }
        else if (it < T_FFN + T_MI + T_SQ) { const int r = it - T_FFN - T_MI; k0 = (r / 32) * 64; n0 = (r % 32) * 64; src = a.in[I_MIXOUT]; ldn = DM; Kd = DM; dst = (bf16_t*)(a.ws + WS_WMO); drow = n0; }
        else if (it < T_FFN + T_MI + 2 * T_SQ) { const int r = it - T_FFN - T_MI - T_SQ; k0 = (r / 32) * 64; n0 = (r % 32) * 64; src = a.in[I_CWOUT]; ldn = DM; Kd = DM; dst = (bf16_t*)(a.ws + WS_WCO); drow = n0; }
        else { const int r = it - T_FFN - T_MI - 2 * T_SQ; k0 = (r / 96) * 64; n0 = (r % 96) * 64; src = a.in[I_CWIN]; ldn = 3 * DM; Kd = DM; dst = (bf16_t*)(a.ws + WS_WCI);
            if (n0 < DM) drow = n0; else if (n0 < 2 * DM) { const int j = n0 - DM; drow = DM + (j >> 7) * 256 + (j & 127); } else { const int j = n0 - 2 * DM; drow = DM + (j >> 7) * 256 + 128 + (j & 127); } }
        transpose_item(src, ldn, k0, n0, dst, Kd, drow, scr, lane);
}
#ifndef NSTEAL
#define NSTEAL 4
#endif
__device__ __forceinline__ void convert_steal(const Args& a, LAS unsigned char* lds, unsigned* ctr, int lo1, int n1, int lo2, int n2) {
    const int tid = otid(), w = __builtin_amdgcn_readfirstlane(tid >> 6), lane = tid & 63;
    LAS float* scr = (LAS float*)lds + w * (64 * 65);
    volatile LAS int* bc = (volatile LAS int*)(lds + LDS_BYTES - 32);
    const int n = n1 + n2;
    for (;;) {
        __syncthreads();
        if (tid == 0) bc[0] = (int)__hip_atomic_fetch_add(ctr, (unsigned)NSTEAL, __ATOMIC_RELAXED, __HIP_MEMORY_SCOPE_AGENT);
        __syncthreads();
        const int base = bc[0];
        if (base >= n) break;
        const int j = base + w;
        if (w < NSTEAL && j < n) convert_item(a, j < n1 ? lo1 + j : lo2 + (j - n1), scr, lane);
    }
}
__device__ __forceinline__ void gemv_fill(const Args& a, LAS unsigned char* lds) {
    LAS float* sc = (LAS float*)lds;
    for (int i = otid(); i < 5 * 2048; i += 512) { const float v = i < 8192 ? a.in[I_C][i] : a.in[I_CCTX][i - 8192]; sc[i] = siluf_(v); }
    __syncthreads();
}
__device__ __forceinline__ void gemv_item(const Args& a, LAS unsigned char* lds, int it) {
    const int tid = otid(), w = __builtin_amdgcn_readfirstlane(tid >> 6), lane = tid & 63;
    LAS float* sc = (LAS float*)lds; LAS float* red = sc + 5 * 2048;
    float* MOD = (float*)(a.ws + WS_MOD);
    const int l = it / 288, n0 = (it % 288) * 64, cl = (lane & 15) * 4, ks = lane >> 4;
    const float* W = a.in[I_ADAW] + (size_t)l * DM * MODW + n0 + cl;
    f32x4 acc[5] = {};
#pragma unroll 8
    for (int kk = 0; kk < 256; kk += 4) { const int k = w * 256 + kk + ks; const f32x4 wv = __builtin_nontemporal_load((const f32x4*)(W + (size_t)k * MODW));
#pragma unroll
        for (int i = 0; i < 5; ++i) acc[i] += wv * sc[i * 2048 + k]; }
#pragma unroll
    for (int i = 0; i < 5; ++i)
#pragma unroll
        for (int e = 0; e < 4; ++e) { float v = acc[i][e]; v += __shfl_xor(v, 16); v += __shfl_xor(v, 32); acc[i][e] = v; }
    if (lane < 16) {
#pragma unroll
        for (int i = 0; i < 5; ++i) *(LAS f32x4*)(red + (w * 5 + i) * 64 + cl) = acc[i]; }
    __syncthreads();
    if (tid < 320) { const int i = tid >> 6, cc = tid & 63; float s = a.in[I_ADAB][l * MODW + n0 + cc];
#pragma unroll
        for (int x = 0; x < 8; ++x) s += red[(x * 5 + i) * 64 + cc];
        MOD[((size_t)l * 5 + i) * MODW + n0 + cc] = s; }
    __syncthreads();
}
__device__ __forceinline__ void gemv_steal(const Args& a, LAS unsigned char* lds, unsigned* ctr, int lo, int n) {
    volatile LAS int* bc = (volatile LAS int*)(lds + LDS_BYTES - 32);
    bool filled = false;
    for (;;) {
        __syncthreads();
        if (otid() == 0) bc[0] = (int)__hip_atomic_fetch_add(ctr, 1u, __ATOMIC_RELAXED, __HIP_MEMORY_SCOPE_AGENT);
        __syncthreads();
        const int j = bc[0];
        if (j >= n) break;
        if (!filled) { gemv_fill(a, lds); filled = true; }
        gemv_item(a, lds, lo + j);
    }
}
__device__ __forceinline__ void phase0(const Args& a, LAS unsigned char* lds, int G) {
    const int tid = otid(), w = __builtin_amdgcn_readfirstlane(tid >> 6), lane = tid & 63, bid = obid();
    { const int id = bid * 512 + tid; if (id < 1024) { const int pos = id >> 4, i = id & 15; const float fr = __builtin_amdgcn_exp2f(-(float)i * (13.287712379549449f / 16.f)); const float ang = (float)pos * fr;
        ((f32x2*)(a.ws + WS_ROPE))[id] = (f32x2){__cosf(ang), __sinf(ang)}; } }
    gemv_fill(a, lds);
    for (int it = bid; it < 64; it += G) gemv_item(a, lds, it);
    LAS float* scr = (LAS float*)lds + w * (64 * 65);
    for (int it = bid * 8 + w; it < 2 * 2752; it += G * 8) convert_item(a, it, scr, lane);
}

struct RowP { const bf16_t* xinb; bf16_t* xoutb; const bf16_t* y; const float* xin; const float* ctxin; float* xout; bf16_t* h; int modeR; float wgt; const float* modg; int gidx; const float* gpost; const float* modh; int sidx; const float* gpre; int has_y, has_h; };
__device__ __forceinline__ void row_phase(const RowP& p, int G) {
    const int tid = otid(), w = tid >> 6, lane = tid & 63;
    const int nrows = p.modeR ? MR : ML;
    for (int r0 = (obid() * 8 + w) * 2; r0 < nrows; r0 += G * 16) {
        int mi; const float* xrow; float* xo; size_t lrow = 0;
        if (p.modeR) { const int b = r0 / RS, s = r0 % RS; if (s < CTX) { mi = 4; xrow = p.ctxin + (size_t)(b * CTX + s) * DM; xo = nullptr; } else { mi = b; lrow = (size_t)(b * SEQ + s - CTX); xrow = p.xin + lrow * DM; xo = p.xout; } }
        else { mi = r0 / SEQ; lrow = (size_t)r0; xrow = p.xin + lrow * DM; xo = p.xout; }
        const bool isctx = p.modeR && mi == 4;
        f32x4 xv[2][4][2]; u32x4 yv[2][4];
        if (p.xinb && !isctx) {
#pragma unroll
            for (int q = 0; q < 2; ++q)
#pragma unroll
                for (int j = 0; j < 4; ++j) { const u32x4 xx = *(const u32x4*)(p.xinb + (lrow + q) * DM + 8 * lane + 512 * j);
                    xv[q][j][0] = (f32x4){bflo(xx[0]), bfhi(xx[0]), bflo(xx[1]), bfhi(xx[1])}; xv[q][j][1] = (f32x4){bflo(xx[2]), bfhi(xx[2]), bflo(xx[3]), bfhi(xx[3])}; }
        } else {
#pragma unroll
            for (int q = 0; q < 2; ++q)
#pragma unroll
                for (int j = 0; j < 4; ++j) { const float* xp = xrow + (size_t)q * DM + 8 * lane + 512 * j; xv[q][j][0] = *(const f32x4*)xp; xv[q][j][1] = *(const f32x4*)(xp + 4); }
        }
        if (p.has_y) {
#pragma unroll
            for (int q = 0; q < 2; ++q)
#pragma unroll
                for (int j = 0; j < 4; ++j) yv[q][j] = *(const u32x4*)(p.y + (size_t)(r0 + q) * DM + 8 * lane + 512 * j);
            float ss[2] = {0.f, 0.f};
#pragma unroll
            for (int q = 0; q < 2; ++q)
#pragma unroll
                for (int j = 0; j < 4; ++j)
#pragma unroll
                    for (int e = 0; e < 4; ++e) { const float a = bflo(yv[q][j][e]), b = bfhi(yv[q][j][e]); ss[q] += a * a + b * b; }
            const float ry0 = rsqrtf(wave_sum(ss[0]) * (1.f / DM) + EPS) * p.wgt, ry1 = rsqrtf(wave_sum(ss[1]) * (1.f / DM) + EPS) * p.wgt;
            const float* gate = p.modg + (size_t)mi * MODW + p.gidx * DM;
#pragma unroll
            for (int j = 0; j < 4; ++j) { const int c = 8 * lane + 512 * j;
                const f32x4 gt0 = *(const f32x4*)(gate + c) * *(const f32x4*)(p.gpost + c), gt1 = *(const f32x4*)(gate + c + 4) * *(const f32x4*)(p.gpost + c + 4);
#pragma unroll
                for (int q = 0; q < 2; ++q) { const float ry = q ? ry1 : ry0; const u32x4 yy = yv[q][j];
                    const f32x4 y0 = {bflo(yy[0]), bfhi(yy[0]), bflo(yy[1]), bfhi(yy[1])}, y1 = {bflo(yy[2]), bfhi(yy[2]), bflo(yy[3]), bfhi(yy[3])};
                    xv[q][j][0] = xv[q][j][0] + gt0 * (y0 * ry); xv[q][j][1] = xv[q][j][1] + gt1 * (y1 * ry);
                    if (!isctx) { if (p.xoutb) *(u32x4*)(p.xoutb + (lrow + q) * DM + c) = (u32x4){cvtpk(xv[q][j][0][0], xv[q][j][0][1]), cvtpk(xv[q][j][0][2], xv[q][j][0][3]), cvtpk(xv[q][j][1][0], xv[q][j][1][1]), cvtpk(xv[q][j][1][2], xv[q][j][1][3])};
                                  else { float* op = xo + (lrow + q) * DM + c; *(f32x4*)op = xv[q][j][0]; *(f32x4*)(op + 4) = xv[q][j][1]; } } } }
        }
        if (p.has_h) {
            float ss[2] = {0.f, 0.f};
#pragma unroll
            for (int q = 0; q < 2; ++q)
#pragma unroll
                for (int j = 0; j < 4; ++j)
#pragma unroll
                    for (int k = 0; k < 2; ++k) { const f32x4 v = xv[q][j][k]; ss[q] += (v[0] * v[0] + v[1] * v[1]) + (v[2] * v[2] + v[3] * v[3]); }
            const float rx0 = rsqrtf(wave_sum(ss[0]) * (1.f / DM) + EPS), rx1 = rsqrtf(wave_sum(ss[1]) * (1.f / DM) + EPS);
            const float* sh = p.modh + (size_t)mi * MODW + p.sidx * DM; const float* scl = sh + DM;
#pragma unroll
            for (int j = 0; j < 4; ++j) { const int c = 8 * lane + 512 * j;
                const f32x4 m0 = *(const f32x4*)(p.gpre + c) * (*(const f32x4*)(scl + c) + 1.f), m1 = *(const f32x4*)(p.gpre + c + 4) * (*(const f32x4*)(scl + c + 4) + 1.f);
                const f32x4 s0 = *(const f32x4*)(sh + c), s1 = *(const f32x4*)(sh + c + 4);
#pragma unroll
                for (int q = 0; q < 2; ++q) { const float rx = q ? rx1 : rx0;
                    const f32x4 h0 = (xv[q][j][0] * rx) * m0 + s0, h1 = (xv[q][j][1] * rx) * m1 + s1;
                    *(u32x4*)(p.h + (size_t)(r0 + q) * DM + c) = (u32x4){cvtpk(h0[0], h0[1]), cvtpk(h0[2], h0[3]), cvtpk(h1[0], h1[1]), cvtpk(h1[2], h1[3])}; } }
        }
    }
}

__device__ __forceinline__ float half_sum(float v) {
#pragma unroll
    for (int o = 1; o < 32; o <<= 1) v += __shfl_xor(v, o);
    return v;
}
__device__ __forceinline__ void merge_phase(const Args& a, int G) {
    const int tid = otid(), w = tid >> 6, lane = tid & 63, l32 = lane & 31, hsel = lane >> 5;
    const float* dl = a.in[I_DLAM];
    const float s01 = wave_sum(dl[lane] * dl[64 + lane]), s23 = wave_sum(dl[128 + lane] * dl[192 + lane]);
    const float lam = __expf(s01) - __expf(s23) + 0.2f;
    const float* OA = (const float*)(a.ws + WS_OATT); const float* OR = (const float*)(a.ws + WS_OREC); const bf16_t* MP = (const bf16_t*)(a.ws + WS_MP); bf16_t* MG = (bf16_t*)(a.ws + WS_MG);
    const f32x4 ga = *(const f32x4*)(a.in[I_DNG] + 4 * l32) * 0.8f, gr = *(const f32x4*)(a.in[I_RNG] + 4 * l32);
    for (int lr = obid() * 8 + w; lr < ML; lr += G * 8) {
        const int b = lr / SEQ; const size_t rrow = (size_t)(lr + 256 * (b + 1));
        f32x4 o1[4], o2[4], of[4], ob[4]; u32x2 gw[4];
#pragma unroll
        for (int hp = 0; hp < 4; ++hp) { const size_t c0 = (size_t)lr * 1024 + (2 * hp + hsel) * 128 + 4 * l32;
            o1[hp] = *(const f32x4*)(OA + c0); o2[hp] = *(const f32x4*)(OA + (size_t)ML * 1024 + c0);
            of[hp] = *(const f32x4*)(OR + c0); ob[hp] = *(const f32x4*)(OR + (size_t)ML * 1024 + c0);
            gw[hp] = *(const u32x2*)(MP + rrow * MIXIN + 7168 + (2 * hp + hsel) * 128 + 4 * l32); }
#pragma unroll
        for (int hp = 0; hp < 4; ++hp) { const int c0 = (2 * hp + hsel) * 128 + 4 * l32;
            const f32x4 d = o1[hp] - o2[hp] * lam; const float r = rsqrtf(half_sum((d[0] * d[0] + d[1] * d[1]) + (d[2] * d[2] + d[3] * d[3])) * (1.f / 128.f) + EPS);
            const f32x4 x = d * r * ga;
            *(u32x2*)(MG + (size_t)lr * DM + c0) = (u32x2){cvtpk(x[0], x[1]), cvtpk(x[2], x[3])};
            const f32x4 o = of[hp] + ob[hp]; const float rr = rsqrtf(half_sum((o[0] * o[0] + o[1] * o[1]) + (o[2] * o[2] + o[3] * o[3])) * (1.f / 128.f) + EPS);
            const f32x4 g = {siluf_(bflo(gw[hp][0])), siluf_(bfhi(gw[hp][0])), siluf_(bflo(gw[hp][1])), siluf_(bfhi(gw[hp][1]))};
            const f32x4 y = o * rr * gr * g;
            *(u32x2*)(MG + (size_t)lr * DM + 1024 + c0) = (u32x2){cvtpk(y[0], y[1]), cvtpk(y[2], y[3])}; }
    }
}

__device__ __forceinline__ void conv_phase(const Args& a, int G) {
    const bf16_t* BG = (const bf16_t*)(a.ws + WS_MP); const bf16_t* CV = BG + (size_t)ML * DM; bf16_t* MG = (bf16_t*)(a.ws + WS_MG); const float* cw = a.in[I_CW];
    const int tid = otid(), c = (tid & 255) * 8, rh = tid >> 8;
    f32x4 w0[2], w1[2], w2[2];
#pragma unroll
    for (int k = 0; k < 2; ++k) { w0[k] = *(const f32x4*)(cw + c + 4 * k); w1[k] = *(const f32x4*)(cw + DM + c + 4 * k); w2[k] = *(const f32x4*)(cw + 2 * DM + c + 4 * k); }
    const u32x4 z = {0u, 0u, 0u, 0u};
    for (int it = obid(); it < ML / 16; it += G) {
        const int r0 = it * 16 + rh * 8;
        const int t0 = r0 & (SEQ - 1);
        u32x4 prev = t0 > 0 ? *(const u32x4*)(CV + (size_t)(r0 - 1) * DM + c) : z;
        u32x4 cur = *(const u32x4*)(CV + (size_t)r0 * DM + c);
#pragma unroll
        for (int i = 0; i < 8; ++i) {
            const int lr = r0 + i;
            const u32x4 nxt = (t0 + i < SEQ - 1) ? *(const u32x4*)(CV + (size_t)(lr + 1) * DM + c) : z;
            const u32x4 bg = *(const u32x4*)(BG + (size_t)lr * DM + c);
            u32x4 o;
#pragma unroll
            for (int e = 0; e < 4; ++e) { const int k = e >> 1, q = (e & 1) * 2;
                const float lo = bflo(bg[e]) * (w0[k][q] * bflo(prev[e]) + w1[k][q] * bflo(cur[e]) + w2[k][q] * bflo(nxt[e]));
                const float hi = bfhi(bg[e]) * (w0[k][q + 1] * bfhi(prev[e]) + w1[k][q + 1] * bfhi(cur[e]) + w2[k][q + 1] * bfhi(nxt[e]));
                o[e] = cvtpk(lo, hi); }
            *(u32x4*)(MG + (size_t)lr * DM + c) = o;
            prev = cur; cur = nxt;
        }
    }
}

#define XB_TMO      128
#define XB_XCNT(j)  (256  + 64 * (j))
#define XB_XSUB(j)  (1280 + 64 * (j))
#define XB_XGEN(j)  (2304 + 64 * (j))
#define XB_TOP      3328
#define XB_TOPGEN   3392
#define XCD_BAR_WORDS 3456
#define XB_SPIN_CAP (1u << 18)

__device__ __forceinline__ unsigned xb_ld(unsigned* p)              { return __hip_atomic_load(p, __ATOMIC_RELAXED, __HIP_MEMORY_SCOPE_AGENT); }
__device__ __forceinline__ unsigned xb_add(unsigned* p, unsigned v) { return __hip_atomic_fetch_add(p, v, __ATOMIC_RELAXED, __HIP_MEMORY_SCOPE_AGENT); }
__device__ __forceinline__ unsigned xb_xcc_id() { return (unsigned)__builtin_amdgcn_s_getreg((3 << 11) | 20) & 0xFu; }
#define XB_SPIN(cond, bar) do { unsigned _sp = 0; while (cond) { __builtin_amdgcn_s_sleep(1); \
    if ((++_sp & 255u) == 0u) { if (xb_ld(&(bar)[XB_TMO])) break; if (_sp > XB_SPIN_CAP) { atomicAdd(&(bar)[XB_TMO], 1u); break; } } } } while (0)

struct XcdBarrier {
    unsigned* bar; unsigned x;
    volatile LAS unsigned* st;
};

__device__ __forceinline__ XcdBarrier xcd_barrier_post(unsigned* bar, volatile LAS unsigned* st) {
    XcdBarrier b; b.bar = bar; b.x = xb_xcc_id(); b.st = st;
    if (threadIdx.x == 0) (void)xb_add(&bar[XB_XCNT(b.x)], 1u);
    return b;
}
__device__ __forceinline__ void xcd_barrier_complete(unsigned* bar, unsigned x, unsigned& nloc, unsigned& nx) {
    const unsigned G = gridDim.x * gridDim.y * gridDim.z;
    unsigned sum, cnt, mine, sp = 0u;
    for (;;) {
        sum = 0u; cnt = 0u; mine = 0u;
#pragma unroll
        for (unsigned j = 0; j < 16; ++j) { const unsigned c = xb_ld(&bar[XB_XCNT(j)]); sum += c; cnt += (c > 0u) ? 1u : 0u; mine = (j == x) ? c : mine; }
        if (sum == G) break;
        __builtin_amdgcn_s_sleep(1);
        if ((++sp & 255u) == 0u) { if (xb_ld(&bar[XB_TMO])) break; if (sp > XB_SPIN_CAP) { atomicAdd(&bar[XB_TMO], 1u); break; } }
    }
    nloc = mine > 0u ? mine : 1u; nx = cnt > 0u ? cnt : 1u;
}

__device__ __forceinline__ void xcd_barrier(const XcdBarrier& b) {
    asm volatile("s_waitcnt vmcnt(0)" ::: "memory");
    __syncthreads();
    if (threadIdx.x == 0) {
        unsigned* bar = b.bar;
        __builtin_amdgcn_s_waitcnt(0);
        unsigned nloc = b.st[0], nx = b.st[1];
        if (nloc == 0u) { xcd_barrier_complete(bar, b.x, nloc, nx); b.st[0] = nloc; b.st[1] = nx; }
        const unsigned old = xb_add(&bar[XB_XSUB(b.x)], 1u);
        const unsigned gen = old / nloc;
        if (old + 1u == (gen + 1u) * nloc) {
            __builtin_amdgcn_fence(__ATOMIC_RELEASE, "agent");
            asm volatile("s_waitcnt vmcnt(0)" ::: "memory");
            const unsigned og = xb_add(&bar[XB_TOP], 1u);
            const unsigned tg = og / nx;
            if (og + 1u == (tg + 1u) * nx) xb_add(&bar[XB_TOPGEN], 1u);
            else XB_SPIN(xb_ld(&bar[XB_TOPGEN]) == tg, bar);
            __builtin_amdgcn_fence(__ATOMIC_ACQUIRE, "agent");
            xb_add(&bar[XB_XGEN(b.x)], 1u);
            asm volatile("s_waitcnt vmcnt(0)" ::: "memory");
        } else {
            XB_SPIN(xb_ld(&bar[XB_XGEN(b.x)]) == gen, bar);
            __builtin_amdgcn_fence(__ATOMIC_ACQUIRE, "agent");
            asm volatile("s_waitcnt vmcnt(0)" ::: "memory");
        }
    }
    __syncthreads();
}

#define CTR_WORD(k) (3520 + 64 * (k))
#ifndef PHMASK
#define PHMASK 0x1ff
#endif
#define PHM(x) (((PHMASK) >> (x)) & 1)
__global__ void __launch_bounds__(512, 2) mega(Args a) {
    extern __shared__ __attribute__((aligned(16))) unsigned char smem[];
    LAS unsigned char* lds = (LAS unsigned char*)smem;
    const int G = gridDim.x;
    unsigned char* ws = a.ws;
    bf16_t* H = (bf16_t*)(ws + WS_H); bf16_t* ACT = (bf16_t*)(ws + WS_ACT); bf16_t* Y = (bf16_t*)(ws + WS_Y); bf16_t* MP = (bf16_t*)(ws + WS_MP); bf16_t* MG = (bf16_t*)(ws + WS_MG);
    const float* MOD = (const float*)(ws + WS_MOD);
#if MK_DIAG_ZERO
    for (int i = otid(); i < LDS_BYTES / 4; i += 512) ((LAS unsigned*)lds)[i] = 0u;
    __syncthreads();
#endif
    XcdBarrier bar; bar.bar = (unsigned*)(ws + WS_BAR); bar.x = 0; bar.st = (volatile LAS unsigned*)(lds + LDS_BYTES - 16);
    unsigned* const ctrs = (unsigned*)(ws + WS_BAR);
    if (a.ph_lo < 0) cg::this_grid().sync();
    if (otid() < 4) ((LAS unsigned*)(lds + LDS_BYTES - 16))[otid()] = 0u;
    __syncthreads();
    if (a.ph_hi - a.ph_lo > 1) bar = xcd_barrier_post((unsigned*)(ws + WS_BAR), (volatile LAS unsigned*)(lds + LDS_BYTES - 16));
    for (int ph = a.ph_lo; ph < a.ph_hi; ++ph) {
      for (int rep = 0; rep < (((MK_PROBE >> ph) & 1) ? 2 : 1); ++rep) {
        const int bid = obid();
        if (PHM(0) && ph == 0) { phase0(a, lds, G); }
        else if (PHM(1) && (ph == 1 || ph == 4 || ph == 9 || ph == 12 || ph == 15 || ph == 19 || ph == 22)) {
            RowP p; p.y = Y; p.ctxin = a.in[I_CTX]; p.xout = a.out; p.h = H;
            bf16_t* XB = (bf16_t*)(ws + WS_XB);
            p.modeR = (ph <= 4); p.xin = a.in[I_X]; p.xinb = (ph <= 4) ? nullptr : XB; p.xoutb = (ph == 22) ? nullptr : XB; p.has_y = (ph != 1); p.has_h = (ph != 22);
            const int lg = (ph <= 12) ? 0 : 1;
            const int lh = (ph <= 9) ? 0 : 1;
            const int sub = (ph == 4 || ph == 15) ? 0 : (ph == 9 || ph == 19) ? 1 : 2;
            const int nxt = (ph == 1 || ph == 12) ? 0 : (ph == 4 || ph == 15) ? 1 : 2;
            p.wgt = (sub == 1) ? 1.f : 0.5f;
            p.modg = MOD + (size_t)lg * 5 * MODW; p.gidx = 3 * sub + 2; p.gpost = a.in[I_NORMG] + (size_t)(lg * 6 + 2 * sub + 1) * DM;
            p.modh = MOD + (size_t)lh * 5 * MODW; p.sidx = 3 * nxt; p.gpre = a.in[I_NORMG] + (size_t)(lh * 6 + 2 * nxt) * DM;
            row_phase(p, G);
        }
        else if (PHM(2) && (ph == 2 || ph == 10 || ph == 13 || ph == 20)) {
            const int f = (ph == 2) ? 0 : (ph == 10) ? 1 : (ph == 13) ? 2 : 3; const int M = (ph == 2) ? MR : ML;
            pg8::Gemm g{H, (const bf16_t*)(ws + WS_WGU + (size_t)f * SZ_WGU), M, 2 * DFF, DM}; pg8::StaticOrder S; S.init(M, 2 * DFF, G, bid);
            pg8::EpiPair E{ACT, DFF, nullptr, 0, 0, 1};
            pg8::gemm_phase<pg8::EpiPair, pg8::StaticOrder, true, true>(lds, g, S, E);
            if (ph == 2) { convert_steal(a, lds, ctrs + CTR_WORD(0), 2 * 2752, 2752, T_FFN, T_MI + T_SQ);
                           gemv_steal(a, lds, ctrs + CTR_WORD(7), 64, 96); }
            else if (ph == 10) convert_steal(a, lds, ctrs + CTR_WORD(2), 9 * 2752, 2752, 0, 0);
            else if (ph == 13) convert_steal(a, lds, ctrs + CTR_WORD(3), 10 * 2752, 2752, 0, 0);
        }
        else if (PHM(2) && ph == 16) {
            pg8::Gemm g{H, (const bf16_t*)(ws + WS_WCI), ML, 3 * DM, DM}; pg8::StaticOrder S; S.init(ML, 3 * DM, G, bid);
            pg8::EpiPair E{MP + (size_t)ML * DM, DM, MP, DM, 8, 0};
            pg8::gemm_phase<pg8::EpiPair, pg8::StaticOrder, true, true>(lds, g, S, E);
        }
        else if (PHM(3) && (ph == 3 || ph == 11 || ph == 14 || ph == 21 || ph == 8 || ph == 18)) {
            const bool down = !(ph == 8 || ph == 18);
            const int f = (ph == 3) ? 0 : (ph == 11) ? 1 : (ph == 14) ? 2 : 3; const int M = (ph == 3) ? MR : ML;
            const bf16_t* A = down ? ACT : MG; const bf16_t* Bt = down ? (const bf16_t*)(ws + WS_WD + (size_t)f * SZ_WD) : (const bf16_t*)(ws + (ph == 8 ? WS_WMO : WS_WCO));
            pg8::Gemm g{A, Bt, M, DM, down ? DFF : DM}; pg8::StaticOrder S; S.init(M, DM, G, bid);
            pg8::EpiB16 E{Y, DM};
            pg8::gemm_phase<pg8::EpiB16, pg8::StaticOrder, true, true>(lds, g, S, E);
            if (ph == 3) { convert_steal(a, lds, ctrs + CTR_WORD(1), 3 * 2752, 3 * 2752, 8 * 2752, 2752);
                           gemv_steal(a, lds, ctrs + CTR_WORD(5), 160, 416); }
        }
        else if (PHM(4) && ph == 5) {
            pg8::Gemm g{H, (const bf16_t*)(ws + WS_WMI), MR, MIXIN, DM}; pg8::StaticOrder S; S.init(MR, MIXIN, G, bid);
            pg8::EpiMix E{MP, MIXIN, (const f32x2*)(ws + WS_ROPE)};
            pg8::gemm_phase<pg8::EpiMix, pg8::StaticOrder, true, true>(lds, g, S, E);
            convert_steal(a, lds, ctrs + CTR_WORD(6), T_FFN + T_MI + T_SQ, T_SQ + T_CI, 0, 0);
        }
        else if (ph == 6) {
            float* OATT = (float*)(ws + WS_OATT);
            if (G >= 128) { if (bid < 64 && PHM(5)) hgrn_unit(a, lds, bid); }
            else { for (int u = bid; u < 64; u += G) if (PHM(5)) hgrn_unit(a, lds, u); }
            volatile LAS int* bc = (volatile LAS int*)(lds + LDS_BYTES - 32);
            for (;;) {
                __syncthreads();
                if (otid() == 0) bc[0] = (int)__hip_atomic_fetch_add(ctrs + CTR_WORD(4), 1u, __ATOMIC_RELAXED, __HIP_MEMORY_SCOPE_AGENT);
                __syncthreads();
                const int u = bc[0];
                if (u >= 512) break;
                const int qb = u & 7, mp = (u >> 3) & 1, h = (u >> 4) & 7, b = u >> 7;
                const bf16_t* base = MP + (size_t)(b * RS) * MIXIN;
                if (PHM(6)) att::attn_body(base + (size_t)(CTX + qb * 256) * MIXIN + h * 128 + mp * 64, base + 1024 + h * 128 + mp * 64, base + 2048 + h * 128,
                               OATT + (size_t)mp * ML * 1024 + (size_t)(b * SEQ + qb * 256) * 1024 + h * 128, RS, (char*)smem);
            }
            convert_steal(a, lds, ctrs + CTR_WORD(8), 6 * 2752, 2 * 2752, 11 * 2752, 2752);
        }
        else if (PHM(7) && ph == 7) { merge_phase(a, G); }
        else if (PHM(8) && ph == 17) { conv_phase(a, G); }
        if (ph + 1 < a.ph_hi) xcd_barrier(bar);
      }
    }

}

extern "C" void kernel_launch(void* const* d_in, const int* in_sizes, int n_in, void* d_out, int out_size, void* d_ws, size_t ws_size, hipStream_t stream) {
    static int grid = 0;
    if (grid == 0) {
        if (n_in != 19 || out_size != ML * DM || ws_size < WS_END) { fprintf(stderr, "kernel_launch: unexpected shapes: n_in %d out %d ws %zu (need %zu)\n", n_in, out_size, ws_size, (size_t)WS_END); grid = -1; return; }
        int dev = 0, cus = 0, per_cu = 0;
        hipGetDevice(&dev); hipDeviceGetAttribute(&cus, hipDeviceAttributeMultiprocessorCount, dev);
        if (hipFuncSetAttribute((const void*)mega, hipFuncAttributeMaxDynamicSharedMemorySize, LDS_BYTES) != hipSuccess) { fprintf(stderr, "kernel_launch: hipFuncSetAttribute failed\n"); grid = -1; return; }
        if (hipOccupancyMaxActiveBlocksPerMultiprocessor(&per_cu, (const void*)mega, 512, LDS_BYTES) != hipSuccess || per_cu < 1) { fprintf(stderr, "kernel_launch: occupancy query gave %d\n", per_cu); per_cu = 1; }
        (void)hipGetLastError();
        grid = cus * per_cu;
        fprintf(stderr, "kernel_launch: grid %d (cus %d x %d)\n", grid, cus, per_cu);
    }
    if (grid < 0) return;
#if MK_DIAG_ZERO
    (void)hipMemsetAsync(d_ws, 0, WS_END, stream);
    (void)hipMemsetAsync(d_out, 0, (size_t)ML * DM * 4, stream);
#endif
    (void)hipMemsetAsync((unsigned char*)d_ws + WS_BAR, 0, 16384, stream);
    Args a{};
    for (int i = 0; i < 19; ++i) a.in[i] = (const float*)d_in[i];
    a.out = (float*)d_out; a.ws = (unsigned char*)d_ws;
#if MK_MULTI
    for (int ph = 0; ph < NPHASE; ++ph) { a.ph_lo = ph; a.ph_hi = ph + 1; hipLaunchKernelGGL(mega, dim3(grid), dim3(512), LDS_BYTES, stream, a); }
#else
    a.ph_lo = 0; a.ph_hi = NPHASE;
    void* args[] = {&a};
    hipError_t e = hipLaunchCooperativeKernel((const void*)mega, dim3(grid), dim3(512), args, LDS_BYTES, stream);
    if (e != hipSuccess) fprintf(stderr, "kernel_launch: cooperative launch failed: %s (grid %d)\n", hipGetErrorString(e), grid);
#endif
}
```

```cpp
#include <hip/hip_runtime.h>
#include <hip/hip_cooperative_groups.h>
#include <cstdio>
#include <cstdint>
namespace cg = cooperative_groups;

#ifndef MK_MULTI
#define MK_MULTI 0
#endif

#ifndef MK_PROBE
#define MK_PROBE 0
#endif
#ifndef MK_DIAG_ZERO
#define MK_DIAG_ZERO 0
#endif
#define LAS __attribute__((address_space(3)))
typedef unsigned short bf16_t;
typedef short bf16x8 __attribute__((ext_vector_type(8)));
typedef short s16x4 __attribute__((ext_vector_type(4)));
typedef float f32x2 __attribute__((ext_vector_type(2)));
typedef float f32x4 __attribute__((ext_vector_type(4)));
typedef float f32x16 __attribute__((ext_vector_type(16)));
typedef unsigned u32x2 __attribute__((ext_vector_type(2)));
typedef unsigned u32x4 __attribute__((ext_vector_type(4)));

constexpr int DM = 2048, NB = 4, SEQ = 2048, CTX = 256, RS = SEQ + CTX, MR = NB * RS, ML = NB * SEQ, DFF = 5504, MODW = 9 * DM, MIXIN = 8192;
constexpr float EPS = 1e-6f;
constexpr int NPHASE = 23;
constexpr int LDS_BYTES = 147456;

struct Args { const float* in[19]; float* out; unsigned char* ws; int ph_lo, ph_hi; };
enum { I_X = 0, I_C, I_CTX, I_CCTX, I_ADAW, I_ADAB, I_NORMG, I_WG, I_WU, I_WDN, I_MIXIN, I_MIXOUT, I_DLAM, I_DNG, I_RNG, I_RLB, I_CWIN, I_CW, I_CWOUT };

constexpr size_t WS_MOD = 0;
constexpr size_t WS_ROPE = WS_MOD + (size_t)2 * 5 * MODW * 4;
constexpr size_t SZ_WGU = (size_t)2 * DFF * DM * 2, SZ_WD = (size_t)DM * DFF * 2;
constexpr size_t WS_BAR = WS_ROPE + 8192;
constexpr size_t WS_WGU = WS_BAR + 16384;
constexpr size_t WS_WD = WS_WGU + 4 * SZ_WGU;
constexpr size_t WS_WMI = WS_WD + 4 * SZ_WD;
constexpr size_t WS_WMO = WS_WMI + (size_t)MIXIN * DM * 2;
constexpr size_t WS_WCI = WS_WMO + (size_t)DM * DM * 2;
constexpr size_t WS_WCO = WS_WCI + (size_t)3 * DM * DM * 2;
constexpr size_t WS_H = WS_WCO + (size_t)DM * DM * 2;
constexpr size_t WS_ACT = WS_H + (size_t)MR * DM * 2;
constexpr size_t WS_Y = WS_ACT + (size_t)MR * DFF * 2;
constexpr size_t WS_MP = WS_Y + (size_t)MR * DM * 4;
constexpr size_t WS_OATT = WS_MP + (size_t)MR * MIXIN * 2;
constexpr size_t WS_OREC = WS_OATT + (size_t)2 * ML * 1024 * 4;
constexpr size_t WS_MG = WS_OREC + (size_t)2 * ML * 1024 * 4;
constexpr size_t WS_XB = WS_MG + (size_t)ML * DM * 2;
constexpr size_t WS_END = WS_XB + (size_t)ML * DM * 2;

typedef __bf16 bf16x2_t __attribute__((ext_vector_type(2)));
__device__ __forceinline__ unsigned cvtpk(float lo, float hi) { const f32x2 v = {lo, hi}; const bf16x2_t b = __builtin_convertvector(v, bf16x2_t); return __builtin_bit_cast(unsigned, b); }
__device__ __forceinline__ float bflo(unsigned w) { return __uint_as_float(w << 16); }
__device__ __forceinline__ float bfhi(unsigned w) { return __uint_as_float(w & 0xffff0000u); }
__device__ __forceinline__ float wave_sum(float v) {
#pragma unroll
    for (int o = 1; o < 64; o <<= 1) v += __shfl_xor(v, o);
    return v;
}
__device__ __forceinline__ int otid() { int t = threadIdx.x; asm volatile("" : "+v"(t)); return t; }
__device__ __forceinline__ int obid() { int t = blockIdx.x; asm volatile("" : "+s"(t)); return t; }
__device__ __forceinline__ float sigmoidf_(float x) { return __builtin_amdgcn_rcpf(1.f + __expf(-x)); }
__device__ __forceinline__ float siluf_(float x) { return x * sigmoidf_(x); }

namespace pg8 {
#define PG8_LAS __attribute__((address_space(3)))
typedef unsigned short bf16_t;
typedef short bf16x8 __attribute__((ext_vector_type(8)));
typedef float f32x4 __attribute__((ext_vector_type(4)));
typedef unsigned u32x4 __attribute__((ext_vector_type(4)));
constexpr int BM = 256, BK = 64, HALF = 128, HTB = HALF * BK * 2  , STAGE_BYTES = 8 * HTB, NXCD = 8, WGM = 8;

__host__ __device__ __forceinline__ int lds_byte(int r, int c) { const int st = (r >> 4) * 2 + (c >> 5), rr = r & 15, cc = c & 31, ob = rr * 64 + cc * 2; return st * 1024 + (ob ^ (((ob >> 9) & 1) << 5)); }
__host__ __device__ __forceinline__ void stage_rc(int b, int& R, int& C) { const int st = b / 1024, sb = b % 1024, swz = sb ^ (((sb >> 9) & 1) << 5); R = (st >> 1) * 16 + swz / 64; C = (st & 1) * 32 + (swz % 64) / 2; }
__host__ __device__ __forceinline__ int perm32(int rho) { const int n = rho >> 4, i = rho & 15; return 8 * (i >> 2) + 4 * n + (i & 3); }

struct Unit { int pm, pn; };
struct Gemm { const bf16_t* A; const bf16_t* Bt; int M, N, K; };

struct StaticOrder {
    int nM, nN, nwg, G, c;
    __host__ __device__ void init(int M, int N, int G_, int c_) { nM = M / BM; nN = N / BM; nwg = nM * nN; G = G_; c = c_; }
    __host__ __device__ bool next(int i, Unit& u) const {
        const long L = (long)i * G + c; if (L >= nwg) return false;
        int wgid = (int)L; { const int q = nwg / NXCD, r = nwg % NXCD, xcd = wgid % NXCD, off = wgid / NXCD; wgid = (xcd < r ? xcd * (q + 1) : r * (q + 1) + (xcd - r) * q) + off; }
        const int nig = WGM * nN, gid = wgid / nig, fm = gid * WGM, gsz = (nM - fm) < WGM ? (nM - fm) : WGM;
        u.pm = fm + ((wgid % nig) % gsz); u.pn = (wgid % nig) / gsz; return true;
    }
    __device__ __forceinline__ void a_ready(const Unit&) const {}
    __device__ __forceinline__ void done(const Unit&) const {}
};

__device__ __forceinline__ unsigned cvt_pk_bf16(float lo, float hi) { return ::cvtpk(lo, hi); }
typedef float f32x2 __attribute__((ext_vector_type(2)));

__device__ __forceinline__ void st8_bf16(bf16_t* p, const f32x4 v0, const f32x4 v1) {
    u32x4 w; w.x = cvt_pk_bf16(v0[0], v0[1]); w.y = cvt_pk_bf16(v0[2], v0[3]); w.z = cvt_pk_bf16(v1[0], v1[1]); w.w = cvt_pk_bf16(v1[2], v1[3]); *(u32x4*)p = w;
}
__device__ __forceinline__ float silu_e(float g) { return g * __builtin_amdgcn_rcpf(1.f + __expf(-g)); }
struct EpiPair {
    static constexpr bool PERM = true, AFTER_DRAIN = false;
    bf16_t* O1; int ld1; bf16_t* O0; int ld0; int nplain; int silu;
    __device__ __forceinline__ void operator()(const f32x4 (&acc)[2][2][4][2], const Unit& u, int wr, int wc, int fr, int fq) const {
        const int row0 = u.pm * BM + wr * 64 + fr;
        if (u.pn < nplain) {
            const int col0 = u.pn * BM + wc * 32 + 8 * fq;
#pragma unroll
            for (int ai = 0; ai < 2; ++ai)
#pragma unroll
                for (int m = 0; m < 4; ++m) { bf16_t* rowp = O0 + (size_t)(row0 + ai * HALF + m * 16) * ld0 + col0;
#pragma unroll
                    for (int bj = 0; bj < 2; ++bj) st8_bf16(rowp + bj * HALF, acc[ai][bj][m][0], acc[ai][bj][m][1]); }
        } else {
            const int col0 = (u.pn - nplain) * HALF + wc * 32 + 8 * fq;
#pragma unroll
            for (int ai = 0; ai < 2; ++ai)
#pragma unroll
                for (int m = 0; m < 4; ++m) { bf16_t* rowp = O1 + (size_t)(row0 + ai * HALF + m * 16) * ld1 + col0;
                    f32x4 g0 = acc[ai][0][m][0], g1 = acc[ai][0][m][1]; const f32x4 u0 = acc[ai][1][m][0], u1 = acc[ai][1][m][1];
                    if (silu) {
#pragma unroll
                        for (int e = 0; e < 4; ++e) { g0[e] = silu_e(g0[e]); g1[e] = silu_e(g1[e]); } }
                    st8_bf16(rowp, g0 * u0, g1 * u1); }
        }
    }
};
struct EpiB16 {
    static constexpr bool PERM = true, AFTER_DRAIN = false;
    bf16_t* O; int ld;
    __device__ __forceinline__ void operator()(const f32x4 (&acc)[2][2][4][2], const Unit& u, int wr, int wc, int fr, int fq) const {
        const int row0 = u.pm * BM + wr * 64 + fr, col0 = u.pn * BM + wc * 32 + 8 * fq;
#pragma unroll
        for (int ai = 0; ai < 2; ++ai)
#pragma unroll
            for (int m = 0; m < 4; ++m) { bf16_t* rowp = O + (size_t)(row0 + ai * HALF + m * 16) * ld + col0;
#pragma unroll
                for (int bj = 0; bj < 2; ++bj) st8_bf16(rowp + bj * HALF, acc[ai][bj][m][0], acc[ai][bj][m][1]); }
    }
};
struct EpiMix {
    static constexpr bool PERM = true, AFTER_DRAIN = false;
    bf16_t* O; int ld; const f32x2* rope;
    __device__ __forceinline__ void operator()(const f32x4 (&acc)[2][2][4][2], const Unit& u, int wr, int wc, int fr, int fq) const {
        const int row0 = u.pm * BM + wr * 64 + fr, col0 = u.pn * BM + wc * 32 + 8 * fq;
        const int pmod = u.pm % 9;
        if (u.pn >= 8 || pmod == 0) {
#pragma unroll
            for (int ai = 0; ai < 2; ++ai)
#pragma unroll
                for (int m = 0; m < 4; ++m) { bf16_t* rowp = O + (size_t)(row0 + ai * HALF + m * 16) * ld + col0;
#pragma unroll
                    for (int bj = 0; bj < 2; ++bj) st8_bf16(rowp + bj * HALF, acc[ai][bj][m][0], acc[ai][bj][m][1]); }
        } else {
            const int half = wc & 1, i0 = 8 * (fq & 1); const float sgn = fq < 2 ? -1.f : 1.f;
#pragma unroll
            for (int ai = 0; ai < 2; ++ai) {
                const int tb = (pmod - 1) * 256 + ai * HALF + wr * 64;
#pragma unroll
                for (int m = 0; m < 4; ++m) {
                    const int pos = half ? (m * 16 + fr) : (tb >> 6);
                    const f32x4* rp = (const f32x4*)(rope + pos * 16 + i0);
                    const f32x4 c01 = rp[0], c23 = rp[1], c45 = rp[2], c67 = rp[3];
                    const float cs[8] = {c01[0], c01[2], c23[0], c23[2], c45[0], c45[2], c67[0], c67[2]};
                    const float sn[8] = {c01[1], c01[3], c23[1], c23[3], c45[1], c45[3], c67[1], c67[3]};
                    bf16_t* rowp = O + (size_t)(row0 + ai * HALF + m * 16) * ld + col0;
#pragma unroll
                    for (int bj = 0; bj < 2; ++bj) {
                        f32x4 v0 = acc[ai][bj][m][0], v1 = acc[ai][bj][m][1], o0, o1;
#pragma unroll
                        for (int e = 0; e < 4; ++e) { const float p0 = __shfl_xor(v0[e], 32), p1 = __shfl_xor(v1[e], 32);
                            o0[e] = v0[e] * cs[e] + sgn * p0 * sn[e]; o1[e] = v1[e] * cs[4 + e] + sgn * p1 * sn[4 + e]; }
                        st8_bf16(rowp + bj * HALF, o0, o1);
                    }
                }
            }
        }
    }
};

template <class Epi, class Sched, bool ALIGN_EPI = false, bool SP2 = false>
__device__ __forceinline__ void gemm_phase(PG8_LAS unsigned char* lds, const Gemm g, const Sched& S, const Epi& E) {
    const int tid = otid(), wid = __builtin_amdgcn_readfirstlane(tid >> 6), lane = tid & 63, wr = wid >> 2, wc = wid & 3, fr = lane & 15, fq = lane >> 4;
    const int K = g.K, nt = K / BK;
    unsigned voffA[2], voffB[2];
#pragma unroll
    for (int i = 0; i < 2; ++i) { int R, C; stage_rc(tid * 16 + i * 8192, R, C); const int Rb = Epi::PERM ? ((R & ~31) + perm32(R & 31)) : R;
        voffA[i] = (unsigned)(R * K + C) * 2u; voffB[i] = (unsigned)(Rb * K + C) * 2u; }
    const size_t kstep = (size_t)(BK * 2);
    const size_t hstep = (size_t)HALF * K * 2;
    const size_t tstep = 2 * hstep;
    const unsigned ldsw = (unsigned)wid * 1024u;
    const int aoff = lds_byte(wr * 64 + fr, fq * 8), boff = lds_byte(wc * 32 + fr, fq * 8);
#define PG8_SA(b, h) (((b) * 2 + (h)) * HTB)
#define PG8_SB(b, h) ((4 + (b) * 2 + (h)) * HTB)
#define PG8_STAGE(bufoff, gbase, voff) do { _Pragma("unroll") for (int _i = 0; _i < 2; ++_i) \
        __builtin_amdgcn_global_load_lds((const unsigned*)((const char*)(gbase) + (voff)[_i]), (PG8_LAS unsigned*)(lds + (bufoff) + ldsw + _i * 8192), 16, 0, 0); } while (0)
#define PG8_LDA(dst, b, h) do { _Pragma("unroll") for (int m = 0; m < 4; ++m) _Pragma("unroll") for (int k = 0; k < 2; ++k) dst[m][k] = *(const PG8_LAS bf16x8*)(lds + PG8_SA(b, h) + aoff + m * 2048 + k * 1024); } while (0)
#define PG8_LDB(dst, b, h) do { _Pragma("unroll") for (int n = 0; n < 2; ++n) _Pragma("unroll") for (int k = 0; k < 2; ++k) dst[n][k] = *(const PG8_LAS bf16x8*)(lds + PG8_SB(b, h) + boff + n * 2048 + k * 1024); } while (0)
#define PG8_MMA(ai, bj, At, Bt) do { __builtin_amdgcn_s_setprio(1); _Pragma("unroll") for (int m = 0; m < 4; ++m) _Pragma("unroll") for (int n = 0; n < 2; ++n) _Pragma("unroll") for (int k = 0; k < 2; ++k) \
        acc[ai][bj][m][n] = __builtin_amdgcn_mfma_f32_16x16x32_bf16(Bt[n][k], At[m][k], acc[ai][bj][m][n], 0, 0, 0); __builtin_amdgcn_s_setprio(0); } while (0)
#define PG8_WAIT_V(n) asm volatile("s_waitcnt vmcnt(" #n ")" ::: "memory")
#define PG8_WAIT_L(n) asm volatile("s_waitcnt lgkmcnt(" #n ")" ::: "memory")
#define PG8_BAR __builtin_amdgcn_s_barrier()
#define PG8_SCHED __builtin_amdgcn_sched_barrier(0)
    Unit cur, nxt; int ui = 0;
    if (!S.next(0, cur)) return;
    f32x4 acc[2][2][4][2];
#pragma unroll
    for (int a = 0; a < 2; ++a)
#pragma unroll
        for (int b = 0; b < 2; ++b)
#pragma unroll
            for (int m = 0; m < 4; ++m)
#pragma unroll
                for (int n = 0; n < 2; ++n) acc[a][b][m][n] = (f32x4){0.f, 0.f, 0.f, 0.f};
    bf16x8 At[4][2], B0[2][2], B1[2][2];
    const char* cA = (const char*)g.A + (size_t)cur.pm * tstep; const char* cB = (const char*)g.Bt + (size_t)cur.pn * tstep;
    S.a_ready(cur);
    if constexpr (SP2) {
        PG8_STAGE(PG8_SB(0, 0), cB, voffB); PG8_STAGE(PG8_SB(0, 1), cB + hstep, voffB); PG8_STAGE(PG8_SA(0, 0), cA, voffA); PG8_STAGE(PG8_SA(0, 1), cA + hstep, voffA);
        if (wr == 1) PG8_BAR;
        PG8_WAIT_V(2); PG8_BAR;
        PG8_STAGE(PG8_SB(1, 0), cB + kstep, voffB); PG8_STAGE(PG8_SA(1, 0), cA + kstep, voffA); PG8_STAGE(PG8_SB(1, 1), cB + hstep + kstep, voffB);
        PG8_WAIT_V(6); PG8_BAR;
    } else {
        PG8_STAGE(PG8_SB(0, 0), cB, voffB); PG8_STAGE(PG8_SA(0, 0), cA, voffA); PG8_STAGE(PG8_SB(0, 1), cB + hstep, voffB); PG8_STAGE(PG8_SA(0, 1), cA + hstep, voffA);
        if (wr == 1) PG8_BAR;
        PG8_WAIT_V(4); PG8_BAR;
        PG8_STAGE(PG8_SB(1, 0), cB + kstep, voffB); PG8_STAGE(PG8_SA(1, 0), cA + kstep, voffA); PG8_STAGE(PG8_SB(1, 1), cB + hstep + kstep, voffB);
        PG8_WAIT_V(6); PG8_BAR;
    }
    for (;;) {
        const bool has_next = S.next(ui + 1, nxt);
        const char* nA = has_next ? (const char*)g.A + (size_t)nxt.pm * tstep : cA; const char* nB = has_next ? (const char*)g.Bt + (size_t)nxt.pn * tstep : cB;
        for (int t = 0; t < nt; t += 2) {
            const bool last = (t == nt - 2);
            const char* a1 = cA + (size_t)(t + 1) * kstep;
            const char* a2 = last ? nA : cA + (size_t)(t + 2) * kstep; const char* b2 = last ? nB : cB + (size_t)(t + 2) * kstep;
            const char* a3 = a2 + kstep; const char* b3 = b2 + kstep;
            if (last && has_next) S.a_ready(nxt);
            if constexpr (SP2) {
            PG8_LDB(B0, 0, 0); PG8_LDB(B1, 0, 1); PG8_SCHED; PG8_LDA(At, 0, 0); PG8_STAGE(PG8_SA(1, 1), a1 + hstep, voffA);
            PG8_WAIT_V(8); PG8_WAIT_L(0); PG8_BAR; PG8_MMA(0, 0, At, B0); PG8_MMA(0, 1, At, B1); PG8_BAR; PG8_SCHED;
            PG8_LDA(At, 0, 1); PG8_STAGE(PG8_SB(0, 0), b2, voffB); PG8_STAGE(PG8_SB(0, 1), b2 + hstep, voffB); PG8_STAGE(PG8_SA(0, 0), a2, voffA);
            PG8_WAIT_V(8); PG8_WAIT_L(0); PG8_BAR; PG8_MMA(1, 0, At, B0); PG8_MMA(1, 1, At, B1); PG8_BAR; PG8_SCHED;
            PG8_LDB(B0, 1, 0); PG8_LDB(B1, 1, 1); PG8_SCHED; PG8_LDA(At, 1, 0); PG8_STAGE(PG8_SA(0, 1), a2 + hstep, voffA);
            PG8_WAIT_V(8); PG8_WAIT_L(0); PG8_BAR; PG8_MMA(0, 0, At, B0); PG8_MMA(0, 1, At, B1); PG8_BAR; PG8_SCHED;
            PG8_LDA(At, 1, 1); PG8_STAGE(PG8_SB(1, 0), b3, voffB); PG8_STAGE(PG8_SB(1, 1), b3 + hstep, voffB); PG8_STAGE(PG8_SA(1, 0), a3, voffA);
            PG8_WAIT_V(8); PG8_WAIT_L(0); PG8_BAR; PG8_MMA(1, 0, At, B0); PG8_MMA(1, 1, At, B1); PG8_BAR; PG8_SCHED;
            } else {
            PG8_LDB(B0, 0, 0); PG8_SCHED; PG8_LDA(At, 0, 0); PG8_STAGE(PG8_SA(1, 1), a1 + hstep, voffA);
            PG8_WAIT_L(8); PG8_BAR; PG8_WAIT_L(0); PG8_MMA(0, 0, At, B0); PG8_BAR; PG8_SCHED;
            PG8_LDB(B1, 0, 1); PG8_STAGE(PG8_SB(0, 0), b2, voffB);
            PG8_BAR; PG8_WAIT_L(0); PG8_MMA(0, 1, At, B1); PG8_BAR;
            PG8_LDA(At, 0, 1); PG8_STAGE(PG8_SA(0, 0), a2, voffA);
            PG8_BAR; PG8_WAIT_L(0); PG8_MMA(1, 0, At, B0); PG8_BAR; PG8_SCHED;
            PG8_STAGE(PG8_SB(0, 1), b2 + hstep, voffB);
            PG8_WAIT_V(6); PG8_BAR; PG8_MMA(1, 1, At, B1); PG8_BAR;
            PG8_LDB(B0, 1, 0); PG8_SCHED; PG8_LDA(At, 1, 0); PG8_STAGE(PG8_SA(0, 1), a2 + hstep, voffA);
            PG8_WAIT_L(8); PG8_BAR; PG8_WAIT_L(0); PG8_MMA(0, 0, At, B0); PG8_BAR; PG8_SCHED;
            PG8_LDB(B1, 1, 1); PG8_STAGE(PG8_SB(1, 0), b3, voffB);
            PG8_BAR; PG8_WAIT_L(0); PG8_MMA(0, 1, At, B1); PG8_BAR;
            PG8_LDA(At, 1, 1); PG8_STAGE(PG8_SA(1, 0), a3, voffA);
            PG8_BAR; PG8_WAIT_L(0); PG8_MMA(1, 0, At, B0); PG8_BAR; PG8_SCHED;
            PG8_STAGE(PG8_SB(1, 1), b3 + hstep, voffB);
            PG8_WAIT_V(6); PG8_BAR; PG8_MMA(1, 1, At, B1); PG8_BAR;
            }
        }
        if constexpr (ALIGN_EPI) { if (wr == 0) PG8_BAR; }
        if constexpr (!Epi::AFTER_DRAIN) { E(acc, cur, wr, wc, fr, fq); S.done(cur); }
        if (!has_next) break;
#pragma unroll
        for (int a = 0; a < 2; ++a)
#pragma unroll
            for (int b = 0; b < 2; ++b)
#pragma unroll
                for (int m = 0; m < 4; ++m)
#pragma unroll
                    for (int n = 0; n < 2; ++n) acc[a][b][m][n] = (f32x4){0.f, 0.f, 0.f, 0.f};
        cur = nxt; cA = nA; cB = nB; ++ui;
        if constexpr (ALIGN_EPI) { if (wr == 1) PG8_BAR; }
    }
    PG8_WAIT_V(0);
    if constexpr (!ALIGN_EPI) { if (wr == 0) PG8_BAR; }
    PG8_BAR;
    if constexpr (Epi::AFTER_DRAIN) { E.fused(acc, cur, wr, wc, fr, fq, lds, wid, lane); S.done(cur); }
#undef PG8_SA
#undef PG8_SB
#undef PG8_STAGE
#undef PG8_LDA
#undef PG8_LDB
#undef PG8_MMA
#undef PG8_WAIT_V
#undef PG8_WAIT_L
#undef PG8_BAR
#undef PG8_SCHED
}
}

namespace att {
constexpr int NW = 8, QBLK = 32, KVBLK = 64, DV = 128, DQ = 64;
constexpr float SCALE = 0.125f, THR = 8.f;
constexpr int LDQ = MIXIN, LDK = MIXIN, LDO = 1024;
constexpr int SHM_V = KVBLK * DV * 2, SHM_K = KVBLK * DQ * 2, SHM_ATTN = 2 * SHM_V + 2 * SHM_K + NW * 64 * 4;
#define KSWZ(row, colB) ((row) * 128 + ((colB) ^ (((row) & 7) << 4)))
#define SBAR() __builtin_amdgcn_sched_barrier(0)
__device__ __forceinline__ int crow(int r, int hi) { return (r & 3) + 8 * (r >> 2) + 4 * hi; }
__device__ __forceinline__ unsigned cvtpkv(float lo, float hi) { unsigned r; asm volatile("v_cvt_pk_bf16_f32 %0, %1, %2" : "=v"(r) : "v"(lo), "v"(hi)); return r; }
__device__ __forceinline__ void partialSM(f32x16& p0, f32x16& p1, float& m_reg, float& mn, float& alpha) {
  constexpr float C = SCALE * 1.4426950408889634f;
  float pmax = p0[0]; for (int r = 1; r < 16; ++r) pmax = fmaxf(pmax, p0[r]); for (int r = 0; r < 16; ++r) pmax = fmaxf(pmax, p1[r]);
  { auto rr = __builtin_amdgcn_permlane32_swap(__float_as_uint(pmax), __float_as_uint(pmax), false, false);
    pmax = fmaxf(__uint_as_float(rr[0]), __uint_as_float(rr[1])); }
  if (__builtin_expect(__all(pmax - m_reg <= THR / SCALE), 1)) { mn = m_reg; alpha = 1.f; }
  else { mn = fmaxf(m_reg, pmax); alpha = __builtin_amdgcn_exp2f((m_reg - mn) * C); m_reg = mn; }
  float mnC = -mn * C;
  for (int r = 0; r < 16; ++r) p0[r] = fmaf(p0[r], C, mnC); for (int r = 0; r < 16; ++r) p1[r] = fmaf(p1[r], C, mnC);
  for (int r = 0; r < 16; ++r) p0[r] = __builtin_amdgcn_exp2f(p0[r]);
}
__device__ __forceinline__ void finishSM(f32x16& p0, f32x16& p1, float alpha, float& l_reg, bf16x8& pa0, bf16x8& pa1, bf16x8& pa2, bf16x8& pa3) {
  for (int r = 0; r < 16; ++r) p1[r] = __builtin_amdgcn_exp2f(p1[r]);
  float ps = 0; for (int r = 0; r < 16; ++r) ps += p0[r]; for (int r = 0; r < 16; ++r) ps += p1[r];
  { auto rr = __builtin_amdgcn_permlane32_swap(__float_as_uint(ps), __float_as_uint(ps), false, false);
    ps = __uint_as_float(rr[0]) + __uint_as_float(rr[1]); }
  l_reg = l_reg * alpha + ps;
#define PK4(P, BASE, OUT) do { unsigned a0 = cvtpkv(P[BASE + 0], P[BASE + 1]), a1 = cvtpkv(P[BASE + 2], P[BASE + 3]);   \
    unsigned b0 = cvtpkv(P[BASE + 4], P[BASE + 5]), b1 = cvtpkv(P[BASE + 6], P[BASE + 7]);                              \
    auto r0 = __builtin_amdgcn_permlane32_swap(a0, b0, false, false); auto r1 = __builtin_amdgcn_permlane32_swap(a1, b1, false, false); \
    u32x4 w = {r0[0], r1[0], r0[1], r1[1]}; OUT = *reinterpret_cast<bf16x8*>(&w); } while (0)
  PK4(p0, 0, pa0); PK4(p0, 8, pa1); PK4(p1, 0, pa2); PK4(p1, 8, pa3);
#undef PK4
}
__device__ __forceinline__ void qkt(f32x16& p0, f32x16& p1, const bf16_t* Ks, const bf16x8* qr, int r32, int hi) {
  p0 = f32x16{}; p1 = f32x16{};
#pragma unroll
  for (int d0 = 0; d0 < 4; ++d0) { int cb = (d0 * 16 + hi * 8) * 2;
    bf16x8 b0 = *reinterpret_cast<const bf16x8*>((const char*)Ks + KSWZ(r32, cb));
    bf16x8 b1 = *reinterpret_cast<const bf16x8*>((const char*)Ks + KSWZ(32 + r32, cb));
    p0 = __builtin_amdgcn_mfma_f32_32x32x16_bf16(b0, qr[d0], p0, 0, 0, 0);
    p1 = __builtin_amdgcn_mfma_f32_32x32x16_bf16(b1, qr[d0], p1, 0, 0, 0); }
}
__device__ __forceinline__ int v_st(int k, int c) { const int kk = (k & ~0xC) | ((k & 4) << 1) | ((k & 8) >> 1); return ((kk >> 3) * 4 + (c >> 5)) * 512 + ((kk & 7) * 32 + (c & 31)) * 2; }
__device__ __forceinline__ int v_rd_base(int lane) { return ((lane & 3) << 3) | (((lane >> 2) & 3) << 6) | (((lane >> 4) & 1) << 5) | (((lane >> 5) & 1) << 8); }
constexpr int v_rd_off(int d0, int ks, int half) { return d0 * 512 + ks * 4096 + half * 2048; }
template <int OFF> __device__ __forceinline__ s16x4 tr_read(int vb) {
  s16x4 r; asm volatile("ds_read_b64_tr_b16 %0, %1 offset:%2" : "=&v"(r) : "v"(vb), "i"(OFF) : "memory"); return r;
}
template <int D0> __device__ __forceinline__ void pv_one(f32x16& od, int vb, bf16x8 pa0, bf16x8 pa1, bf16x8 pa2, bf16x8 pa3) {
  const s16x4 l0 = tr_read<v_rd_off(D0, 0, 0)>(vb), h0 = tr_read<v_rd_off(D0, 0, 1)>(vb), l1 = tr_read<v_rd_off(D0, 1, 0)>(vb), h1 = tr_read<v_rd_off(D0, 1, 1)>(vb);
  const s16x4 l2 = tr_read<v_rd_off(D0, 2, 0)>(vb), h2 = tr_read<v_rd_off(D0, 2, 1)>(vb), l3 = tr_read<v_rd_off(D0, 3, 0)>(vb), h3 = tr_read<v_rd_off(D0, 3, 1)>(vb);
  asm volatile("s_waitcnt lgkmcnt(0)" ::: "memory"); SBAR();
#define PK(L, H) (bf16x8){L[0], L[1], L[2], L[3], H[0], H[1], H[2], H[3]}
  od = __builtin_amdgcn_mfma_f32_32x32x16_bf16(pa0, PK(l0, h0), od, 0, 0, 0);
  od = __builtin_amdgcn_mfma_f32_32x32x16_bf16(pa1, PK(l1, h1), od, 0, 0, 0);
  od = __builtin_amdgcn_mfma_f32_32x32x16_bf16(pa2, PK(l2, h2), od, 0, 0, 0);
  od = __builtin_amdgcn_mfma_f32_32x32x16_bf16(pa3, PK(l3, h3), od, 0, 0, 0);
#undef PK
}
__device__ __forceinline__ void pv_d0(f32x16* o, int vb, bf16x8 pa0, bf16x8 pa1, bf16x8 pa2, bf16x8 pa3) {
  pv_one<0>(o[0], vb, pa0, pa1, pa2, pa3); pv_one<1>(o[1], vb, pa0, pa1, pa2, pa3); pv_one<2>(o[2], vb, pa0, pa1, pa2, pa3); pv_one<3>(o[3], vb, pa0, pa1, pa2, pa3);
}
__device__ __forceinline__ void attn_body(const bf16_t* __restrict__ Qb, const bf16_t* __restrict__ Kh, const bf16_t* __restrict__ Vh, float* __restrict__ Ob, int seq, char* lds) {
  const int tid = otid(), wid = tid >> 6, lane = tid & 63, r32 = lane & 31, hi = lane >> 5;
  bf16_t* V_lds = (bf16_t*)lds; bf16_t* K_lds = (bf16_t*)(lds + 2 * SHM_V);
  float* ws = (float*)(lds + 2 * SHM_V + 2 * SHM_K) + wid * 64; float* li_l = ws; float* al_l = ws + 32;
  float m_reg = -1e30f, l_reg = 0; f32x16 o[4] = {}; bf16x8 qr[4];
  const bf16_t* Qw = Qb + (long)(wid * QBLK + r32) * LDQ + hi * 8;
#pragma unroll
  for (int d0 = 0; d0 < 4; ++d0) qr[d0] = *reinterpret_cast<const bf16x8*>(Qw + d0 * 16);
  const int sr = tid >> 4, sc = (tid & 15) * 8, vst0 = v_st(sr, sc), vst1 = v_st(32 + sr, sc);
  const int kr = tid >> 3, kc = (tid & 7) * 8, kst = KSWZ(kr, kc * 2);
  const int vb0 = (int)(uintptr_t)V_lds + v_rd_base(lane);
  struct { bf16x8 vs0, vs1, ks0; } sr_[2];
#define SLOAD(i, k0) do { sr_[i].vs0 = *reinterpret_cast<const bf16x8*>(&Vh[(long)((k0) + sr) * LDK + sc]); sr_[i].vs1 = *reinterpret_cast<const bf16x8*>(&Vh[(long)((k0) + 32 + sr) * LDK + sc]); \
    sr_[i].ks0 = *reinterpret_cast<const bf16x8*>(&Kh[(long)((k0) + kr) * LDK + kc]); } while (0)
#define SWRITE(b, i) do { *(bf16x8*)((char*)V_lds + (b) * SHM_V + vst0) = sr_[i].vs0;          \
    *(bf16x8*)((char*)V_lds + (b) * SHM_V + vst1) = sr_[i].vs1;                                  \
    *(bf16x8*)((char*)K_lds + (b) * SHM_K + kst) = sr_[i].ks0; } while (0)
#define SWAIT() asm volatile("s_waitcnt vmcnt(3)" ::: "memory")
#define RESC(a) do { if (__any((a) < 1.f)) { if (hi == 0) al_l[r32] = (a); asm volatile("s_waitcnt lgkmcnt(0)" ::: "memory"); \
    for (int d = 0; d < 4; ++d) for (int r = 0; r < 16; ++r) o[d][r] *= al_l[crow(r, hi)]; } } while (0)
  f32x16 pA0, pA1, pB0, pB1; float mnA, mnB, alA, alB; bf16x8 pa0, pa1, pa2, pa3; const int NT = seq / KVBLK;
  constexpr int SE = 0, SO = 1;
  SLOAD(SE, 0); asm volatile("s_waitcnt vmcnt(0)" ::: "memory"); SWRITE(0, SE); __syncthreads();
  qkt(pA0, pA1, K_lds, qr, r32, hi); partialSM(pA0, pA1, m_reg, mnA, alA);
  SLOAD(SO, KVBLK); if (2 < NT) SLOAD(SE, 2 * KVBLK);
  SWAIT(); SWRITE(1, SO); __syncthreads();
  for (int j = 1; j + 1 < NT; j += 2) {
    SBAR(); qkt(pB0, pB1, (bf16_t*)((char*)K_lds + SHM_K), qr, r32, hi);
    finishSM(pA0, pA1, alA, l_reg, pa0, pa1, pa2, pa3); SBAR();
    SLOAD(SO, (j + 2) * KVBLK); SBAR();
    pv_d0(o, vb0, pa0, pa1, pa2, pa3); partialSM(pB0, pB1, m_reg, mnB, alB);
    __syncthreads(); SWAIT(); SWRITE(0, SE);
    RESC(alB); __syncthreads();
    SBAR(); qkt(pA0, pA1, K_lds, qr, r32, hi);
    finishSM(pB0, pB1, alB, l_reg, pa0, pa1, pa2, pa3); SBAR();
    if (j + 3 < NT) SLOAD(SE, (j + 3) * KVBLK); SBAR();
    pv_d0(o, vb0 + (int)SHM_V, pa0, pa1, pa2, pa3); partialSM(pA0, pA1, m_reg, mnA, alA);
    __syncthreads(); SWAIT(); SWRITE(1, SO);
    RESC(alA); __syncthreads();
  }
  SBAR(); qkt(pB0, pB1, (bf16_t*)((char*)K_lds + SHM_K), qr, r32, hi);
  finishSM(pA0, pA1, alA, l_reg, pa0, pa1, pa2, pa3); SBAR();
  pv_d0(o, vb0, pa0, pa1, pa2, pa3); partialSM(pB0, pB1, m_reg, mnB, alB);
  __syncthreads(); RESC(alB);
  finishSM(pB0, pB1, alB, l_reg, pa0, pa1, pa2, pa3); SBAR();
  pv_d0(o, vb0 + (int)SHM_V, pa0, pa1, pa2, pa3);
  if (hi == 0) li_l[r32] = l_reg; asm volatile("s_waitcnt lgkmcnt(0)" ::: "memory");
  float rli[16];
#pragma unroll
  for (int r = 0; r < 16; ++r) rli[r] = __builtin_amdgcn_rcpf(li_l[crow(r, hi)]);
  float* Ow = Ob + (long)(wid * QBLK) * LDO;
#pragma unroll
  for (int r = 0; r < 16; ++r) { int orow = crow(r, hi);
    for (int d0 = 0; d0 < 4; ++d0) Ow[(long)orow * LDO + d0 * 32 + r32] = o[d0][r] * rli[r]; }
#undef SLOAD
#undef SWRITE
#undef SWAIT
#undef RESC
}
}

__device__ __forceinline__ int hcrow(int r, int hi) { return (r & 3) + 8 * (r >> 2) + 4 * hi; }
__device__ __forceinline__ void hgrn_unit(const Args& a, LAS unsigned char* lds, int unit) {
    const int tid = otid(), w = __builtin_amdgcn_readfirstlane(tid >> 6), lane = tid & 63, r32 = lane & 31, hi = lane >> 5;
    const int dir = unit & 1, h = (unit >> 1) & 7, b = unit >> 4;
    constexpr int PQ = 136, PS = 72;
    LAS bf16_t* Qt = (LAS bf16_t*)lds;
    LAS bf16_t* Kt = Qt + 64 * PQ;
    LAS bf16_t* KhT = Kt + 64 * PQ;
    LAS bf16_t* Vt = KhT + 128 * PS;
    LAS bf16_t* At = Vt + 128 * PS;
    LAS bf16_t* St = At + 64 * PS;
    LAS float* part = (LAS float*)(St + 128 * PQ);
    LAS float* dec = part + 8 * 128;
    const bf16_t* MP = (const bf16_t*)(a.ws + WS_MP);
    float* OREC = (float*)(a.ws + WS_OREC) + (size_t)dir * ML * 1024;
    const int kp = lane;
    float lb[2];
#pragma unroll
    for (int j = 0; j < 2; ++j) { const float a0 = a.in[I_RLB][(dir * 2 + 0) * 1024 + h * 128 + 2 * kp + j], a1 = a.in[I_RLB][(dir * 2 + 1) * 1024 + h * 128 + 2 * kp + j];
        lb[j] = 1.f / (1.f + __expf(a1 - a0)); }
    __syncthreads();
    for (int i = tid; i < 128 * PQ / 2; i += 512) ((LAS unsigned*)St)[i] = 0u;
    f32x16 S[2] = {};
    unsigned q2[8], z2[8], v2[8];
    const int zcol = (dir ? 5120 : 4096) + h * 128 + 2 * kp, qcol = 3072 + h * 128 + 2 * kp, vcol = 6144 + h * 128 + 2 * kp;
#define HG_ROWBASE(c) (b * RS + (dir ? ((c) < 4 ? 192 - 64 * (c) : RS - 64 * ((c) - 3)) : 64 * (c)))
#define HG_LOAD(c) do { const int rb_ = HG_ROWBASE(c); _Pragma("unroll") for (int e = 0; e < 8; ++e) { const int tau = 8 * w + e, rr = dir ? 63 - tau : tau; \
        const bf16_t* rp = MP + (size_t)(rb_ + rr) * MIXIN; q2[e] = *(const unsigned*)(rp + qcol); z2[e] = *(const unsigned*)(rp + zcol); v2[e] = *(const unsigned*)(rp + vcol); } } while (0)
    HG_LOAD(0);
    const int ti = w >> 2, vi = w & 3, ki = w >> 1, vi0 = 2 * (w & 1);
    for (int c = 0; c < 36; ++c) {
        const int rowbase = HG_ROWBASE(c);
        float Pl[8][2], fk[8][2]; float p0 = 1.f, p1 = 1.f;
#pragma unroll
        for (int e = 0; e < 8; ++e) {
            const float f0 = lb[0] + (1.f - lb[0]) * sigmoidf_(bflo(z2[e])), f1 = lb[1] + (1.f - lb[1]) * sigmoidf_(bfhi(z2[e]));
            p0 *= f0; p1 *= f1; Pl[e][0] = p0; Pl[e][1] = p1; fk[e][0] = 1.f - f0; fk[e][1] = 1.f - f1;
        }
        *(LAS f32x2*)(part + w * 128 + 2 * kp) = (f32x2){p0, p1};
        __syncthreads();
        float off0 = 1.f, off1 = 1.f, tot0 = 1.f, tot1 = 1.f;
#pragma unroll
        for (int x = 0; x < 8; ++x) { const f32x2 pp = *(LAS f32x2*)(part + x * 128 + 2 * kp); tot0 *= pp[0]; tot1 *= pp[1]; if (x < w) { off0 *= pp[0]; off1 *= pp[1]; } }
        unsigned kh0[4], kh1[4], vt0[4], vt1[4];
        float kha[8][2];
#pragma unroll
        for (int e = 0; e < 8; ++e) {
            const int tau = 8 * w + e;
            const float P0 = fmaxf(off0 * Pl[e][0], 1e-35f), P1 = fmaxf(off1 * Pl[e][1], 1e-35f);
            const float i0 = __builtin_amdgcn_rcpf(P0), i1 = __builtin_amdgcn_rcpf(P1);
            const float qs0 = bflo(q2[e]) * 0.08838834764831845f * P0, qs1 = bfhi(q2[e]) * 0.08838834764831845f * P1;
            const float kt0 = fk[e][0] * i0, kt1 = fk[e][1] * i1;
            kha[e][0] = kt0 * tot0; kha[e][1] = kt1 * tot1;
            *(LAS unsigned*)(Qt + tau * PQ + 2 * kp) = cvtpk(qs0, qs1);
            *(LAS unsigned*)(Kt + tau * PQ + 2 * kp) = cvtpk(kt0, kt1);
        }
#pragma unroll
        for (int e = 0; e < 4; ++e) { kh0[e] = cvtpk(kha[2 * e][0], kha[2 * e + 1][0]); kh1[e] = cvtpk(kha[2 * e][1], kha[2 * e + 1][1]);
            vt0[e] = (v2[2 * e] & 0xffffu) | (v2[2 * e + 1] << 16); vt1[e] = (v2[2 * e] >> 16) | (v2[2 * e + 1] & 0xffff0000u); }
        *(LAS u32x4*)(KhT + (2 * kp) * PS + 8 * w) = (u32x4){kh0[0], kh0[1], kh0[2], kh0[3]};
        *(LAS u32x4*)(KhT + (2 * kp + 1) * PS + 8 * w) = (u32x4){kh1[0], kh1[1], kh1[2], kh1[3]};
        *(LAS u32x4*)(Vt + (2 * kp) * PS + 8 * w) = (u32x4){vt0[0], vt0[1], vt0[2], vt0[3]};
        *(LAS u32x4*)(Vt + (2 * kp + 1) * PS + 8 * w) = (u32x4){vt1[0], vt1[1], vt1[2], vt1[3]};
        if (w == 0) *(LAS f32x2*)(dec + 2 * kp) = (f32x2){tot0, tot1};
        if (c + 1 < 36) HG_LOAD(c + 1);
        __syncthreads();
        const bool outc = c >= 4;
        f32x16 o = {};
        if (outc) {
#pragma unroll
            for (int j = 0; j < 8; ++j) { const bf16x8 A = *(const LAS bf16x8*)(Qt + (32 * ti + r32) * PQ + 16 * j + 8 * hi), B = *(const LAS bf16x8*)(St + (32 * vi + r32) * PQ + 16 * j + 8 * hi);
                o = __builtin_amdgcn_mfma_f32_32x32x16_bf16(A, B, o, 0, 0, 0); }
            if (w < 4) {
                const int ta = w >> 1, sa = w & 1;
                f32x16 acc = {};
                if (sa <= ta) {
#pragma unroll
                    for (int j = 0; j < 8; ++j) { const bf16x8 A = *(const LAS bf16x8*)(Qt + (32 * ta + r32) * PQ + 16 * j + 8 * hi), B = *(const LAS bf16x8*)(Kt + (32 * sa + r32) * PQ + 16 * j + 8 * hi);
                        acc = __builtin_amdgcn_mfma_f32_32x32x16_bf16(A, B, acc, 0, 0, 0); }
                }
#pragma unroll
                for (int i = 0; i < 16; ++i) { const int t = 32 * ta + hcrow(i, hi), s = 32 * sa + r32; const float v = (s <= t) ? acc[i] : 0.f;
                    At[t * PS + s] = (bf16_t)(cvtpk(v, 0.f) & 0xffffu); }
            }
        }
#pragma unroll
        for (int x = 0; x < 2; ++x) {
#pragma unroll
            for (int i = 0; i < 16; ++i) S[x][i] *= dec[32 * ki + hcrow(i, hi)];
#pragma unroll
            for (int j = 0; j < 4; ++j) { const bf16x8 A = *(const LAS bf16x8*)(KhT + (32 * ki + r32) * PS + 16 * j + 8 * hi), B = *(const LAS bf16x8*)(Vt + (32 * (vi0 + x) + r32) * PS + 16 * j + 8 * hi);
                S[x] = __builtin_amdgcn_mfma_f32_32x32x16_bf16(A, B, S[x], 0, 0, 0); }
        }
        __syncthreads();
        if (outc) {
#pragma unroll
            for (int j = 0; j < 4; ++j) { const bf16x8 A = *(const LAS bf16x8*)(At + (32 * ti + r32) * PS + 16 * j + 8 * hi), B = *(const LAS bf16x8*)(Vt + (32 * vi + r32) * PS + 16 * j + 8 * hi);
                o = __builtin_amdgcn_mfma_f32_32x32x16_bf16(A, B, o, 0, 0, 0); }
#pragma unroll
            for (int i = 0; i < 16; ++i) { const int tau = 32 * ti + hcrow(i, hi), rr = dir ? 63 - tau : tau; const int lrow = rowbase + rr - 256 * (b + 1);
                OREC[(size_t)lrow * 1024 + h * 128 + 32 * vi + r32] = o[i]; }
        }
#pragma unroll
        for (int x = 0; x < 2; ++x)
#pragma unroll
            for (int g = 0; g < 4; ++g) { const int k0 = 32 * ki + 8 * g + 4 * hi;
                *(LAS u32x2*)(St + (32 * (vi0 + x) + r32) * PQ + k0) = (u32x2){cvtpk(S[x][4 * g], S[x][4 * g + 1]), cvtpk(S[x][4 * g + 2], S[x][4 * g + 3])}; }
    }
    __syncthreads();
#undef HG_LOAD
#undef HG_ROWBASE
}

__device__ __forceinline__ void transpose_item(const float* __restrict__ src, int ldn, int k0, int n0, bf16_t* __restrict__ dst, int Kd, int drow, LAS float* scr, int lane) {
    const int cl = (lane & 15) * 4, ks = lane >> 4;
    f32x4 v[16];
#pragma unroll
    for (int i = 0; i < 16; ++i) v[i] = __builtin_nontemporal_load((const f32x4*)(src + (size_t)(k0 + 4 * i + ks) * ldn + n0 + cl));
#pragma unroll
    for (int i = 0; i < 16; ++i) { LAS float* s = scr + (4 * i + ks) * 65 + cl; s[0] = v[i][0]; s[1] = v[i][1]; s[2] = v[i][2]; s[3] = v[i][3]; }
    asm volatile("s_waitcnt lgkmcnt(0)" ::: "memory");
    const int c = lane & 7;
#pragma unroll
    for (int j = 0; j < 8; ++j) { const int n = (lane >> 3) + 8 * j; const LAS float* s = scr + (8 * c) * 65 + n;
        u32x4 o; o.x = cvtpk(s[0 * 65], s[1 * 65]); o.y = cvtpk(s[2 * 65], s[3 * 65]); o.z = cvtpk(s[4 * 65], s[5 * 65]); o.w = cvtpk(s[6 * 65], s[7 * 65]);
        __builtin_nontemporal_store(o, (u32x4*)(dst + (size_t)(drow + n) * Kd + k0 + 8 * c)); }
    asm volatile("s_waitcnt lgkmcnt(0)" ::: "memory");
}
constexpr int T_FFN = 12 * 2752, T_MI = 4096, T_SQ = 1024, T_CI = 3072, T_ALL = T_FFN + T_MI + 2 * T_SQ + T_CI;
__device__ __forceinline__ void convert_item(const Args& a, int it, LAS float* scr, int lane) {
    bf16_t* WGU = (bf16_t*)(a.ws + WS_WGU); bf16_t* WD = (bf16_t*)(a.ws + WS_WD);
        const float* src; int ldn, k0, n0, Kd, drow; bf16_t* dst;
        if (it < T_FFN) { const int m = it / 2752, r = it % 2752, f = m / 3, kind = m % 3;
            if (kind < 2) { k0 = (r / 86) * 64; n0 = (r % 86) * 64; src = a.in[kind ? I_WU : I_WG] + (size_t)f * DM * DFF; ldn = DFF; Kd = DM; dst = WGU + (size_t)f * 2 * DFF * DM; drow = (n0 >> 7) * 256 + kind * 128 + (n0 & 127); }
            else { k0 = (r / 32) * 64; n0 = (r % 32) * 64; src = a.in[I_WDN] + (size_t)f * DFF * DM; ldn = DM; Kd = DFF; dst = WD + (size_t)f * DM * DFF; drow = n0; }
        } else if (it < T_FFN + T_MI) { const int r = it - T_FFN; k0 = (r / 128) * 64; n0 = (r % 128) * 64; src = a.in[I_MIXIN]; ldn = MIXIN; Kd = DM; dst = (bf16_t*)(a.ws + WS_WMI); drow = n0; }
        else if (it < T_FFN + T_MI + T_SQ) { const int r = it - T_FFN - T_MI; k0 = (r / 32) * 64; n0 = (r % 32) * 64; src = a.in[I_MIXOUT]; ldn = DM; Kd = DM; dst = (bf16_t*)(a.ws + WS_WMO); drow = n0; }
        else if (it < T_FFN + T_MI + 2 * T_SQ) { const int r = it - T_FFN - T_MI - T_SQ; k0 = (r / 32) * 64; n0 = (r % 32) * 64; src = a.in[I_CWOUT]; ldn = DM; Kd = DM; dst = (bf16_t*)(a.ws + WS_WCO); drow = n0; }
        else { const int r = it - T_FFN - T_MI - 2 * T_SQ; k0 = (r / 96) * 64; n0 = (r % 96) * 64; src = a.in[I_CWIN]; ldn = 3 * DM; Kd = DM; dst = (bf16_t*)(a.ws + WS_WCI);
            if (n0 < DM) drow = n0; else if (n0 < 2 * DM) { const int j = n0 - DM; drow = DM + (j >> 7) * 256 + (j & 127); } else { const int j = n0 - 2 * DM; drow = DM + (j >> 7) * 256 + 128 + (j & 127); } }
        transpose_item(src, ldn, k0, n0, dst, Kd, drow, scr, lane);
}
#ifndef NSTEAL
#define NSTEAL 4
#endif
__device__ __forceinline__ void convert_steal(const Args& a, LAS unsigned char* lds, unsigned* ctr, int lo1, int n1, int lo2, int n2) {
    const int tid = otid(), w = __builtin_amdgcn_readfirstlane(tid >> 6), lane = tid & 63;
    LAS float* scr = (LAS float*)lds + w * (64 * 65);
    volatile LAS int* bc = (volatile LAS int*)(lds + LDS_BYTES - 32);
    const int n = n1 + n2;
    for (;;) {
        __syncthreads();
        if (tid == 0) bc[0] = (int)__hip_atomic_fetch_add(ctr, (unsigned)NSTEAL, __ATOMIC_RELAXED, __HIP_MEMORY_SCOPE_AGENT);
        __syncthreads();
        const int base = bc[0];
        if (base >= n) break;
        const int j = base + w;
        if (w < NSTEAL && j < n) convert_item(a, j < n1 ? lo1 + j : lo2 + (j - n1), scr, lane);
    }
}
__device__ __forceinline__ void gemv_fill(const Args& a, LAS unsigned char* lds) {
    LAS float* sc = (LAS float*)lds;
    for (int i = otid(); i < 5 * 2048; i += 512) { const float v = i < 8192 ? a.in[I_C][i] : a.in[I_CCTX][i - 8192]; sc[i] = siluf_(v); }
    __syncthreads();
}
__device__ __forceinline__ void gemv_item(const Args& a, LAS unsigned char* lds, int it) {
    const int tid = otid(), w = __builtin_amdgcn_readfirstlane(tid >> 6), lane = tid & 63;
    LAS float* sc = (LAS float*)lds; LAS float* red = sc + 5 * 2048;
    float* MOD = (float*)(a.ws + WS_MOD);
    const int l = it / 288, n0 = (it % 288) * 64, cl = (lane & 15) * 4, ks = lane >> 4;
    const float* W = a.in[I_ADAW] + (size_t)l * DM * MODW + n0 + cl;
    f32x4 acc[5] = {};
#pragma unroll 8
    for (int kk = 0; kk < 256; kk += 4) { const int k = w * 256 + kk + ks; const f32x4 wv = __builtin_nontemporal_load((const f32x4*)(W + (size_t)k * MODW));
#pragma unroll
        for (int i = 0; i < 5; ++i) acc[i] += wv * sc[i * 2048 + k]; }
#pragma unroll
    for (int i = 0; i < 5; ++i)
#pragma unroll
        for (int e = 0; e < 4; ++e) { float v = acc[i][e]; v += __shfl_xor(v, 16); v += __shfl_xor(v, 32); acc[i][e] = v; }
    if (lane < 16) {
#pragma unroll
        for (int i = 0; i < 5; ++i) *(LAS f32x4*)(red + (w * 5 + i) * 64 + cl) = acc[i]; }
    __syncthreads();
    if (tid < 320) { const int i = tid >> 6, cc = tid & 63; float s = a.in[I_ADAB][l * MODW + n0 + cc];
#pragma unroll
        for (int x = 0; x < 8; ++x) s += red[(x * 5 + i) * 64 + cc];
        MOD[((size_t)l * 5 + i) * MODW + n0 + cc] = s; }
    __syncthreads();
}
__device__ __forceinline__ void gemv_steal(const Args& a, LAS unsigned char* lds, unsigned* ctr, int lo, int n) {
    volatile LAS int* bc = (volatile LAS int*)(lds + LDS_BYTES - 32);
    bool filled = false;
    for (;;) {
        __syncthreads();
        if (otid() == 0) bc[0] = (int)__hip_atomic_fetch_add(ctr, 1u, __ATOMIC_RELAXED, __HIP_MEMORY_SCOPE_AGENT);
        __syncthreads();
        const int j = bc[0];
        if (j >= n) break;
        if (!filled) { gemv_fill(a, lds); filled = true; }
        gemv_item(a, lds, lo + j);
    }
}
__device__ __forceinline__ void phase0(const Args& a, LAS unsigned char* lds, int G) {
    const int tid = otid(), w = __builtin_amdgcn_readfirstlane(tid >> 6), lane = tid & 63, bid = obid();
    { const int id = bid * 512 + tid; if (id < 1024) { const int pos = id >> 4, i = id & 15; const float fr = __builtin_amdgcn_exp2f(-(float)i * (13.287712379549449f / 16.f)); const float ang = (float)pos * fr;
        ((f32x2*)(a.ws + WS_ROPE))[id] = (f32x2){__cosf(ang), __sinf(ang)}; } }
    gemv_fill(a, lds);
    for (int it = bid; it < 64; it += G) gemv_item(a, lds, it);
    LAS float* scr = (LAS float*)lds + w * (64 * 65);
    for (int it = bid * 8 + w; it < 2 * 2752; it += G * 8) convert_item(a, it, scr, lane);
}

struct RowP { const bf16_t* xinb; bf16_t* xoutb; const bf16_t* y; const float* xin; const float* ctxin; float* xout; bf16_t* h; int modeR; float wgt; const float* modg; int gidx; const float* gpost; const float* modh; int sidx; const float* gpre; int has_y, has_h; };
__device__ __forceinline__ void row_phase(const RowP& p, int G) {
    const int tid = otid(), w = tid >> 6, lane = tid & 63;
    const int nrows = p.modeR ? MR : ML;
    for (int r0 = (obid() * 8 + w) * 2; r0 < nrows; r0 += G * 16) {
        int mi; const float* xrow; float* xo; size_t lrow = 0;
        if (p.modeR) { const int b = r0 / RS, s = r0 % RS; if (s < CTX) { mi = 4; xrow = p.ctxin + (size_t)(b * CTX + s) * DM; xo = nullptr; } else { mi = b; lrow = (size_t)(b * SEQ + s - CTX); xrow = p.xin + lrow * DM; xo = p.xout; } }
        else { mi = r0 / SEQ; lrow = (size_t)r0; xrow = p.xin + lrow * DM; xo = p.xout; }
        const bool isctx = p.modeR && mi == 4;
        f32x4 xv[2][4][2]; u32x4 yv[2][4];
        if (p.xinb && !isctx) {
#pragma unroll
            for (int q = 0; q < 2; ++q)
#pragma unroll
                for (int j = 0; j < 4; ++j) { const u32x4 xx = *(const u32x4*)(p.xinb + (lrow + q) * DM + 8 * lane + 512 * j);
                    xv[q][j][0] = (f32x4){bflo(xx[0]), bfhi(xx[0]), bflo(xx[1]), bfhi(xx[1])}; xv[q][j][1] = (f32x4){bflo(xx[2]), bfhi(xx[2]), bflo(xx[3]), bfhi(xx[3])}; }
        } else {
#pragma unroll
            for (int q = 0; q < 2; ++q)
#pragma unroll
                for (int j = 0; j < 4; ++j) { const float* xp = xrow + (size_t)q * DM + 8 * lane + 512 * j; xv[q][j][0] = *(const f32x4*)xp; xv[q][j][1] = *(const f32x4*)(xp + 4); }
        }
        if (p.has_y) {
#pragma unroll
            for (int q = 0; q < 2; ++q)
#pragma unroll
                for (int j = 0; j < 4; ++j) yv[q][j] = *(const u32x4*)(p.y + (size_t)(r0 + q) * DM + 8 * lane + 512 * j);
            float ss[2] = {0.f, 0.f};
#pragma unroll
            for (int q = 0; q < 2; ++q)
#pragma unroll
                for (int j = 0; j < 4; ++j)
#pragma unroll
                    for (int e = 0; e < 4; ++e) { const float a = bflo(yv[q][j][e]), b = bfhi(yv[q][j][e]); ss[q] += a * a + b * b; }
            const float ry0 = rsqrtf(wave_sum(ss[0]) * (1.f / DM) + EPS) * p.wgt, ry1 = rsqrtf(wave_sum(ss[1]) * (1.f / DM) + EPS) * p.wgt;
            const float* gate = p.modg + (size_t)mi * MODW + p.gidx * DM;
#pragma unroll
            for (int j = 0; j < 4; ++j) { const int c = 8 * lane + 512 * j;
                const f32x4 gt0 = *(const f32x4*)(gate + c) * *(const f32x4*)(p.gpost + c), gt1 = *(const f32x4*)(gate + c + 4) * *(const f32x4*)(p.gpost + c + 4);
#pragma unroll
                for (int q = 0; q < 2; ++q) { const float ry = q ? ry1 : ry0; const u32x4 yy = yv[q][j];
                    const f32x4 y0 = {bflo(yy[0]), bfhi(yy[0]), bflo(yy[1]), bfhi(yy[1])}, y1 = {bflo(yy[2]), bfhi(yy[2]), bflo(yy[3]), bfhi(yy[3])};
                    xv[q][j][0] = xv[q][j][0] + gt0 * (y0 * ry); xv[q][j][1] = xv[q][j][1] + gt1 * (y1 * ry);
                    if (!isctx) { if (p.xoutb) *(u32x4*)(p.xoutb + (lrow + q) * DM + c) = (u32x4){cvtpk(xv[q][j][0][0], xv[q][j][0][1]), cvtpk(xv[q][j][0][2], xv[q][j][0][3]), cvtpk(xv[q][j][1][0], xv[q][j][1][1]), cvtpk(xv[q][j][1][2], xv[q][j][1][3])};
                                  else { float* op = xo + (lrow + q) * DM + c; *(f32x4*)op = xv[q][j][0]; *(f32x4*)(op + 4) = xv[q][j][1]; } } } }
        }
        if (p.has_h) {
            float ss[2] = {0.f, 0.f};
#pragma unroll
            for (int q = 0; q < 2; ++q)
#pragma unroll
                for (int j = 0; j < 4; ++j)
#pragma unroll
                    for (int k = 0; k < 2; ++k) { const f32x4 v = xv[q][j][k]; ss[q] += (v[0] * v[0] + v[1] * v[1]) + (v[2] * v[2] + v[3] * v[3]); }
            const float rx0 = rsqrtf(wave_sum(ss[0]) * (1.f / DM) + EPS), rx1 = rsqrtf(wave_sum(ss[1]) * (1.f / DM) + EPS);
            const float* sh = p.modh + (size_t)mi * MODW + p.sidx * DM; const float* scl = sh + DM;
#pragma unroll
            for (int j = 0; j < 4; ++j) { const int c = 8 * lane + 512 * j;
                const f32x4 m0 = *(const f32x4*)(p.gpre + c) * (*(const f32x4*)(scl + c) + 1.f), m1 = *(const f32x4*)(p.gpre + c + 4) * (*(const f32x4*)(scl + c + 4) + 1.f);
                const f32x4 s0 = *(const f32x4*)(sh + c), s1 = *(const f32x4*)(sh + c + 4);
#pragma unroll
                for (int q = 0; q < 2; ++q) { const float rx = q ? rx1 : rx0;
                    const f32x4 h0 = (xv[q][j][0] * rx) * m0 + s0, h1 = (xv[q][j][1] * rx) * m1 + s1;
                    *(u32x4*)(p.h + (size_t)(r0 + q) * DM + c) = (u32x4){cvtpk(h0[0], h0[1]), cvtpk(h0[2], h0[3]), cvtpk(h1[0], h1[1]), cvtpk(h1[2], h1[3])}; } }
        }
    }
}

__device__ __forceinline__ float half_sum(float v) {
#pragma unroll
    for (int o = 1; o < 32; o <<= 1) v += __shfl_xor(v, o);
    return v;
}
__device__ __forceinline__ void merge_phase(const Args& a, int G) {
    const int tid = otid(), w = tid >> 6, lane = tid & 63, l32 = lane & 31, hsel = lane >> 5;
    const float* dl = a.in[I_DLAM];
    const float s01 = wave_sum(dl[lane] * dl[64 + lane]), s23 = wave_sum(dl[128 + lane] * dl[192 + lane]);
    const float lam = __expf(s01) - __expf(s23) + 0.2f;
    const float* OA = (const float*)(a.ws + WS_OATT); const float* OR = (const float*)(a.ws + WS_OREC); const bf16_t* MP = (const bf16_t*)(a.ws + WS_MP); bf16_t* MG = (bf16_t*)(a.ws + WS_MG);
    const f32x4 ga = *(const f32x4*)(a.in[I_DNG] + 4 * l32) * 0.8f, gr = *(const f32x4*)(a.in[I_RNG] + 4 * l32);
    for (int lr = obid() * 8 + w; lr < ML; lr += G * 8) {
        const int b = lr / SEQ; const size_t rrow = (size_t)(lr + 256 * (b + 1));
        f32x4 o1[4], o2[4], of[4], ob[4]; u32x2 gw[4];
#pragma unroll
        for (int hp = 0; hp < 4; ++hp) { const size_t c0 = (size_t)lr * 1024 + (2 * hp + hsel) * 128 + 4 * l32;
            o1[hp] = *(const f32x4*)(OA + c0); o2[hp] = *(const f32x4*)(OA + (size_t)ML * 1024 + c0);
            of[hp] = *(const f32x4*)(OR + c0); ob[hp] = *(const f32x4*)(OR + (size_t)ML * 1024 + c0);
            gw[hp] = *(const u32x2*)(MP + rrow * MIXIN + 7168 + (2 * hp + hsel) * 128 + 4 * l32); }
#pragma unroll
        for (int hp = 0; hp < 4; ++hp) { const int c0 = (2 * hp + hsel) * 128 + 4 * l32;
            const f32x4 d = o1[hp] - o2[hp] * lam; const float r = rsqrtf(half_sum((d[0] * d[0] + d[1] * d[1]) + (d[2] * d[2] + d[3] * d[3])) * (1.f / 128.f) + EPS);
            const f32x4 x = d * r * ga;
            *(u32x2*)(MG + (size_t)lr * DM + c0) = (u32x2){cvtpk(x[0], x[1]), cvtpk(x[2], x[3])};
            const f32x4 o = of[hp] + ob[hp]; const float rr = rsqrtf(half_sum((o[0] * o[0] + o[1] * o[1]) + (o[2] * o[2] + o[3] * o[3])) * (1.f / 128.f) + EPS);
            const f32x4 g = {siluf_(bflo(gw[hp][0])), siluf_(bfhi(gw[hp][0])), siluf_(bflo(gw[hp][1])), siluf_(bfhi(gw[hp][1]))};
            const f32x4 y = o * rr * gr * g;
            *(u32x2*)(MG + (size_t)lr * DM + 1024 + c0) = (u32x2){cvtpk(y[0], y[1]), cvtpk(y[2], y[3])}; }
    }
}

__device__ __forceinline__ void conv_phase(const Args& a, int G) {
    const bf16_t* BG = (const bf16_t*)(a.ws + WS_MP); const bf16_t* CV = BG + (size_t)ML * DM; bf16_t* MG = (bf16_t*)(a.ws + WS_MG); const float* cw = a.in[I_CW];
    const int tid = otid(), c = (tid & 255) * 8, rh = tid >> 8;
    f32x4 w0[2], w1[2], w2[2];
#pragma unroll
    for (int k = 0; k < 2; ++k) { w0[k] = *(const f32x4*)(cw + c + 4 * k); w1[k] = *(const f32x4*)(cw + DM + c + 4 * k); w2[k] = *(const f32x4*)(cw + 2 * DM + c + 4 * k); }
    const u32x4 z = {0u, 0u, 0u, 0u};
    for (int it = obid(); it < ML / 16; it += G) {
        const int r0 = it * 16 + rh * 8;
        const int t0 = r0 & (SEQ - 1);
        u32x4 prev = t0 > 0 ? *(const u32x4*)(CV + (size_t)(r0 - 1) * DM + c) : z;
        u32x4 cur = *(const u32x4*)(CV + (size_t)r0 * DM + c);
#pragma unroll
        for (int i = 0; i < 8; ++i) {
            const int lr = r0 + i;
            const u32x4 nxt = (t0 + i < SEQ - 1) ? *(const u32x4*)(CV + (size_t)(lr + 1) * DM + c) : z;
            const u32x4 bg = *(const u32x4*)(BG + (size_t)lr * DM + c);
            u32x4 o;
#pragma unroll
            for (int e = 0; e < 4; ++e) { const int k = e >> 1, q = (e & 1) * 2;
                const float lo = bflo(bg[e]) * (w0[k][q] * bflo(prev[e]) + w1[k][q] * bflo(cur[e]) + w2[k][q] * bflo(nxt[e]));
                const float hi = bfhi(bg[e]) * (w0[k][q + 1] * bfhi(prev[e]) + w1[k][q + 1] * bfhi(cur[e]) + w2[k][q + 1] * bfhi(nxt[e]));
                o[e] = cvtpk(lo, hi); }
            *(u32x4*)(MG + (size_t)lr * DM + c) = o;
            prev = cur; cur = nxt;
        }
    }
}

#define XB_TMO      128
#define XB_XCNT(j)  (256  + 64 * (j))
#define XB_XSUB(j)  (1280 + 64 * (j))
#define XB_XGEN(j)  (2304 + 64 * (j))
#define XB_TOP      3328
#define XB_TOPGEN   3392
#define XCD_BAR_WORDS 3456
#define XB_SPIN_CAP (1u << 18)

__device__ __forceinline__ unsigned xb_ld(unsigned* p)              { return __hip_atomic_load(p, __ATOMIC_RELAXED, __HIP_MEMORY_SCOPE_AGENT); }
__device__ __forceinline__ unsigned xb_add(unsigned* p, unsigned v) { return __hip_atomic_fetch_add(p, v, __ATOMIC_RELAXED, __HIP_MEMORY_SCOPE_AGENT); }
__device__ __forceinline__ unsigned xb_xcc_id() { return (unsigned)__builtin_amdgcn_s_getreg((3 << 11) | 20) & 0xFu; }
#define XB_SPIN(cond, bar) do { unsigned _sp = 0; while (cond) { __builtin_amdgcn_s_sleep(1); \
    if ((++_sp & 255u) == 0u) { if (xb_ld(&(bar)[XB_TMO])) break; if (_sp > XB_SPIN_CAP) { atomicAdd(&(bar)[XB_TMO], 1u); break; } } } } while (0)

struct XcdBarrier {
    unsigned* bar; unsigned x;
    volatile LAS unsigned* st;
};

__device__ __forceinline__ XcdBarrier xcd_barrier_post(unsigned* bar, volatile LAS unsigned* st) {
    XcdBarrier b; b.bar = bar; b.x = xb_xcc_id(); b.st = st;
    if (threadIdx.x == 0) (void)xb_add(&bar[XB_XCNT(b.x)], 1u);
    return b;
}
__device__ __forceinline__ void xcd_barrier_complete(unsigned* bar, unsigned x, unsigned& nloc, unsigned& nx) {
    const unsigned G = gridDim.x * gridDim.y * gridDim.z;
    unsigned sum, cnt, mine, sp = 0u;
    for (;;) {
        sum = 0u; cnt = 0u; mine = 0u;
#pragma unroll
        for (unsigned j = 0; j < 16; ++j) { const unsigned c = xb_ld(&bar[XB_XCNT(j)]); sum += c; cnt += (c > 0u) ? 1u : 0u; mine = (j == x) ? c : mine; }
        if (sum == G) break;
        __builtin_amdgcn_s_sleep(1);
        if ((++sp & 255u) == 0u) { if (xb_ld(&bar[XB_TMO])) break; if (sp > XB_SPIN_CAP) { atomicAdd(&bar[XB_TMO], 1u); break; } }
    }
    nloc = mine > 0u ? mine : 1u; nx = cnt > 0u ? cnt : 1u;
}

__device__ __forceinline__ void xcd_barrier(const XcdBarrier& b) {
    asm volatile("s_waitcnt vmcnt(0)" ::: "memory");
    __syncthreads();
    if (threadIdx.x == 0) {
        unsigned* bar = b.bar;
        __builtin_amdgcn_s_waitcnt(0);
        unsigned nloc = b.st[0], nx = b.st[1];
        if (nloc == 0u) { xcd_barrier_complete(bar, b.x, nloc, nx); b.st[0] = nloc; b.st[1] = nx; }
        const unsigned old = xb_add(&bar[XB_XSUB(b.x)], 1u);
        const unsigned gen = old / nloc;
        if (old + 1u == (gen + 1u) * nloc) {
            __builtin_amdgcn_fence(__ATOMIC_RELEASE, "agent");
            asm volatile("s_waitcnt vmcnt(0)" ::: "memory");
            const unsigned og = xb_add(&bar[XB_TOP], 1u);
            const unsigned tg = og / nx;
            if (og + 1u == (tg + 1u) * nx) xb_add(&bar[XB_TOPGEN], 1u);
            else XB_SPIN(xb_ld(&bar[XB_TOPGEN]) == tg, bar);
            __builtin_amdgcn_fence(__ATOMIC_ACQUIRE, "agent");
            xb_add(&bar[XB_XGEN(b.x)], 1u);
            asm volatile("s_waitcnt vmcnt(0)" ::: "memory");
        } else {
            XB_SPIN(xb_ld(&bar[XB_XGEN(b.x)]) == gen, bar);
            __builtin_amdgcn_fence(__ATOMIC_ACQUIRE, "agent");
            asm volatile("s_waitcnt vmcnt(0)" ::: "memory");
        }
    }
    __syncthreads();
}

#define CTR_WORD(k) (3520 + 64 * (k))
#ifndef PHMASK
#define PHMASK 0x1ff
#endif
#define PHM(x) (((PHMASK) >> (x)) & 1)
__global__ void __launch_bounds__(512, 2) mega(Args a) {
    extern __shared__ __attribute__((aligned(16))) unsigned char smem[];
    LAS unsigned char* lds = (LAS unsigned char*)smem;
    const int G = gridDim.x;
    unsigned char* ws = a.ws;
    bf16_t* H = (bf16_t*)(ws + WS_H); bf16_t* ACT = (bf16_t*)(ws + WS_ACT); bf16_t* Y = (bf16_t*)(ws + WS_Y); bf16_t* MP = (bf16_t*)(ws + WS_MP); bf16_t* MG = (bf16_t*)(ws + WS_MG);
    const float* MOD = (const float*)(ws + WS_MOD);
#if MK_DIAG_ZERO
    for (int i = otid(); i < LDS_BYTES / 4; i += 512) ((LAS unsigned*)lds)[i] = 0u;
    __syncthreads();
#endif
    XcdBarrier bar; bar.bar = (unsigned*)(ws + WS_BAR); bar.x = 0; bar.st = (volatile LAS unsigned*)(lds + LDS_BYTES - 16);
    unsigned* const ctrs = (unsigned*)(ws + WS_BAR);
    if (a.ph_lo < 0) cg::this_grid().sync();
    if (otid() < 4) ((LAS unsigned*)(lds + LDS_BYTES - 16))[otid()] = 0u;
    __syncthreads();
    if (a.ph_hi - a.ph_lo > 1) bar = xcd_barrier_post((unsigned*)(ws + WS_BAR), (volatile LAS unsigned*)(lds + LDS_BYTES - 16));
    for (int ph = a.ph_lo; ph < a.ph_hi; ++ph) {
      for (int rep = 0; rep < (((MK_PROBE >> ph) & 1) ? 2 : 1); ++rep) {
        const int bid = obid();
        if (PHM(0) && ph == 0) { phase0(a, lds, G); }
        else if (PHM(1) && (ph == 1 || ph == 4 || ph == 9 || ph == 12 || ph == 15 || ph == 19 || ph == 22)) {
            RowP p; p.y = Y; p.ctxin = a.in[I_CTX]; p.xout = a.out; p.h = H;
            bf16_t* XB = (bf16_t*)(ws + WS_XB);
            p.modeR = (ph <= 4); p.xin = a.in[I_X]; p.xinb = (ph <= 4) ? nullptr : XB; p.xoutb = (ph == 22) ? nullptr : XB; p.has_y = (ph != 1); p.has_h = (ph != 22);
            const int lg = (ph <= 12) ? 0 : 1;
            const int lh = (ph <= 9) ? 0 : 1;
            const int sub = (ph == 4 || ph == 15) ? 0 : (ph == 9 || ph == 19) ? 1 : 2;
            const int nxt = (ph == 1 || ph == 12) ? 0 : (ph == 4 || ph == 15) ? 1 : 2;
            p.wgt = (sub == 1) ? 1.f : 0.5f;
            p.modg = MOD + (size_t)lg * 5 * MODW; p.gidx = 3 * sub + 2; p.gpost = a.in[I_NORMG] + (size_t)(lg * 6 + 2 * sub + 1) * DM;
            p.modh = MOD + (size_t)lh * 5 * MODW; p.sidx = 3 * nxt; p.gpre = a.in[I_NORMG] + (size_t)(lh * 6 + 2 * nxt) * DM;
            row_phase(p, G);
        }
        else if (PHM(2) && (ph == 2 || ph == 10 || ph == 13 || ph == 20)) {
            const int f = (ph == 2) ? 0 : (ph == 10) ? 1 : (ph == 13) ? 2 : 3; const int M = (ph == 2) ? MR : ML;
            pg8::Gemm g{H, (const bf16_t*)(ws + WS_WGU + (size_t)f * SZ_WGU), M, 2 * DFF, DM}; pg8::StaticOrder S; S.init(M, 2 * DFF, G, bid);
            pg8::EpiPair E{ACT, DFF, nullptr, 0, 0, 1};
            pg8::gemm_phase<pg8::EpiPair, pg8::StaticOrder, true, true>(lds, g, S, E);
            if (ph == 2) convert_steal(a, lds, ctrs + CTR_WORD(0), 2 * 2752, 2752, T_FFN, T_MI);
            else if (ph == 10) convert_steal(a, lds, ctrs + CTR_WORD(2), 9 * 2752, 2752, 0, 0);
            else if (ph == 13) convert_steal(a, lds, ctrs + CTR_WORD(3), 10 * 2752, 2752, 0, 0);
        }
        else if (PHM(2) && ph == 16) {
            pg8::Gemm g{H, (const bf16_t*)(ws + WS_WCI), ML, 3 * DM, DM}; pg8::StaticOrder S; S.init(ML, 3 * DM, G, bid);
            pg8::EpiPair E{MP + (size_t)ML * DM, DM, MP, DM, 8, 0};
            pg8::gemm_phase<pg8::EpiPair, pg8::StaticOrder, true, true>(lds, g, S, E);
        }
        else if (PHM(3) && (ph == 3 || ph == 11 || ph == 14 || ph == 21 || ph == 8 || ph == 18)) {
            const bool down = !(ph == 8 || ph == 18);
            const int f = (ph == 3) ? 0 : (ph == 11) ? 1 : (ph == 14) ? 2 : 3; const int M = (ph == 3) ? MR : ML;
            const bf16_t* A = down ? ACT : MG; const bf16_t* Bt = down ? (const bf16_t*)(ws + WS_WD + (size_t)f * SZ_WD) : (const bf16_t*)(ws + (ph == 8 ? WS_WMO : WS_WCO));
            pg8::Gemm g{A, Bt, M, DM, down ? DFF : DM}; pg8::StaticOrder S; S.init(M, DM, G, bid);
            pg8::EpiB16 E{Y, DM};
            pg8::gemm_phase<pg8::EpiB16, pg8::StaticOrder, true, true>(lds, g, S, E);
            if (ph == 3) { convert_steal(a, lds, ctrs + CTR_WORD(1), 3 * 2752, 3 * 2752, 8 * 2752, 2752);
                           gemv_steal(a, lds, ctrs + CTR_WORD(5), 64, 512); }
        }
        else if (PHM(4) && ph == 5) {
            pg8::Gemm g{H, (const bf16_t*)(ws + WS_WMI), MR, MIXIN, DM}; pg8::StaticOrder S; S.init(MR, MIXIN, G, bid);
            pg8::EpiMix E{MP, MIXIN, (const f32x2*)(ws + WS_ROPE)};
            pg8::gemm_phase<pg8::EpiMix, pg8::StaticOrder, true, true>(lds, g, S, E);
            convert_steal(a, lds, ctrs + CTR_WORD(6), T_FFN + T_MI + T_SQ, T_SQ + T_CI, 0, 0);
        }
        else if (ph == 6) {
            float* OATT = (float*)(ws + WS_OATT);
            if (G >= 128) { if (bid < 64 && PHM(5)) hgrn_unit(a, lds, bid); }
            else { for (int u = bid; u < 64; u += G) if (PHM(5)) hgrn_unit(a, lds, u); }
            volatile LAS int* bc = (volatile LAS int*)(lds + LDS_BYTES - 32);
            for (;;) {
                __syncthreads();
                if (otid() == 0) bc[0] = (int)__hip_atomic_fetch_add(ctrs + CTR_WORD(4), 1u, __ATOMIC_RELAXED, __HIP_MEMORY_SCOPE_AGENT);
                __syncthreads();
                const int u = bc[0];
                if (u >= 512) break;
                const int qb = u & 7, mp = (u >> 3) & 1, h = (u >> 4) & 7, b = u >> 7;
                const bf16_t* base = MP + (size_t)(b * RS) * MIXIN;
                if (PHM(6)) att::attn_body(base + (size_t)(CTX + qb * 256) * MIXIN + h * 128 + mp * 64, base + 1024 + h * 128 + mp * 64, base + 2048 + h * 128,
                               OATT + (size_t)mp * ML * 1024 + (size_t)(b * SEQ + qb * 256) * 1024 + h * 128, RS, (char*)smem);
            }
            convert_steal(a, lds, ctrs + CTR_WORD(7), T_FFN + T_MI, T_SQ, 0, 0);
            convert_steal(a, lds, ctrs + CTR_WORD(8), 6 * 2752, 2 * 2752, 11 * 2752, 2752);
        }
        else if (PHM(7) && ph == 7) { merge_phase(a, G); }
        else if (PHM(8) && ph == 17) { conv_phase(a, G); }
        if (ph + 1 < a.ph_hi) xcd_barrier(bar);
      }
    }

}

extern "C" void kernel_launch(void* const* d_in, const int* in_sizes, int n_in, void* d_out, int out_size, void* d_ws, size_t ws_size, hipStream_t stream) {
    static int grid = 0;
    if (grid == 0) {
        if (n_in != 19 || out_size != ML * DM || ws_size < WS_END) { fprintf(stderr, "kernel_launch: unexpected shapes: n_in %d out %d ws %zu (need %zu)\n", n_in, out_size, ws_size, (size_t)WS_END); grid = -1; return; }
        int dev = 0, cus = 0, per_cu = 0;
        hipGetDevice(&dev); hipDeviceGetAttribute(&cus, hipDeviceAttributeMultiprocessorCount, dev);
        if (hipFuncSetAttribute((const void*)mega, hipFuncAttributeMaxDynamicSharedMemorySize, LDS_BYTES) != hipSuccess) { fprintf(stderr, "kernel_launch: hipFuncSetAttribute failed\n"); grid = -1; return; }
        if (hipOccupancyMaxActiveBlocksPerMultiprocessor(&per_cu, (const void*)mega, 512, LDS_BYTES) != hipSuccess || per_cu < 1) { fprintf(stderr, "kernel_launch: occupancy query gave %d\n", per_cu); per_cu = 1; }
        (void)hipGetLastError();
        grid = cus * per_cu;
        fprintf(stderr, "kernel_launch: grid %d (cus %d x %d)\n", grid, cus, per_cu);
    }
    if (grid < 0) return;
#if MK_DIAG_ZERO
    (void)hipMemsetAsync(d_ws, 0, WS_END, stream);
    (void)hipMemsetAsync(d_out, 0, (size_t)ML * DM * 4, stream);
#endif
    (void)hipMemsetAsync((unsigned char*)d_ws + WS_BAR, 0, 16384, stream);
    Args a{};
    for (int i = 0; i < 19; ++i) a.in[i] = (const float*)d_in[i];
    a.out = (float*)d_out; a.ws = (unsigned char*)d_ws;
#if MK_MULTI
    for (int ph = 0; ph < NPHASE; ++ph) { a.ph_lo = ph; a.ph_hi = ph + 1; hipLaunchKernelGGL(mega, dim3(grid), dim3(512), LDS_BYTES, stream, a); }
#else
    a.ph_lo = 0; a.ph_hi = NPHASE;
    void* args[] = {&a};
    hipError_t e = hipLaunchCooperativeKernel((const void*)mega, dim3(grid), dim3(512), args, LDS_BYTES, stream);
    if (e != hipSuccess) fprintf(stderr, "kernel_launch: cooperative launch failed: %s (grid %d)\n", hipGetErrorString(e), grid);
#endif
}
```

```cpp
#include <hip/hip_runtime.h>
#include <hip/hip_cooperative_groups.h>
#include <cstdio>
#include <cstdint>
namespace cg = cooperative_groups;

#ifndef MK_MULTI
#define MK_MULTI 0
#endif

#ifndef MK_PROBE
#define MK_PROBE 0
#endif
#ifndef MK_DIAG_ZERO
#define MK_DIAG_ZERO 0
#endif
#define LAS __attribute__((address_space(3)))
typedef unsigned short bf16_t;
typedef short bf16x8 __attribute__((ext_vector_type(8)));
typedef short s16x4 __attribute__((ext_vector_type(4)));
typedef float f32x2 __attribute__((ext_vector_type(2)));
typedef float f32x4 __attribute__((ext_vector_type(4)));
typedef float f32x16 __attribute__((ext_vector_type(16)));
typedef unsigned u32x2 __attribute__((ext_vector_type(2)));
typedef unsigned u32x4 __attribute__((ext_vector_type(4)));

constexpr int DM = 2048, NB = 4, SEQ = 2048, CTX = 256, RS = SEQ + CTX, MR = NB * RS, ML = NB * SEQ, DFF = 5504, MODW = 9 * DM, MIXIN = 8192;
constexpr float EPS = 1e-6f;
constexpr int NPHASE = 23;
constexpr int LDS_BYTES = 147456;

struct Args { const float* in[19]; float* out; unsigned char* ws; int ph_lo, ph_hi; };
enum { I_X = 0, I_C, I_CTX, I_CCTX, I_ADAW, I_ADAB, I_NORMG, I_WG, I_WU, I_WDN, I_MIXIN, I_MIXOUT, I_DLAM, I_DNG, I_RNG, I_RLB, I_CWIN, I_CW, I_CWOUT };

constexpr size_t WS_MOD = 0;
constexpr size_t WS_ROPE = WS_MOD + (size_t)2 * 5 * MODW * 4;
constexpr size_t SZ_WGU = (size_t)2 * DFF * DM * 2, SZ_WD = (size_t)DM * DFF * 2;
constexpr size_t WS_BAR = WS_ROPE + 8192;
constexpr size_t WS_WGU = WS_BAR + 16384;
constexpr size_t WS_WD = WS_WGU + 4 * SZ_WGU;
constexpr size_t WS_WMI = WS_WD + 4 * SZ_WD;
constexpr size_t WS_WMO = WS_WMI + (size_t)MIXIN * DM * 2;
constexpr size_t WS_WCI = WS_WMO + (size_t)DM * DM * 2;
constexpr size_t WS_WCO = WS_WCI + (size_t)3 * DM * DM * 2;
constexpr size_t WS_H = WS_WCO + (size_t)DM * DM * 2;
constexpr size_t WS_ACT = WS_H + (size_t)MR * DM * 2;
constexpr size_t WS_Y = WS_ACT + (size_t)MR * DFF * 2;
constexpr size_t WS_MP = WS_Y + (size_t)MR * DM * 4;
constexpr size_t WS_OATT = WS_MP + (size_t)MR * MIXIN * 2;
constexpr size_t WS_OREC = WS_OATT + (size_t)2 * ML * 1024 * 4;
constexpr size_t WS_MG = WS_OREC + (size_t)2 * ML * 1024 * 4;
constexpr size_t WS_XB = WS_MG + (size_t)ML * DM * 2;
constexpr size_t WS_END = WS_XB + (size_t)ML * DM * 2;

typedef __bf16 bf16x2_t __attribute__((ext_vector_type(2)));
__device__ __forceinline__ unsigned cvtpk(float lo, float hi) { const f32x2 v = {lo, hi}; const bf16x2_t b = __builtin_convertvector(v, bf16x2_t); return __builtin_bit_cast(unsigned, b); }
__device__ __forceinline__ float bflo(unsigned w) { return __uint_as_float(w << 16); }
__device__ __forceinline__ float bfhi(unsigned w) { return __uint_as_float(w & 0xffff0000u); }
__device__ __forceinline__ float wave_sum(float v) {
#pragma unroll
    for (int o = 1; o < 64; o <<= 1) v += __shfl_xor(v, o);
    return v;
}
__device__ __forceinline__ int otid() { int t = threadIdx.x; asm volatile("" : "+v"(t)); return t; }
__device__ __forceinline__ int obid() { int t = blockIdx.x; asm volatile("" : "+s"(t)); return t; }
__device__ __forceinline__ float sigmoidf_(float x) { return __builtin_amdgcn_rcpf(1.f + __expf(-x)); }
__device__ __forceinline__ float siluf_(float x) { return x * sigmoidf_(x); }

namespace pg8 {
#define PG8_LAS __attribute__((address_space(3)))
typedef unsigned short bf16_t;
typedef short bf16x8 __attribute__((ext_vector_type(8)));
typedef float f32x4 __attribute__((ext_vector_type(4)));
typedef unsigned u32x4 __attribute__((ext_vector_type(4)));
constexpr int BM = 256, BK = 64, HALF = 128, HTB = HALF * BK * 2  , STAGE_BYTES = 8 * HTB, NXCD = 8, WGM = 8;

__host__ __device__ __forceinline__ int lds_byte(int r, int c) { const int st = (r >> 4) * 2 + (c >> 5), rr = r & 15, cc = c & 31, ob = rr * 64 + cc * 2; return st * 1024 + (ob ^ (((ob >> 9) & 1) << 5)); }
__host__ __device__ __forceinline__ void stage_rc(int b, int& R, int& C) { const int st = b / 1024, sb = b % 1024, swz = sb ^ (((sb >> 9) & 1) << 5); R = (st >> 1) * 16 + swz / 64; C = (st & 1) * 32 + (swz % 64) / 2; }
__host__ __device__ __forceinline__ int perm32(int rho) { const int n = rho >> 4, i = rho & 15; return 8 * (i >> 2) + 4 * n + (i & 3); }

struct Unit { int pm, pn; };
struct Gemm { const bf16_t* A; const bf16_t* Bt; int M, N, K; };

struct StaticOrder {
    int nM, nN, nwg, G, c;
    __host__ __device__ void init(int M, int N, int G_, int c_) { nM = M / BM; nN = N / BM; nwg = nM * nN; G = G_; c = c_; }
    __host__ __device__ bool next(int i, Unit& u) const {
        const long L = (long)i * G + c; if (L >= nwg) return false;
        int wgid = (int)L; { const int q = nwg / NXCD, r = nwg % NXCD, xcd = wgid % NXCD, off = wgid / NXCD; wgid = (xcd < r ? xcd * (q + 1) : r * (q + 1) + (xcd - r) * q) + off; }
        const int nig = WGM * nN, gid = wgid / nig, fm = gid * WGM, gsz = (nM - fm) < WGM ? (nM - fm) : WGM;
        u.pm = fm + ((wgid % nig) % gsz); u.pn = (wgid % nig) / gsz; return true;
    }
    __device__ __forceinline__ void a_ready(const Unit&) const {}
    __device__ __forceinline__ void done(const Unit&) const {}
};

struct FlexOrder {
    int nM, nN, nwg, G, c, mode, nrun; const unsigned* ready;
    __device__ void init(int M, int N, int G_, int c_, int mode_ = 0, const unsigned* ready_ = nullptr) { nM = M / BM; nN = N / BM; nwg = nM * nN; G = G_; c = c_; mode = mode_; ready = ready_; nrun = (mode_ == 1) ? nwg - 12 : nwg; }
    __device__ __forceinline__ void unit_at(int L, Unit& u) const {
        int wgid = L; { const int q = nwg / NXCD, r = nwg % NXCD, xcd = wgid % NXCD, off = wgid / NXCD; wgid = (xcd < r ? xcd * (q + 1) : r * (q + 1) + (xcd - r) * q) + off; }
        const int nig = WGM * nN, gid = wgid / nig, fm = gid * WGM, gsz = (nM - fm) < WGM ? (nM - fm) : WGM;
        u.pm = fm + ((wgid % nig) % gsz); u.pn = (wgid % nig) / gsz;
    }
    __device__ bool next(int i, Unit& u) const {
        if (mode == 2) { if (i == 0 && c < 12) { u.pm = 0; u.pn = 31 + c; return true; } return false; }
        const long L = (long)i * G + c;
        if (mode == 3) {
            if (L >= 288) return false;
            if (L < 256) { const int e = (c & 7) * 32 + (c >> 3); u.pm = 1 + (e >> 3); u.pn = e & 7; }
            else { const int cc = (int)L - 256; if (cc < 24) { const int e = 256 + cc; u.pm = 1 + (e >> 3); u.pn = e & 7; } else { u.pm = 0; u.pn = cc - 24; } }
            return true;
        }
        if (L >= nrun) return false;
        unit_at((int)L, u);
        if (mode == 1 && u.pm == 0 && u.pn >= 31) unit_at(nrun + (u.pn - 31), u);
        return true;
    }
    __device__ __forceinline__ void a_ready(const Unit& u) const {
        if (mode == 3 && u.pm == 0) {
            if (threadIdx.x < 64) {
                unsigned sp = 0;
                while ((unsigned)__builtin_amdgcn_readfirstlane(__hip_atomic_load(ready, __ATOMIC_RELAXED, __HIP_MEMORY_SCOPE_AGENT)) < 12u) { __builtin_amdgcn_s_sleep(2); if (++sp > (1u << 20)) break; }
                __builtin_amdgcn_fence(__ATOMIC_ACQUIRE, "agent");
                asm volatile("s_waitcnt vmcnt(0)" ::: "memory");
            }
            asm volatile("" ::: "memory"); __builtin_amdgcn_s_barrier(); asm volatile("" ::: "memory");
        }
    }
    __device__ __forceinline__ void done(const Unit&) const {}
};

__device__ __forceinline__ unsigned cvt_pk_bf16(float lo, float hi) { return ::cvtpk(lo, hi); }
typedef float f32x2 __attribute__((ext_vector_type(2)));

__device__ __forceinline__ void st8_bf16(bf16_t* p, const f32x4 v0, const f32x4 v1) {
    u32x4 w; w.x = cvt_pk_bf16(v0[0], v0[1]); w.y = cvt_pk_bf16(v0[2], v0[3]); w.z = cvt_pk_bf16(v1[0], v1[1]); w.w = cvt_pk_bf16(v1[2], v1[3]); *(u32x4*)p = w;
}
__device__ __forceinline__ float silu_e(float g) { return g * __builtin_amdgcn_rcpf(1.f + __expf(-g)); }
struct EpiPair {
    static constexpr bool PERM = true, AFTER_DRAIN = false;
    bf16_t* O1; int ld1; bf16_t* O0; int ld0; int nplain; int silu;
    __device__ __forceinline__ void operator()(const f32x4 (&acc)[2][2][4][2], const Unit& u, int wr, int wc, int fr, int fq) const {
        const int row0 = u.pm * BM + wr * 64 + fr;
        if (u.pn < nplain) {
            const int col0 = u.pn * BM + wc * 32 + 8 * fq;
#pragma unroll
            for (int ai = 0; ai < 2; ++ai)
#pragma unroll
                for (int m = 0; m < 4; ++m) { bf16_t* rowp = O0 + (size_t)(row0 + ai * HALF + m * 16) * ld0 + col0;
#pragma unroll
                    for (int bj = 0; bj < 2; ++bj) st8_bf16(rowp + bj * HALF, acc[ai][bj][m][0], acc[ai][bj][m][1]); }
        } else {
            const int col0 = (u.pn - nplain) * HALF + wc * 32 + 8 * fq;
#pragma unroll
            for (int ai = 0; ai < 2; ++ai)
#pragma unroll
                for (int m = 0; m < 4; ++m) { bf16_t* rowp = O1 + (size_t)(row0 + ai * HALF + m * 16) * ld1 + col0;
                    f32x4 g0 = acc[ai][0][m][0], g1 = acc[ai][0][m][1]; const f32x4 u0 = acc[ai][1][m][0], u1 = acc[ai][1][m][1];
                    if (silu) {
#pragma unroll
                        for (int e = 0; e < 4; ++e) { g0[e] = silu_e(g0[e]); g1[e] = silu_e(g1[e]); } }
                    st8_bf16(rowp, g0 * u0, g1 * u1); }
        }
    }
};
struct EpiB16 {
    static constexpr bool PERM = true, AFTER_DRAIN = false;
    bf16_t* O; int ld;
    __device__ __forceinline__ void operator()(const f32x4 (&acc)[2][2][4][2], const Unit& u, int wr, int wc, int fr, int fq) const {
        const int row0 = u.pm * BM + wr * 64 + fr, col0 = u.pn * BM + wc * 32 + 8 * fq;
#pragma unroll
        for (int ai = 0; ai < 2; ++ai)
#pragma unroll
            for (int m = 0; m < 4; ++m) { bf16_t* rowp = O + (size_t)(row0 + ai * HALF + m * 16) * ld + col0;
#pragma unroll
                for (int bj = 0; bj < 2; ++bj) st8_bf16(rowp + bj * HALF, acc[ai][bj][m][0], acc[ai][bj][m][1]); }
    }
};
struct EpiMix {
    static constexpr bool PERM = true, AFTER_DRAIN = false;
    bf16_t* O; int ld; const f32x2* rope;
    __device__ __forceinline__ void operator()(const f32x4 (&acc)[2][2][4][2], const Unit& u, int wr, int wc, int fr, int fq) const {
        const int row0 = u.pm * BM + wr * 64 + fr, col0 = u.pn * BM + wc * 32 + 8 * fq;
        const int pmod = u.pm % 9;
        if (u.pn >= 8 || pmod == 0) {
#pragma unroll
            for (int ai = 0; ai < 2; ++ai)
#pragma unroll
                for (int m = 0; m < 4; ++m) { bf16_t* rowp = O + (size_t)(row0 + ai * HALF + m * 16) * ld + col0;
#pragma unroll
                    for (int bj = 0; bj < 2; ++bj) st8_bf16(rowp + bj * HALF, acc[ai][bj][m][0], acc[ai][bj][m][1]); }
        } else {
            const int half = wc & 1, i0 = 8 * (fq & 1); const float sgn = fq < 2 ? -1.f : 1.f;
#pragma unroll
            for (int ai = 0; ai < 2; ++ai) {
                const int tb = (pmod - 1) * 256 + ai * HALF + wr * 64;
#pragma unroll
                for (int m = 0; m < 4; ++m) {
                    const int pos = half ? (m * 16 + fr) : (tb >> 6);
                    const f32x4* rp = (const f32x4*)(rope + pos * 16 + i0);
                    const f32x4 c01 = rp[0], c23 = rp[1], c45 = rp[2], c67 = rp[3];
                    const float cs[8] = {c01[0], c01[2], c23[0], c23[2], c45[0], c45[2], c67[0], c67[2]};
                    const float sn[8] = {c01[1], c01[3], c23[1], c23[3], c45[1], c45[3], c67[1], c67[3]};
                    bf16_t* rowp = O + (size_t)(row0 + ai * HALF + m * 16) * ld + col0;
#pragma unroll
                    for (int bj = 0; bj < 2; ++bj) {
                        f32x4 v0 = acc[ai][bj][m][0], v1 = acc[ai][bj][m][1], o0, o1;
#pragma unroll
                        for (int e = 0; e < 4; ++e) { const float p0 = __shfl_xor(v0[e], 32), p1 = __shfl_xor(v1[e], 32);
                            o0[e] = v0[e] * cs[e] + sgn * p0 * sn[e]; o1[e] = v1[e] * cs[4 + e] + sgn * p1 * sn[4 + e]; }
                        st8_bf16(rowp + bj * HALF, o0, o1);
                    }
                }
            }
        }
    }
};

template <class Epi, class Sched, bool ALIGN_EPI = false, bool SP2 = false>
__device__ __forceinline__ void gemm_phase(PG8_LAS unsigned char* lds, const Gemm g, const Sched& S, const Epi& E) {
    const int tid = otid(), wid = __builtin_amdgcn_readfirstlane(tid >> 6), lane = tid & 63, wr = wid >> 2, wc = wid & 3, fr = lane & 15, fq = lane >> 4;
    const int K = g.K, nt = K / BK;
    unsigned voffA[2], voffB[2];
#pragma unroll
    for (int i = 0; i < 2; ++i) { int R, C; stage_rc(tid * 16 + i * 8192, R, C); const int Rb = Epi::PERM ? ((R & ~31) + perm32(R & 31)) : R;
        voffA[i] = (unsigned)(R * K + C) * 2u; voffB[i] = (unsigned)(Rb * K + C) * 2u; }
    const size_t kstep = (size_t)(BK * 2);
    const size_t hstep = (size_t)HALF * K * 2;
    const size_t tstep = 2 * hstep;
    const unsigned ldsw = (unsigned)wid * 1024u;
    const int aoff = lds_byte(wr * 64 + fr, fq * 8), boff = lds_byte(wc * 32 + fr, fq * 8);
#define PG8_SA(b, h) (((b) * 2 + (h)) * HTB)
#define PG8_SB(b, h) ((4 + (b) * 2 + (h)) * HTB)
#define PG8_STAGE(bufoff, gbase, voff) do { _Pragma("unroll") for (int _i = 0; _i < 2; ++_i) \
        __builtin_amdgcn_global_load_lds((const unsigned*)((const char*)(gbase) + (voff)[_i]), (PG8_LAS unsigned*)(lds + (bufoff) + ldsw + _i * 8192), 16, 0, 0); } while (0)
#define PG8_LDA(dst, b, h) do { _Pragma("unroll") for (int m = 0; m < 4; ++m) _Pragma("unroll") for (int k = 0; k < 2; ++k) dst[m][k] = *(const PG8_LAS bf16x8*)(lds + PG8_SA(b, h) + aoff + m * 2048 + k * 1024); } while (0)
#define PG8_LDB(dst, b, h) do { _Pragma("unroll") for (int n = 0; n < 2; ++n) _Pragma("unroll") for (int k = 0; k < 2; ++k) dst[n][k] = *(const PG8_LAS bf16x8*)(lds + PG8_SB(b, h) + boff + n * 2048 + k * 1024); } while (0)
#define PG8_MMA(ai, bj, At, Bt) do { __builtin_amdgcn_s_setprio(1); _Pragma("unroll") for (int m = 0; m < 4; ++m) _Pragma("unroll") for (int n = 0; n < 2; ++n) _Pragma("unroll") for (int k = 0; k < 2; ++k) \
        acc[ai][bj][m][n] = __builtin_amdgcn_mfma_f32_16x16x32_bf16(Bt[n][k], At[m][k], acc[ai][bj][m][n], 0, 0, 0); __builtin_amdgcn_s_setprio(0); } while (0)
#define PG8_WAIT_V(n) asm volatile("s_waitcnt vmcnt(" #n ")" ::: "memory")
#define PG8_WAIT_L(n) asm volatile("s_waitcnt lgkmcnt(" #n ")" ::: "memory")
#define PG8_BAR __builtin_amdgcn_s_barrier()
#define PG8_SCHED __builtin_amdgcn_sched_barrier(0)
    Unit cur, nxt; int ui = 0;
    if (!S.next(0, cur)) return;
    f32x4 acc[2][2][4][2];
#pragma unroll
    for (int a = 0; a < 2; ++a)
#pragma unroll
        for (int b = 0; b < 2; ++b)
#pragma unroll
            for (int m = 0; m < 4; ++m)
#pragma unroll
                for (int n = 0; n < 2; ++n) acc[a][b][m][n] = (f32x4){0.f, 0.f, 0.f, 0.f};
    bf16x8 At[4][2], B0[2][2], B1[2][2];
    const char* cA = (const char*)g.A + (size_t)cur.pm * tstep; const char* cB = (const char*)g.Bt + (size_t)cur.pn * tstep;
    S.a_ready(cur);
    if constexpr (SP2) {
        PG8_STAGE(PG8_SB(0, 0), cB, voffB); PG8_STAGE(PG8_SB(0, 1), cB + hstep, voffB); PG8_STAGE(PG8_SA(0, 0), cA, voffA); PG8_STAGE(PG8_SA(0, 1), cA + hstep, voffA);
        if (wr == 1) PG8_BAR;
        PG8_WAIT_V(2); PG8_BAR;
        PG8_STAGE(PG8_SB(1, 0), cB + kstep, voffB); PG8_STAGE(PG8_SA(1, 0), cA + kstep, voffA); PG8_STAGE(PG8_SB(1, 1), cB + hstep + kstep, voffB);
        PG8_WAIT_V(6); PG8_BAR;
    } else {
        PG8_STAGE(PG8_SB(0, 0), cB, voffB); PG8_STAGE(PG8_SA(0, 0), cA, voffA); PG8_STAGE(PG8_SB(0, 1), cB + hstep, voffB); PG8_STAGE(PG8_SA(0, 1), cA + hstep, voffA);
        if (wr == 1) PG8_BAR;
        PG8_WAIT_V(4); PG8_BAR;
        PG8_STAGE(PG8_SB(1, 0), cB + kstep, voffB); PG8_STAGE(PG8_SA(1, 0), cA + kstep, voffA); PG8_STAGE(PG8_SB(1, 1), cB + hstep + kstep, voffB);
        PG8_WAIT_V(6); PG8_BAR;
    }
    for (;;) {
        const bool has_next = S.next(ui + 1, nxt);
        const char* nA = has_next ? (const char*)g.A + (size_t)nxt.pm * tstep : cA; const char* nB = has_next ? (const char*)g.Bt + (size_t)nxt.pn * tstep : cB;
        for (int t = 0; t < nt; t += 2) {
            const bool last = (t == nt - 2);
            const char* a1 = cA + (size_t)(t + 1) * kstep;
            const char* a2 = last ? nA : cA + (size_t)(t + 2) * kstep; const char* b2 = last ? nB : cB + (size_t)(t + 2) * kstep;
            const char* a3 = a2 + kstep; const char* b3 = b2 + kstep;
            if (last && has_next) S.a_ready(nxt);
            if constexpr (SP2) {
            PG8_LDB(B0, 0, 0); PG8_LDB(B1, 0, 1); PG8_SCHED; PG8_LDA(At, 0, 0); PG8_STAGE(PG8_SA(1, 1), a1 + hstep, voffA);
            PG8_WAIT_V(8); PG8_WAIT_L(0); PG8_BAR; PG8_MMA(0, 0, At, B0); PG8_MMA(0, 1, At, B1); PG8_BAR; PG8_SCHED;
            PG8_LDA(At, 0, 1); PG8_STAGE(PG8_SB(0, 0), b2, voffB); PG8_STAGE(PG8_SB(0, 1), b2 + hstep, voffB); PG8_STAGE(PG8_SA(0, 0), a2, voffA);
            PG8_WAIT_V(8); PG8_WAIT_L(0); PG8_BAR; PG8_MMA(1, 0, At, B0); PG8_MMA(1, 1, At, B1); PG8_BAR; PG8_SCHED;
            PG8_LDB(B0, 1, 0); PG8_LDB(B1, 1, 1); PG8_SCHED; PG8_LDA(At, 1, 0); PG8_STAGE(PG8_SA(0, 1), a2 + hstep, voffA);
            PG8_WAIT_V(8); PG8_WAIT_L(0); PG8_BAR; PG8_MMA(0, 0, At, B0); PG8_MMA(0, 1, At, B1); PG8_BAR; PG8_SCHED;
            PG8_LDA(At, 1, 1); PG8_STAGE(PG8_SB(1, 0), b3, voffB); PG8_STAGE(PG8_SB(1, 1), b3 + hstep, voffB); PG8_STAGE(PG8_SA(1, 0), a3, voffA);
            PG8_WAIT_V(8); PG8_WAIT_L(0); PG8_BAR; PG8_MMA(1, 0, At, B0); PG8_MMA(1, 1, At, B1); PG8_BAR; PG8_SCHED;
            } else {
            PG8_LDB(B0, 0, 0); PG8_SCHED; PG8_LDA(At, 0, 0); PG8_STAGE(PG8_SA(1, 1), a1 + hstep, voffA);
            PG8_WAIT_L(8); PG8_BAR; PG8_WAIT_L(0); PG8_MMA(0, 0, At, B0); PG8_BAR; PG8_SCHED;
            PG8_LDB(B1, 0, 1); PG8_STAGE(PG8_SB(0, 0), b2, voffB);
            PG8_BAR; PG8_WAIT_L(0); PG8_MMA(0, 1, At, B1); PG8_BAR;
            PG8_LDA(At, 0, 1); PG8_STAGE(PG8_SA(0, 0), a2, voffA);
            PG8_BAR; PG8_WAIT_L(0); PG8_MMA(1, 0, At, B0); PG8_BAR; PG8_SCHED;
            PG8_STAGE(PG8_SB(0, 1), b2 + hstep, voffB);
            PG8_WAIT_V(6); PG8_BAR; PG8_MMA(1, 1, At, B1); PG8_BAR;
            PG8_LDB(B0, 1, 0); PG8_SCHED; PG8_LDA(At, 1, 0); PG8_STAGE(PG8_SA(0, 1), a2 + hstep, voffA);
            PG8_WAIT_L(8); PG8_BAR; PG8_WAIT_L(0); PG8_MMA(0, 0, At, B0); PG8_BAR; PG8_SCHED;
            PG8_LDB(B1, 1, 1); PG8_STAGE(PG8_SB(1, 0), b3, voffB);
            PG8_BAR; PG8_WAIT_L(0); PG8_MMA(0, 1, At, B1); PG8_BAR;
            PG8_LDA(At, 1, 1); PG8_STAGE(PG8_SA(1, 0), a3, voffA);
            PG8_BAR; PG8_WAIT_L(0); PG8_MMA(1, 0, At, B0); PG8_BAR; PG8_SCHED;
            PG8_STAGE(PG8_SB(1, 1), b3 + hstep, voffB);
            PG8_WAIT_V(6); PG8_BAR; PG8_MMA(1, 1, At, B1); PG8_BAR;
            }
        }
        if constexpr (ALIGN_EPI) { if (wr == 0) PG8_BAR; }
        if constexpr (!Epi::AFTER_DRAIN) { E(acc, cur, wr, wc, fr, fq); S.done(cur); }
        if (!has_next) break;
#pragma unroll
        for (int a = 0; a < 2; ++a)
#pragma unroll
            for (int b = 0; b < 2; ++b)
#pragma unroll
                for (int m = 0; m < 4; ++m)
#pragma unroll
                    for (int n = 0; n < 2; ++n) acc[a][b][m][n] = (f32x4){0.f, 0.f, 0.f, 0.f};
        cur = nxt; cA = nA; cB = nB; ++ui;
        if constexpr (ALIGN_EPI) { if (wr == 1) PG8_BAR; }
    }
    PG8_WAIT_V(0);
    if constexpr (!ALIGN_EPI) { if (wr == 0) PG8_BAR; }
    PG8_BAR;
    if constexpr (Epi::AFTER_DRAIN) { E.fused(acc, cur, wr, wc, fr, fq, lds, wid, lane); S.done(cur); }
#undef PG8_SA
#undef PG8_SB
#undef PG8_STAGE
#undef PG8_LDA
#undef PG8_LDB
#undef PG8_MMA
#undef PG8_WAIT_V
#undef PG8_WAIT_L
#undef PG8_BAR
#undef PG8_SCHED
}
}

namespace att {
constexpr int NW = 8, QBLK = 32, KVBLK = 64, DV = 128, DQ = 64;
constexpr float SCALE = 0.125f, THR = 8.f;
constexpr int LDQ = MIXIN, LDK = MIXIN, LDO = 1024;
constexpr int SHM_V = KVBLK * DV * 2, SHM_K = KVBLK * DQ * 2, SHM_ATTN = 2 * SHM_V + 2 * SHM_K + NW * 64 * 4;
#define KSWZ(row, colB) ((row) * 128 + ((colB) ^ (((row) & 7) << 4)))
#define SBAR() __builtin_amdgcn_sched_barrier(0)
__device__ __forceinline__ int crow(int r, int hi) { return (r & 3) + 8 * (r >> 2) + 4 * hi; }
__device__ __forceinline__ unsigned cvtpkv(float lo, float hi) { unsigned r; asm volatile("v_cvt_pk_bf16_f32 %0, %1, %2" : "=v"(r) : "v"(lo), "v"(hi)); return r; }
__device__ __forceinline__ void partialSM(f32x16& p0, f32x16& p1, float& m_reg, float& mn, float& alpha) {
  constexpr float C = SCALE * 1.4426950408889634f;
  float pmax = p0[0]; for (int r = 1; r < 16; ++r) pmax = fmaxf(pmax, p0[r]); for (int r = 0; r < 16; ++r) pmax = fmaxf(pmax, p1[r]);
  { auto rr = __builtin_amdgcn_permlane32_swap(__float_as_uint(pmax), __float_as_uint(pmax), false, false);
    pmax = fmaxf(__uint_as_float(rr[0]), __uint_as_float(rr[1])); }
  if (__builtin_expect(__all(pmax - m_reg <= THR / SCALE), 1)) { mn = m_reg; alpha = 1.f; }
  else { mn = fmaxf(m_reg, pmax); alpha = __builtin_amdgcn_exp2f((m_reg - mn) * C); m_reg = mn; }
  float mnC = -mn * C;
  for (int r = 0; r < 16; ++r) p0[r] = fmaf(p0[r], C, mnC); for (int r = 0; r < 16; ++r) p1[r] = fmaf(p1[r], C, mnC);
  for (int r = 0; r < 16; ++r) p0[r] = __builtin_amdgcn_exp2f(p0[r]);
}
__device__ __forceinline__ void finishSM(f32x16& p0, f32x16& p1, float alpha, float& l_reg, bf16x8& pa0, bf16x8& pa1, bf16x8& pa2, bf16x8& pa3) {
  for (int r = 0; r < 16; ++r) p1[r] = __builtin_amdgcn_exp2f(p1[r]);
  float ps = 0; for (int r = 0; r < 16; ++r) ps += p0[r]; for (int r = 0; r < 16; ++r) ps += p1[r];
  { auto rr = __builtin_amdgcn_permlane32_swap(__float_as_uint(ps), __float_as_uint(ps), false, false);
    ps = __uint_as_float(rr[0]) + __uint_as_float(rr[1]); }
  l_reg = l_reg * alpha + ps;
#define PK4(P, BASE, OUT) do { unsigned a0 = cvtpkv(P[BASE + 0], P[BASE + 1]), a1 = cvtpkv(P[BASE + 2], P[BASE + 3]);   \
    unsigned b0 = cvtpkv(P[BASE + 4], P[BASE + 5]), b1 = cvtpkv(P[BASE + 6], P[BASE + 7]);                              \
    auto r0 = __builtin_amdgcn_permlane32_swap(a0, b0, false, false); auto r1 = __builtin_amdgcn_permlane32_swap(a1, b1, false, false); \
    u32x4 w = {r0[0], r1[0], r0[1], r1[1]}; OUT = *reinterpret_cast<bf16x8*>(&w); } while (0)
  PK4(p0, 0, pa0); PK4(p0, 8, pa1); PK4(p1, 0, pa2); PK4(p1, 8, pa3);
#undef PK4
}
__device__ __forceinline__ void qkt(f32x16& p0, f32x16& p1, const bf16_t* Ks, const bf16x8* qr, int r32, int hi) {
  p0 = f32x16{}; p1 = f32x16{};
#pragma unroll
  for (int d0 = 0; d0 < 4; ++d0) { int cb = (d0 * 16 + hi * 8) * 2;
    bf16x8 b0 = *reinterpret_cast<const bf16x8*>((const char*)Ks + KSWZ(r32, cb));
    bf16x8 b1 = *reinterpret_cast<const bf16x8*>((const char*)Ks + KSWZ(32 + r32, cb));
    p0 = __builtin_amdgcn_mfma_f32_32x32x16_bf16(b0, qr[d0], p0, 0, 0, 0);
    p1 = __builtin_amdgcn_mfma_f32_32x32x16_bf16(b1, qr[d0], p1, 0, 0, 0); }
}
__device__ __forceinline__ int v_st(int k, int c) { const int kk = (k & ~0xC) | ((k & 4) << 1) | ((k & 8) >> 1); return ((kk >> 3) * 4 + (c >> 5)) * 512 + ((kk & 7) * 32 + (c & 31)) * 2; }
__device__ __forceinline__ int v_rd_base(int lane) { return ((lane & 3) << 3) | (((lane >> 2) & 3) << 6) | (((lane >> 4) & 1) << 5) | (((lane >> 5) & 1) << 8); }
constexpr int v_rd_off(int d0, int ks, int half) { return d0 * 512 + ks * 4096 + half * 2048; }
template <int OFF> __device__ __forceinline__ s16x4 tr_read(int vb) {
  s16x4 r; asm volatile("ds_read_b64_tr_b16 %0, %1 offset:%2" : "=&v"(r) : "v"(vb), "i"(OFF) : "memory"); return r;
}
template <int D0> __device__ __forceinline__ void pv_one(f32x16& od, int vb, bf16x8 pa0, bf16x8 pa1, bf16x8 pa2, bf16x8 pa3) {
  const s16x4 l0 = tr_read<v_rd_off(D0, 0, 0)>(vb), h0 = tr_read<v_rd_off(D0, 0, 1)>(vb), l1 = tr_read<v_rd_off(D0, 1, 0)>(vb), h1 = tr_read<v_rd_off(D0, 1, 1)>(vb);
  const s16x4 l2 = tr_read<v_rd_off(D0, 2, 0)>(vb), h2 = tr_read<v_rd_off(D0, 2, 1)>(vb), l3 = tr_read<v_rd_off(D0, 3, 0)>(vb), h3 = tr_read<v_rd_off(D0, 3, 1)>(vb);
  asm volatile("s_waitcnt lgkmcnt(0)" ::: "memory"); SBAR();
#define PK(L, H) (bf16x8){L[0], L[1], L[2], L[3], H[0], H[1], H[2], H[3]}
  od = __builtin_amdgcn_mfma_f32_32x32x16_bf16(pa0, PK(l0, h0), od, 0, 0, 0);
  od = __builtin_amdgcn_mfma_f32_32x32x16_bf16(pa1, PK(l1, h1), od, 0, 0, 0);
  od = __builtin_amdgcn_mfma_f32_32x32x16_bf16(pa2, PK(l2, h2), od, 0, 0, 0);
  od = __builtin_amdgcn_mfma_f32_32x32x16_bf16(pa3, PK(l3, h3), od, 0, 0, 0);
#undef PK
}
__device__ __forceinline__ void pv_d0(f32x16* o, int vb, bf16x8 pa0, bf16x8 pa1, bf16x8 pa2, bf16x8 pa3) {
  pv_one<0>(o[0], vb, pa0, pa1, pa2, pa3); pv_one<1>(o[1], vb, pa0, pa1, pa2, pa3); pv_one<2>(o[2], vb, pa0, pa1, pa2, pa3); pv_one<3>(o[3], vb, pa0, pa1, pa2, pa3);
}
__device__ __forceinline__ void attn_body(const bf16_t* __restrict__ Qb, const bf16_t* __restrict__ Kh, const bf16_t* __restrict__ Vh, float* __restrict__ Ob, int seq, char* lds) {
  const int tid = otid(), wid = tid >> 6, lane = tid & 63, r32 = lane & 31, hi = lane >> 5;
  bf16_t* V_lds = (bf16_t*)lds; bf16_t* K_lds = (bf16_t*)(lds + 2 * SHM_V);
  float* ws = (float*)(lds + 2 * SHM_V + 2 * SHM_K) + wid * 64; float* li_l = ws; float* al_l = ws + 32;
  float m_reg = -1e30f, l_reg = 0; f32x16 o[4] = {}; bf16x8 qr[4];
  const bf16_t* Qw = Qb + (long)(wid * QBLK + r32) * LDQ + hi * 8;
#pragma unroll
  for (int d0 = 0; d0 < 4; ++d0) qr[d0] = *reinterpret_cast<const bf16x8*>(Qw + d0 * 16);
  const int sr = tid >> 4, sc = (tid & 15) * 8, vst0 = v_st(sr, sc), vst1 = v_st(32 + sr, sc);
  const int kr = tid >> 3, kc = (tid & 7) * 8, kst = KSWZ(kr, kc * 2);
  const int vb0 = (int)(uintptr_t)V_lds + v_rd_base(lane);
  struct { bf16x8 vs0, vs1, ks0; } sr_[2];
#define SLOAD(i, k0) do { sr_[i].vs0 = *reinterpret_cast<const bf16x8*>(&Vh[(long)((k0) + sr) * LDK + sc]); sr_[i].vs1 = *reinterpret_cast<const bf16x8*>(&Vh[(long)((k0) + 32 + sr) * LDK + sc]); \
    sr_[i].ks0 = *reinterpret_cast<const bf16x8*>(&Kh[(long)((k0) + kr) * LDK + kc]); } while (0)
#define SWRITE(b, i) do { *(bf16x8*)((char*)V_lds + (b) * SHM_V + vst0) = sr_[i].vs0;          \
    *(bf16x8*)((char*)V_lds + (b) * SHM_V + vst1) = sr_[i].vs1;                                  \
    *(bf16x8*)((char*)K_lds + (b) * SHM_K + kst) = sr_[i].ks0; } while (0)
#define SWAIT() asm volatile("s_waitcnt vmcnt(3)" ::: "memory")
#define RESC(a) do { if (__any((a) < 1.f)) { if (hi == 0) al_l[r32] = (a); asm volatile("s_waitcnt lgkmcnt(0)" ::: "memory"); \
    for (int d = 0; d < 4; ++d) for (int r = 0; r < 16; ++r) o[d][r] *= al_l[crow(r, hi)]; } } while (0)
  f32x16 pA0, pA1, pB0, pB1; float mnA, mnB, alA, alB; bf16x8 pa0, pa1, pa2, pa3; const int NT = seq / KVBLK;
  constexpr int SE = 0, SO = 1;
  SLOAD(SE, 0); asm volatile("s_waitcnt vmcnt(0)" ::: "memory"); SWRITE(0, SE); __syncthreads();
  qkt(pA0, pA1, K_lds, qr, r32, hi); partialSM(pA0, pA1, m_reg, mnA, alA);
  SLOAD(SO, KVBLK); if (2 < NT) SLOAD(SE, 2 * KVBLK);
  SWAIT(); SWRITE(1, SO); __syncthreads();
  for (int j = 1; j + 1 < NT; j += 2) {
    SBAR(); qkt(pB0, pB1, (bf16_t*)((char*)K_lds + SHM_K), qr, r32, hi);
    finishSM(pA0, pA1, alA, l_reg, pa0, pa1, pa2, pa3); SBAR();
    SLOAD(SO, (j + 2) * KVBLK); SBAR();
    pv_d0(o, vb0, pa0, pa1, pa2, pa3); partialSM(pB0, pB1, m_reg, mnB, alB);
    __syncthreads(); SWAIT(); SWRITE(0, SE);
    RESC(alB); __syncthreads();
    SBAR(); qkt(pA0, pA1, K_lds, qr, r32, hi);
    finishSM(pB0, pB1, alB, l_reg, pa0, pa1, pa2, pa3); SBAR();
    if (j + 3 < NT) SLOAD(SE, (j + 3) * KVBLK); SBAR();
    pv_d0(o, vb0 + (int)SHM_V, pa0, pa1, pa2, pa3); partialSM(pA0, pA1, m_reg, mnA, alA);
    __syncthreads(); SWAIT(); SWRITE(1, SO);
    RESC(alA); __syncthreads();
  }
  SBAR(); qkt(pB0, pB1, (bf16_t*)((char*)K_lds + SHM_K), qr, r32, hi);
  finishSM(pA0, pA1, alA, l_reg, pa0, pa1, pa2, pa3); SBAR();
  pv_d0(o, vb0, pa0, pa1, pa2, pa3); partialSM(pB0, pB1, m_reg, mnB, alB);
  __syncthreads(); RESC(alB);
  finishSM(pB0, pB1, alB, l_reg, pa0, pa1, pa2, pa3); SBAR();
  pv_d0(o, vb0 + (int)SHM_V, pa0, pa1, pa2, pa3);
  if (hi == 0) li_l[r32] = l_reg; asm volatile("s_waitcnt lgkmcnt(0)" ::: "memory");
  float rli[16];
#pragma unroll
  for (int r = 0; r < 16; ++r) rli[r] = __builtin_amdgcn_rcpf(li_l[crow(r, hi)]);
  float* Ow = Ob + (long)(wid * QBLK) * LDO;
#pragma unroll
  for (int r = 0; r < 16; ++r) { int orow = crow(r, hi);
    for (int d0 = 0; d0 < 4; ++d0) Ow[(long)orow * LDO + d0 * 32 + r32] = o[d0][r] * rli[r]; }
#undef SLOAD
#undef SWRITE
#undef SWAIT
#undef RESC
}
}

__device__ __forceinline__ int hcrow(int r, int hi) { return (r & 3) + 8 * (r >> 2) + 4 * hi; }
__device__ __forceinline__ void hgrn_unit(const Args& a, LAS unsigned char* lds, int unit) {
    const int tid = otid(), w = __builtin_amdgcn_readfirstlane(tid >> 6), lane = tid & 63, r32 = lane & 31, hi = lane >> 5;
    const int dir = unit & 1, h = (unit >> 1) & 7, b = unit >> 4;
    constexpr int PQ = 136, PS = 72;
    LAS bf16_t* Qt = (LAS bf16_t*)lds;
    LAS bf16_t* Kt = Qt + 64 * PQ;
    LAS bf16_t* KhT = Kt + 64 * PQ;
    LAS bf16_t* Vt = KhT + 128 * PS;
    LAS bf16_t* At = Vt + 128 * PS;
    LAS bf16_t* St = At + 64 * PS;
    LAS float* part = (LAS float*)(St + 128 * PQ);
    LAS float* dec = part + 8 * 128;
    const bf16_t* MP = (const bf16_t*)(a.ws + WS_MP);
    float* OREC = (float*)(a.ws + WS_OREC) + (size_t)dir * ML * 1024;
    const int kp = lane;
    float lb[2];
#pragma unroll
    for (int j = 0; j < 2; ++j) { const float a0 = a.in[I_RLB][(dir * 2 + 0) * 1024 + h * 128 + 2 * kp + j], a1 = a.in[I_RLB][(dir * 2 + 1) * 1024 + h * 128 + 2 * kp + j];
        lb[j] = 1.f / (1.f + __expf(a1 - a0)); }
    __syncthreads();
    for (int i = tid; i < 128 * PQ / 2; i += 512) ((LAS unsigned*)St)[i] = 0u;
    f32x16 S[2] = {};
    unsigned q2[8], z2[8], v2[8];
    const int zcol = (dir ? 5120 : 4096) + h * 128 + 2 * kp, qcol = 3072 + h * 128 + 2 * kp, vcol = 6144 + h * 128 + 2 * kp;
#define HG_ROWBASE(c) (b * RS + (dir ? ((c) < 4 ? 192 - 64 * (c) : RS - 64 * ((c) - 3)) : 64 * (c)))
#define HG_LOAD(c) do { const int rb_ = HG_ROWBASE(c); _Pragma("unroll") for (int e = 0; e < 8; ++e) { const int tau = 8 * w + e, rr = dir ? 63 - tau : tau; \
        const bf16_t* rp = MP + (size_t)(rb_ + rr) * MIXIN; q2[e] = *(const unsigned*)(rp + qcol); z2[e] = *(const unsigned*)(rp + zcol); v2[e] = *(const unsigned*)(rp + vcol); } } while (0)
    HG_LOAD(0);
    const int ti = w >> 2, vi = w & 3, ki = w >> 1, vi0 = 2 * (w & 1);
    for (int c = 0; c < 36; ++c) {
        const int rowbase = HG_ROWBASE(c);
        float Pl[8][2], fk[8][2]; float p0 = 1.f, p1 = 1.f;
#pragma unroll
        for (int e = 0; e < 8; ++e) {
            const float f0 = lb[0] + (1.f - lb[0]) * sigmoidf_(bflo(z2[e])), f1 = lb[1] + (1.f - lb[1]) * sigmoidf_(bfhi(z2[e]));
            p0 *= f0; p1 *= f1; Pl[e][0] = p0; Pl[e][1] = p1; fk[e][0] = 1.f - f0; fk[e][1] = 1.f - f1;
        }
        *(LAS f32x2*)(part + w * 128 + 2 * kp) = (f32x2){p0, p1};
        __syncthreads();
        float off0 = 1.f, off1 = 1.f, tot0 = 1.f, tot1 = 1.f;
#pragma unroll
        for (int x = 0; x < 8; ++x) { const f32x2 pp = *(LAS f32x2*)(part + x * 128 + 2 * kp); tot0 *= pp[0]; tot1 *= pp[1]; if (x < w) { off0 *= pp[0]; off1 *= pp[1]; } }
        unsigned kh0[4], kh1[4], vt0[4], vt1[4];
        float kha[8][2];
#pragma unroll
        for (int e = 0; e < 8; ++e) {
            const int tau = 8 * w + e;
            const float P0 = fmaxf(off0 * Pl[e][0], 1e-35f), P1 = fmaxf(off1 * Pl[e][1], 1e-35f);
            const float i0 = __builtin_amdgcn_rcpf(P0), i1 = __builtin_amdgcn_rcpf(P1);
            const float qs0 = bflo(q2[e]) * 0.08838834764831845f * P0, qs1 = bfhi(q2[e]) * 0.08838834764831845f * P1;
            const float kt0 = fk[e][0] * i0, kt1 = fk[e][1] * i1;
            kha[e][0] = kt0 * tot0; kha[e][1] = kt1 * tot1;
            *(LAS unsigned*)(Qt + tau * PQ + 2 * kp) = cvtpk(qs0, qs1);
            *(LAS unsigned*)(Kt + tau * PQ + 2 * kp) = cvtpk(kt0, kt1);
        }
#pragma unroll
        for (int e = 0; e < 4; ++e) { kh0[e] = cvtpk(kha[2 * e][0], kha[2 * e + 1][0]); kh1[e] = cvtpk(kha[2 * e][1], kha[2 * e + 1][1]);
            vt0[e] = (v2[2 * e] & 0xffffu) | (v2[2 * e + 1] << 16); vt1[e] = (v2[2 * e] >> 16) | (v2[2 * e + 1] & 0xffff0000u); }
        *(LAS u32x4*)(KhT + (2 * kp) * PS + 8 * w) = (u32x4){kh0[0], kh0[1], kh0[2], kh0[3]};
        *(LAS u32x4*)(KhT + (2 * kp + 1) * PS + 8 * w) = (u32x4){kh1[0], kh1[1], kh1[2], kh1[3]};
        *(LAS u32x4*)(Vt + (2 * kp) * PS + 8 * w) = (u32x4){vt0[0], vt0[1], vt0[2], vt0[3]};
        *(LAS u32x4*)(Vt + (2 * kp + 1) * PS + 8 * w) = (u32x4){vt1[0], vt1[1], vt1[2], vt1[3]};
        if (w == 0) *(LAS f32x2*)(dec + 2 * kp) = (f32x2){tot0, tot1};
        if (c + 1 < 36) HG_LOAD(c + 1);
        __syncthreads();
        const bool outc = c >= 4;
        f32x16 o = {};
        if (outc) {
#pragma unroll
            for (int j = 0; j < 8; ++j) { const bf16x8 A = *(const LAS bf16x8*)(Qt + (32 * ti + r32) * PQ + 16 * j + 8 * hi), B = *(const LAS bf16x8*)(St + (32 * vi + r32) * PQ + 16 * j + 8 * hi);
                o = __builtin_amdgcn_mfma_f32_32x32x16_bf16(A, B, o, 0, 0, 0); }
            if (w < 4) {
                const int ta = w >> 1, sa = w & 1;
                f32x16 acc = {};
                if (sa <= ta) {
#pragma unroll
                    for (int j = 0; j < 8; ++j) { const bf16x8 A = *(const LAS bf16x8*)(Qt + (32 * ta + r32) * PQ + 16 * j + 8 * hi), B = *(const LAS bf16x8*)(Kt + (32 * sa + r32) * PQ + 16 * j + 8 * hi);
                        acc = __builtin_amdgcn_mfma_f32_32x32x16_bf16(A, B, acc, 0, 0, 0); }
                }
#pragma unroll
                for (int i = 0; i < 16; ++i) { const int t = 32 * ta + hcrow(i, hi), s = 32 * sa + r32; const float v = (s <= t) ? acc[i] : 0.f;
                    At[t * PS + s] = (bf16_t)(cvtpk(v, 0.f) & 0xffffu); }
            }
        }
#pragma unroll
        for (int x = 0; x < 2; ++x) {
#pragma unroll
            for (int i = 0; i < 16; ++i) S[x][i] *= dec[32 * ki + hcrow(i, hi)];
#pragma unroll
            for (int j = 0; j < 4; ++j) { const bf16x8 A = *(const LAS bf16x8*)(KhT + (32 * ki + r32) * PS + 16 * j + 8 * hi), B = *(const LAS bf16x8*)(Vt + (32 * (vi0 + x) + r32) * PS + 16 * j + 8 * hi);
                S[x] = __builtin_amdgcn_mfma_f32_32x32x16_bf16(A, B, S[x], 0, 0, 0); }
        }
        __syncthreads();
        if (outc) {
#pragma unroll
            for (int j = 0; j < 4; ++j) { const bf16x8 A = *(const LAS bf16x8*)(At + (32 * ti + r32) * PS + 16 * j + 8 * hi), B = *(const LAS bf16x8*)(Vt + (32 * vi + r32) * PS + 16 * j + 8 * hi);
                o = __builtin_amdgcn_mfma_f32_32x32x16_bf16(A, B, o, 0, 0, 0); }
#pragma unroll
            for (int i = 0; i < 16; ++i) { const int tau = 32 * ti + hcrow(i, hi), rr = dir ? 63 - tau : tau; const int lrow = rowbase + rr - 256 * (b + 1);
                OREC[(size_t)lrow * 1024 + h * 128 + 32 * vi + r32] = o[i]; }
        }
#pragma unroll
        for (int x = 0; x < 2; ++x)
#pragma unroll
            for (int g = 0; g < 4; ++g) { const int k0 = 32 * ki + 8 * g + 4 * hi;
                *(LAS u32x2*)(St + (32 * (vi0 + x) + r32) * PQ + k0) = (u32x2){cvtpk(S[x][4 * g], S[x][4 * g + 1]), cvtpk(S[x][4 * g + 2], S[x][4 * g + 3])}; }
    }
    __syncthreads();
#undef HG_LOAD
#undef HG_ROWBASE
}

__device__ __forceinline__ void transpose_item(const float* __restrict__ src, int ldn, int k0, int n0, bf16_t* __restrict__ dst, int Kd, int drow, LAS float* scr, int lane) {
    const int cl = (lane & 15) * 4, ks = lane >> 4;
    f32x4 v[16];
#pragma unroll
    for (int i = 0; i < 16; ++i) v[i] = __builtin_nontemporal_load((const f32x4*)(src + (size_t)(k0 + 4 * i + ks) * ldn + n0 + cl));
#pragma unroll
    for (int i = 0; i < 16; ++i) { LAS float* s = scr + (4 * i + ks) * 65 + cl; s[0] = v[i][0]; s[1] = v[i][1]; s[2] = v[i][2]; s[3] = v[i][3]; }
    asm volatile("s_waitcnt lgkmcnt(0)" ::: "memory");
    const int c = lane & 7;
#pragma unroll
    for (int j = 0; j < 8; ++j) { const int n = (lane >> 3) + 8 * j; const LAS float* s = scr + (8 * c) * 65 + n;
        u32x4 o; o.x = cvtpk(s[0 * 65], s[1 * 65]); o.y = cvtpk(s[2 * 65], s[3 * 65]); o.z = cvtpk(s[4 * 65], s[5 * 65]); o.w = cvtpk(s[6 * 65], s[7 * 65]);
        __builtin_nontemporal_store(o, (u32x4*)(dst + (size_t)(drow + n) * Kd + k0 + 8 * c)); }
    asm volatile("s_waitcnt lgkmcnt(0)" ::: "memory");
}
constexpr int T_FFN = 12 * 2752, T_MI = 4096, T_SQ = 1024, T_CI = 3072, T_ALL = T_FFN + T_MI + 2 * T_SQ + T_CI;
__device__ __forceinline__ void convert_item(const Args& a, int it, LAS float* scr, int lane) {
    bf16_t* WGU = (bf16_t*)(a.ws + WS_WGU); bf16_t* WD = (bf16_t*)(a.ws + WS_WD);
        const float* src; int ldn, k0, n0, Kd, drow; bf16_t* dst;
        if (it < T_FFN) { const int m = it / 2752, r = it % 2752, f = m / 3, kind = m % 3;
            if (kind < 2) { k0 = (r / 86) * 64; n0 = (r % 86) * 64; src = a.in[kind ? I_WU : I_WG] + (size_t)f * DM * DFF; ldn = DFF; Kd = DM; dst = WGU + (size_t)f * 2 * DFF * DM; drow = (n0 >> 7) * 256 + kind * 128 + (n0 & 127); }
            else { k0 = (r / 32) * 64; n0 = (r % 32) * 64; src = a.in[I_WDN] + (size_t)f * DFF * DM; ldn = DM; Kd = DFF; dst = WD + (size_t)f * DM * DFF; drow = n0; }
        } else if (it < T_FFN + T_MI) { const int r = it - T_FFN; k0 = (r / 128) * 64; n0 = (r % 128) * 64; src = a.in[I_MIXIN]; ldn = MIXIN; Kd = DM; dst = (bf16_t*)(a.ws + WS_WMI); drow = n0; }
        else if (it < T_FFN + T_MI + T_SQ) { const int r = it - T_FFN - T_MI; k0 = (r / 32) * 64; n0 = (r % 32) * 64; src = a.in[I_MIXOUT]; ldn = DM; Kd = DM; dst = (bf16_t*)(a.ws + WS_WMO); drow = n0; }
        else if (it < T_FFN + T_MI + 2 * T_SQ) { const int r = it - T_FFN - T_MI - T_SQ; k0 = (r / 32) * 64; n0 = (r % 32) * 64; src = a.in[I_CWOUT]; ldn = DM; Kd = DM; dst = (bf16_t*)(a.ws + WS_WCO); drow = n0; }
        else { const int r = it - T_FFN - T_MI - 2 * T_SQ; k0 = (r / 96) * 64; n0 = (r % 96) * 64; src = a.in[I_CWIN]; ldn = 3 * DM; Kd = DM; dst = (bf16_t*)(a.ws + WS_WCI);
            if (n0 < DM) drow = n0; else if (n0 < 2 * DM) { const int j = n0 - DM; drow = DM + (j >> 7) * 256 + (j & 127); } else { const int j = n0 - 2 * DM; drow = DM + (j >> 7) * 256 + 128 + (j & 127); } }
        transpose_item(src, ldn, k0, n0, dst, Kd, drow, scr, lane);
}
#ifndef NSTEAL
#define NSTEAL 4
#endif
__device__ __forceinline__ void convert_steal(const Args& a, LAS unsigned char* lds, unsigned* ctr, int lo1, int n1, int lo2, int n2, int lo3 = 0, int n3 = 0) {
    const int tid = otid(), w = __builtin_amdgcn_readfirstlane(tid >> 6), lane = tid & 63;
    LAS float* scr = (LAS float*)lds + w * (64 * 65);
    volatile LAS int* bc = (volatile LAS int*)(lds + LDS_BYTES - 32);
    const int n = n1 + n2 + n3;
    for (;;) {
        __syncthreads();
        if (tid == 0) bc[0] = (int)__hip_atomic_fetch_add(ctr, (unsigned)NSTEAL, __ATOMIC_RELAXED, __HIP_MEMORY_SCOPE_AGENT);
        __syncthreads();
        const int base = bc[0];
        if (base >= n) break;
        const int j = base + w;
        if (w < NSTEAL && j < n) convert_item(a, j < n1 ? lo1 + j : (j < n1 + n2 ? lo2 + (j - n1) : lo3 + (j - n1 - n2)), scr, lane);
    }
}
__device__ __forceinline__ void gemv_fill(const Args& a, LAS unsigned char* lds) {
    LAS float* sc = (LAS float*)lds;
    for (int i = otid(); i < 5 * 2048; i += 512) { const float v = i < 8192 ? a.in[I_C][i] : a.in[I_CCTX][i - 8192]; sc[i] = siluf_(v); }
    __syncthreads();
}
__device__ __forceinline__ void gemv_item(const Args& a, LAS unsigned char* lds, int it) {
    const int tid = otid(), w = __builtin_amdgcn_readfirstlane(tid >> 6), lane = tid & 63;
    LAS float* sc = (LAS float*)lds; LAS float* red = sc + 5 * 2048;
    float* MOD = (float*)(a.ws + WS_MOD);
    const int l = it / 288, n0 = (it % 288) * 64, cl = (lane & 15) * 4, ks = lane >> 4;
    const float* W = a.in[I_ADAW] + (size_t)l * DM * MODW + n0 + cl;
    f32x4 acc[5] = {};
#pragma unroll 8
    for (int kk = 0; kk < 256; kk += 4) { const int k = w * 256 + kk + ks; const f32x4 wv = __builtin_nontemporal_load((const f32x4*)(W + (size_t)k * MODW));
#pragma unroll
        for (int i = 0; i < 5; ++i) acc[i] += wv * sc[i * 2048 + k]; }
#pragma unroll
    for (int i = 0; i < 5; ++i)
#pragma unroll
        for (int e = 0; e < 4; ++e) { float v = acc[i][e]; v += __shfl_xor(v, 16); v += __shfl_xor(v, 32); acc[i][e] = v; }
    if (lane < 16) {
#pragma unroll
        for (int i = 0; i < 5; ++i) *(LAS f32x4*)(red + (w * 5 + i) * 64 + cl) = acc[i]; }
    __syncthreads();
    if (tid < 320) { const int i = tid >> 6, cc = tid & 63; float s = a.in[I_ADAB][l * MODW + n0 + cc];
#pragma unroll
        for (int x = 0; x < 8; ++x) s += red[(x * 5 + i) * 64 + cc];
        MOD[((size_t)l * 5 + i) * MODW + n0 + cc] = s; }
    __syncthreads();
}
__device__ __forceinline__ void gemv_steal(const Args& a, LAS unsigned char* lds, unsigned* ctr, int lo, int n) {
    volatile LAS int* bc = (volatile LAS int*)(lds + LDS_BYTES - 32);
    bool filled = false;
    for (;;) {
        __syncthreads();
        if (otid() == 0) bc[0] = (int)__hip_atomic_fetch_add(ctr, 1u, __ATOMIC_RELAXED, __HIP_MEMORY_SCOPE_AGENT);
        __syncthreads();
        const int j = bc[0];
        if (j >= n) break;
        if (!filled) { gemv_fill(a, lds); filled = true; }
        gemv_item(a, lds, lo + j);
    }
}
__device__ __forceinline__ void phase0(const Args& a, LAS unsigned char* lds, int G) {
    const int tid = otid(), w = __builtin_amdgcn_readfirstlane(tid >> 6), lane = tid & 63, bid = obid();
    { const int id = bid * 512 + tid; if (id < 1024) { const int pos = id >> 4, i = id & 15; const float fr = __builtin_amdgcn_exp2f(-(float)i * (13.287712379549449f / 16.f)); const float ang = (float)pos * fr;
        ((f32x2*)(a.ws + WS_ROPE))[id] = (f32x2){__cosf(ang), __sinf(ang)}; } }
    gemv_fill(a, lds);
    for (int it = bid; it < 64; it += G) gemv_item(a, lds, it);
    LAS float* scr = (LAS float*)lds + w * (64 * 65);
    for (int it = bid * 8 + w; it < 3 * 2752; it += G * 8) convert_item(a, it, scr, lane);
}

struct RowP { const bf16_t* xinb; bf16_t* xoutb; const bf16_t* y; const float* xin; const float* ctxin; float* xout; bf16_t* h; int modeR; float wgt; const float* modg; int gidx; const float* gpost; const float* modh; int sidx; const float* gpre; int has_y, has_h; };
__device__ __forceinline__ void row_phase(const RowP& p, int G) {
    const int tid = otid(), w = tid >> 6, lane = tid & 63;
    const int nrows = p.modeR ? MR : ML;
    for (int r0 = (obid() * 8 + w) * 2; r0 < nrows; r0 += G * 16) {
        int mi; const float* xrow; float* xo; size_t lrow = 0;
        if (p.modeR) { const int b = r0 / RS, s = r0 % RS; if (s < CTX) { mi = 4; xrow = p.ctxin + (size_t)(b * CTX + s) * DM; xo = nullptr; } else { mi = b; lrow = (size_t)(b * SEQ + s - CTX); xrow = p.xin + lrow * DM; xo = p.xout; } }
        else { mi = r0 / SEQ; lrow = (size_t)r0; xrow = p.xin + lrow * DM; xo = p.xout; }
        const bool isctx = p.modeR && mi == 4;
        f32x4 xv[2][4][2]; u32x4 yv[2][4];
        if (p.xinb && !isctx) {
#pragma unroll
            for (int q = 0; q < 2; ++q)
#pragma unroll
                for (int j = 0; j < 4; ++j) { const u32x4 xx = *(const u32x4*)(p.xinb + (lrow + q) * DM + 8 * lane + 512 * j);
                    xv[q][j][0] = (f32x4){bflo(xx[0]), bfhi(xx[0]), bflo(xx[1]), bfhi(xx[1])}; xv[q][j][1] = (f32x4){bflo(xx[2]), bfhi(xx[2]), bflo(xx[3]), bfhi(xx[3])}; }
        } else {
#pragma unroll
            for (int q = 0; q < 2; ++q)
#pragma unroll
                for (int j = 0; j < 4; ++j) { const float* xp = xrow + (size_t)q * DM + 8 * lane + 512 * j; xv[q][j][0] = *(const f32x4*)xp; xv[q][j][1] = *(const f32x4*)(xp + 4); }
        }
        if (p.has_y) {
#pragma unroll
            for (int q = 0; q < 2; ++q)
#pragma unroll
                for (int j = 0; j < 4; ++j) yv[q][j] = *(const u32x4*)(p.y + (size_t)(r0 + q) * DM + 8 * lane + 512 * j);
            float ss[2] = {0.f, 0.f};
#pragma unroll
            for (int q = 0; q < 2; ++q)
#pragma unroll
                for (int j = 0; j < 4; ++j)
#pragma unroll
                    for (int e = 0; e < 4; ++e) { const float a = bflo(yv[q][j][e]), b = bfhi(yv[q][j][e]); ss[q] += a * a + b * b; }
            const float ry0 = rsqrtf(wave_sum(ss[0]) * (1.f / DM) + EPS) * p.wgt, ry1 = rsqrtf(wave_sum(ss[1]) * (1.f / DM) + EPS) * p.wgt;
            const float* gate = p.modg + (size_t)mi * MODW + p.gidx * DM;
#pragma unroll
            for (int j = 0; j < 4; ++j) { const int c = 8 * lane + 512 * j;
                const f32x4 gt0 = *(const f32x4*)(gate + c) * *(const f32x4*)(p.gpost + c), gt1 = *(const f32x4*)(gate + c + 4) * *(const f32x4*)(p.gpost + c + 4);
#pragma unroll
                for (int q = 0; q < 2; ++q) { const float ry = q ? ry1 : ry0; const u32x4 yy = yv[q][j];
                    const f32x4 y0 = {bflo(yy[0]), bfhi(yy[0]), bflo(yy[1]), bfhi(yy[1])}, y1 = {bflo(yy[2]), bfhi(yy[2]), bflo(yy[3]), bfhi(yy[3])};
                    xv[q][j][0] = xv[q][j][0] + gt0 * (y0 * ry); xv[q][j][1] = xv[q][j][1] + gt1 * (y1 * ry);
                    if (!isctx) { if (p.xoutb) *(u32x4*)(p.xoutb + (lrow + q) * DM + c) = (u32x4){cvtpk(xv[q][j][0][0], xv[q][j][0][1]), cvtpk(xv[q][j][0][2], xv[q][j][0][3]), cvtpk(xv[q][j][1][0], xv[q][j][1][1]), cvtpk(xv[q][j][1][2], xv[q][j][1][3])};
                                  else { float* op = xo + (lrow + q) * DM + c; *(f32x4*)op = xv[q][j][0]; *(f32x4*)(op + 4) = xv[q][j][1]; } } } }
        }
        if (p.has_h) {
            float ss[2] = {0.f, 0.f};
#pragma unroll
            for (int q = 0; q < 2; ++q)
#pragma unroll
                for (int j = 0; j < 4; ++j)
#pragma unroll
                    for (int k = 0; k < 2; ++k) { const f32x4 v = xv[q][j][k]; ss[q] += (v[0] * v[0] + v[1] * v[1]) + (v[2] * v[2] + v[3] * v[3]); }
            const float rx0 = rsqrtf(wave_sum(ss[0]) * (1.f / DM) + EPS), rx1 = rsqrtf(wave_sum(ss[1]) * (1.f / DM) + EPS);
            const float* sh = p.modh + (size_t)mi * MODW + p.sidx * DM; const float* scl = sh + DM;
#pragma unroll
            for (int j = 0; j < 4; ++j) { const int c = 8 * lane + 512 * j;
                const f32x4 m0 = *(const f32x4*)(p.gpre + c) * (*(const f32x4*)(scl + c) + 1.f), m1 = *(const f32x4*)(p.gpre + c + 4) * (*(const f32x4*)(scl + c + 4) + 1.f);
                const f32x4 s0 = *(const f32x4*)(sh + c), s1 = *(const f32x4*)(sh + c + 4);
#pragma unroll
                for (int q = 0; q < 2; ++q) { const float rx = q ? rx1 : rx0;
                    const f32x4 h0 = (xv[q][j][0] * rx) * m0 + s0, h1 = (xv[q][j][1] * rx) * m1 + s1;
                    *(u32x4*)(p.h + (size_t)(r0 + q) * DM + c) = (u32x4){cvtpk(h0[0], h0[1]), cvtpk(h0[2], h0[3]), cvtpk(h1[0], h1[1]), cvtpk(h1[2], h1[3])}; } }
        }
    }
}

__device__ __forceinline__ float half_sum(float v) {
#pragma unroll
    for (int o = 1; o < 32; o <<= 1) v += __shfl_xor(v, o);
    return v;
}
__device__ __forceinline__ void merge_phase(const Args& a, int G) {
    const int tid = otid(), w = tid >> 6, lane = tid & 63, l32 = lane & 31, hsel = lane >> 5;
    const float* dl = a.in[I_DLAM];
    const float s01 = wave_sum(dl[lane] * dl[64 + lane]), s23 = wave_sum(dl[128 + lane] * dl[192 + lane]);
    const float lam = __expf(s01) - __expf(s23) + 0.2f;
    const float* OA = (const float*)(a.ws + WS_OATT); const float* OR = (const float*)(a.ws + WS_OREC); const bf16_t* MP = (const bf16_t*)(a.ws + WS_MP); bf16_t* MG = (bf16_t*)(a.ws + WS_MG);
    const f32x4 ga = *(const f32x4*)(a.in[I_DNG] + 4 * l32) * 0.8f, gr = *(const f32x4*)(a.in[I_RNG] + 4 * l32);
    for (int lr = obid() * 8 + w; lr < ML; lr += G * 8) {
        const int b = lr / SEQ; const size_t rrow = (size_t)(lr + 256 * (b + 1));
        f32x4 o1[4], o2[4], of[4], ob[4]; u32x2 gw[4];
#pragma unroll
        for (int hp = 0; hp < 4; ++hp) { const size_t c0 = (size_t)lr * 1024 + (2 * hp + hsel) * 128 + 4 * l32;
            o1[hp] = *(const f32x4*)(OA + c0); o2[hp] = *(const f32x4*)(OA + (size_t)ML * 1024 + c0);
            of[hp] = *(const f32x4*)(OR + c0); ob[hp] = *(const f32x4*)(OR + (size_t)ML * 1024 + c0);
            gw[hp] = *(const u32x2*)(MP + rrow * MIXIN + 7168 + (2 * hp + hsel) * 128 + 4 * l32); }
#pragma unroll
        for (int hp = 0; hp < 4; ++hp) { const int c0 = (2 * hp + hsel) * 128 + 4 * l32;
            const f32x4 d = o1[hp] - o2[hp] * lam; const float r = rsqrtf(half_sum((d[0] * d[0] + d[1] * d[1]) + (d[2] * d[2] + d[3] * d[3])) * (1.f / 128.f) + EPS);
            const f32x4 x = d * r * ga;
            *(u32x2*)(MG + (size_t)lr * DM + c0) = (u32x2){cvtpk(x[0], x[1]), cvtpk(x[2], x[3])};
            const f32x4 o = of[hp] + ob[hp]; const float rr = rsqrtf(half_sum((o[0] * o[0] + o[1] * o[1]) + (o[2] * o[2] + o[3] * o[3])) * (1.f / 128.f) + EPS);
            const f32x4 g = {siluf_(bflo(gw[hp][0])), siluf_(bfhi(gw[hp][0])), siluf_(bflo(gw[hp][1])), siluf_(bfhi(gw[hp][1]))};
            const f32x4 y = o * rr * gr * g;
            *(u32x2*)(MG + (size_t)lr * DM + 1024 + c0) = (u32x2){cvtpk(y[0], y[1]), cvtpk(y[2], y[3])}; }
    }
}

__device__ __forceinline__ void conv_phase(const Args& a, int G) {
    const bf16_t* BG = (const bf16_t*)(a.ws + WS_MP); const bf16_t* CV = BG + (size_t)ML * DM; bf16_t* MG = (bf16_t*)(a.ws + WS_MG); const float* cw = a.in[I_CW];
    const int tid = otid(), c = (tid & 255) * 8, rh = tid >> 8;
    f32x4 w0[2], w1[2], w2[2];
#pragma unroll
    for (int k = 0; k < 2; ++k) { w0[k] = *(const f32x4*)(cw + c + 4 * k); w1[k] = *(const f32x4*)(cw + DM + c + 4 * k); w2[k] = *(const f32x4*)(cw + 2 * DM + c + 4 * k); }
    const u32x4 z = {0u, 0u, 0u, 0u};
    for (int it = obid(); it < ML / 16; it += G) {
        const int r0 = it * 16 + rh * 8;
        const int t0 = r0 & (SEQ - 1);
        u32x4 prev = t0 > 0 ? *(const u32x4*)(CV + (size_t)(r0 - 1) * DM + c) : z;
        u32x4 cur = *(const u32x4*)(CV + (size_t)r0 * DM + c);
#pragma unroll
        for (int i = 0; i < 8; ++i) {
            const int lr = r0 + i;
            const u32x4 nxt = (t0 + i < SEQ - 1) ? *(const u32x4*)(CV + (size_t)(lr + 1) * DM + c) : z;
            const u32x4 bg = *(const u32x4*)(BG + (size_t)lr * DM + c);
            u32x4 o;
#pragma unroll
            for (int e = 0; e < 4; ++e) { const int k = e >> 1, q = (e & 1) * 2;
                const float lo = bflo(bg[e]) * (w0[k][q] * bflo(prev[e]) + w1[k][q] * bflo(cur[e]) + w2[k][q] * bflo(nxt[e]));
                const float hi = bfhi(bg[e]) * (w0[k][q + 1] * bfhi(prev[e]) + w1[k][q + 1] * bfhi(cur[e]) + w2[k][q + 1] * bfhi(nxt[e]));
                o[e] = cvtpk(lo, hi); }
            *(u32x4*)(MG + (size_t)lr * DM + c) = o;
            prev = cur; cur = nxt;
        }
    }
}

#define XB_TMO      128
#define XB_XCNT(j)  (256  + 64 * (j))
#define XB_XSUB(j)  (1280 + 64 * (j))
#define XB_XGEN(j)  (2304 + 64 * (j))
#define XB_TOP      3328
#define XB_TOPGEN   3392
#define XCD_BAR_WORDS 3456
#define XB_SPIN_CAP (1u << 18)

__device__ __forceinline__ unsigned xb_ld(unsigned* p)              { return __hip_atomic_load(p, __ATOMIC_RELAXED, __HIP_MEMORY_SCOPE_AGENT); }
__device__ __forceinline__ unsigned xb_add(unsigned* p, unsigned v) { return __hip_atomic_fetch_add(p, v, __ATOMIC_RELAXED, __HIP_MEMORY_SCOPE_AGENT); }
__device__ __forceinline__ unsigned xb_xcc_id() { return (unsigned)__builtin_amdgcn_s_getreg((3 << 11) | 20) & 0xFu; }
#define XB_SPIN(cond, bar) do { unsigned _sp = 0; while (cond) { __builtin_amdgcn_s_sleep(1); \
    if ((++_sp & 255u) == 0u) { if (xb_ld(&(bar)[XB_TMO])) break; if (_sp > XB_SPIN_CAP) { atomicAdd(&(bar)[XB_TMO], 1u); break; } } } } while (0)

struct XcdBarrier {
    unsigned* bar; unsigned x;
    volatile LAS unsigned* st;
};

__device__ __forceinline__ XcdBarrier xcd_barrier_post(unsigned* bar, volatile LAS unsigned* st) {
    XcdBarrier b; b.bar = bar; b.x = xb_xcc_id(); b.st = st;
    if (threadIdx.x == 0) (void)xb_add(&bar[XB_XCNT(b.x)], 1u);
    return b;
}
__device__ __forceinline__ void xcd_barrier_complete(unsigned* bar, unsigned x, unsigned& nloc, unsigned& nx) {
    const unsigned G = gridDim.x * gridDim.y * gridDim.z;
    unsigned sum, cnt, mine, sp = 0u;
    for (;;) {
        sum = 0u; cnt = 0u; mine = 0u;
#pragma unroll
        for (unsigned j = 0; j < 16; ++j) { const unsigned c = xb_ld(&bar[XB_XCNT(j)]); sum += c; cnt += (c > 0u) ? 1u : 0u; mine = (j == x) ? c : mine; }
        if (sum == G) break;
        __builtin_amdgcn_s_sleep(1);
        if ((++sp & 255u) == 0u) { if (xb_ld(&bar[XB_TMO])) break; if (sp > XB_SPIN_CAP) { atomicAdd(&bar[XB_TMO], 1u); break; } }
    }
    nloc = mine > 0u ? mine : 1u; nx = cnt > 0u ? cnt : 1u;
}

__device__ __forceinline__ void xcd_barrier(const XcdBarrier& b) {
    asm volatile("s_waitcnt vmcnt(0)" ::: "memory");
    __syncthreads();
    if (threadIdx.x == 0) {
        unsigned* bar = b.bar;
        __builtin_amdgcn_s_waitcnt(0);
        unsigned nloc = b.st[0], nx = b.st[1];
        if (nloc == 0u) { xcd_barrier_complete(bar, b.x, nloc, nx); b.st[0] = nloc; b.st[1] = nx; }
        const unsigned old = xb_add(&bar[XB_XSUB(b.x)], 1u);
        const unsigned gen = old / nloc;
        if (old + 1u == (gen + 1u) * nloc) {
            __builtin_amdgcn_fence(__ATOMIC_RELEASE, "agent");
            asm volatile("s_waitcnt vmcnt(0)" ::: "memory");
            const unsigned og = xb_add(&bar[XB_TOP], 1u);
            const unsigned tg = og / nx;
            if (og + 1u == (tg + 1u) * nx) xb_add(&bar[XB_TOPGEN], 1u);
            else XB_SPIN(xb_ld(&bar[XB_TOPGEN]) == tg, bar);
            __builtin_amdgcn_fence(__ATOMIC_ACQUIRE, "agent");
            xb_add(&bar[XB_XGEN(b.x)], 1u);
            asm volatile("s_waitcnt vmcnt(0)" ::: "memory");
        } else {
            XB_SPIN(xb_ld(&bar[XB_XGEN(b.x)]) == gen, bar);
            __builtin_amdgcn_fence(__ATOMIC_ACQUIRE, "agent");
            asm volatile("s_waitcnt vmcnt(0)" ::: "memory");
        }
    }
    __syncthreads();
}

#define CTR_WORD(k) (3520 + 64 * (k))
#ifndef PHMASK
#define PHMASK 0x1ff
#endif
#define PHM(x) (((PHMASK) >> (x)) & 1)
__global__ void __launch_bounds__(512, 2) mega(Args a) {
    extern __shared__ __attribute__((aligned(16))) unsigned char smem[];
    LAS unsigned char* lds = (LAS unsigned char*)smem;
    const int G = gridDim.x;
    unsigned char* ws = a.ws;
    bf16_t* H = (bf16_t*)(ws + WS_H); bf16_t* ACT = (bf16_t*)(ws + WS_ACT); bf16_t* Y = (bf16_t*)(ws + WS_Y); bf16_t* MP = (bf16_t*)(ws + WS_MP); bf16_t* MG = (bf16_t*)(ws + WS_MG);
    const float* MOD = (const float*)(ws + WS_MOD);
#if MK_DIAG_ZERO
    for (int i = otid(); i < LDS_BYTES / 4; i += 512) ((LAS unsigned*)lds)[i] = 0u;
    __syncthreads();
#endif
    XcdBarrier bar; bar.bar = (unsigned*)(ws + WS_BAR); bar.x = 0; bar.st = (volatile LAS unsigned*)(lds + LDS_BYTES - 16);
    unsigned* const ctrs = (unsigned*)(ws + WS_BAR);
    if (a.ph_lo < 0) cg::this_grid().sync();
    if (otid() < 4) ((LAS unsigned*)(lds + LDS_BYTES - 16))[otid()] = 0u;
    __syncthreads();
    if (a.ph_hi - a.ph_lo > 1) bar = xcd_barrier_post((unsigned*)(ws + WS_BAR), (volatile LAS unsigned*)(lds + LDS_BYTES - 16));
    for (int ph = a.ph_lo; ph < a.ph_hi; ++ph) {
      for (int rep = 0; rep < (((MK_PROBE >> ph) & 1) ? 2 : 1); ++rep) {
        const int bid = obid();
        if (PHM(0) && ph == 0) { phase0(a, lds, G); }
        else if (PHM(1) && (ph == 1 || ph == 4 || ph == 9 || ph == 12 || ph == 15 || ph == 19 || ph == 22)) {
            RowP p; p.y = Y; p.ctxin = a.in[I_CTX]; p.xout = a.out; p.h = H;
            bf16_t* XB = (bf16_t*)(ws + WS_XB);
            p.modeR = (ph <= 4); p.xin = a.in[I_X]; p.xinb = (ph <= 4) ? nullptr : XB; p.xoutb = (ph == 22) ? nullptr : XB; p.has_y = (ph != 1); p.has_h = (ph != 22);
            const int lg = (ph <= 12) ? 0 : 1;
            const int lh = (ph <= 9) ? 0 : 1;
            const int sub = (ph == 4 || ph == 15) ? 0 : (ph == 9 || ph == 19) ? 1 : 2;
            const int nxt = (ph == 1 || ph == 12) ? 0 : (ph == 4 || ph == 15) ? 1 : 2;
            p.wgt = (sub == 1) ? 1.f : 0.5f;
            p.modg = MOD + (size_t)lg * 5 * MODW; p.gidx = 3 * sub + 2; p.gpost = a.in[I_NORMG] + (size_t)(lg * 6 + 2 * sub + 1) * DM;
            p.modh = MOD + (size_t)lh * 5 * MODW; p.sidx = 3 * nxt; p.gpre = a.in[I_NORMG] + (size_t)(lh * 6 + 2 * nxt) * DM;
            row_phase(p, G);
        }
        else if (PHM(2) && (ph == 2 || ph == 10 || ph == 13 || ph == 20)) {
            const int f = (ph == 2) ? 0 : (ph == 10) ? 1 : (ph == 13) ? 2 : 3; const int M = (ph == 2) ? MR : ML;
            pg8::Gemm g{H, (const bf16_t*)(ws + WS_WGU + (size_t)f * SZ_WGU), M, 2 * DFF, DM}; pg8::FlexOrder S; S.init(M, 2 * DFF, G, bid, (ph == 2 && G == 256) ? 1 : 0);
            pg8::EpiPair E{ACT, DFF, nullptr, 0, 0, 1};
            pg8::gemm_phase<pg8::EpiPair, pg8::FlexOrder, true, true>(lds, g, S, E);
            if (ph == 10) convert_steal(a, lds, ctrs + CTR_WORD(2), 9 * 2752, 2752, 0, 0);
            else if (ph == 13) convert_steal(a, lds, ctrs + CTR_WORD(3), 10 * 2752, 2752, 0, 0);
        }
        else if (PHM(2) && ph == 16) {
            pg8::Gemm g{H, (const bf16_t*)(ws + WS_WCI), ML, 3 * DM, DM}; pg8::StaticOrder S; S.init(ML, 3 * DM, G, bid);
            pg8::EpiPair E{MP + (size_t)ML * DM, DM, MP, DM, 8, 0};
            pg8::gemm_phase<pg8::EpiPair, pg8::StaticOrder, true, true>(lds, g, S, E);
        }
        else if (PHM(3) && (ph == 3 || ph == 11 || ph == 14 || ph == 21 || ph == 8 || ph == 18)) {
            const bool down = !(ph == 8 || ph == 18);
            const int f = (ph == 3) ? 0 : (ph == 11) ? 1 : (ph == 14) ? 2 : 3; const int M = (ph == 3) ? MR : ML;
            const bf16_t* A = down ? ACT : MG; const bf16_t* Bt = down ? (const bf16_t*)(ws + WS_WD + (size_t)f * SZ_WD) : (const bf16_t*)(ws + (ph == 8 ? WS_WMO : WS_WCO));
            const bool defer = (ph == 3) && (G == 256);
            if (defer) {
                pg8::Gemm g0{H, (const bf16_t*)(ws + WS_WGU), MR, 2 * DFF, DM}; pg8::FlexOrder S0; S0.init(MR, 2 * DFF, G, bid, 2);
                pg8::EpiPair E0{ACT, DFF, nullptr, 0, 0, 1};
                pg8::gemm_phase<pg8::EpiPair, pg8::FlexOrder, true, true>(lds, g0, S0, E0);
                if (bid < 12) { __syncthreads();
                    if (otid() == 0) { __builtin_amdgcn_fence(__ATOMIC_RELEASE, "agent"); asm volatile("s_waitcnt vmcnt(0)" ::: "memory");
                                       __hip_atomic_fetch_add(ctrs + CTR_WORD(0), 1u, __ATOMIC_RELAXED, __HIP_MEMORY_SCOPE_AGENT); } }
            }
            pg8::Gemm g{A, Bt, M, DM, down ? DFF : DM}; pg8::FlexOrder S; S.init(M, DM, G, bid, defer ? 3 : 0, ctrs + CTR_WORD(0));
            pg8::EpiB16 E{Y, DM};
            pg8::gemm_phase<pg8::EpiB16, pg8::FlexOrder, true, true>(lds, g, S, E);
            if (ph == 3) { convert_steal(a, lds, ctrs + CTR_WORD(1), 3 * 2752, 3 * 2752, 8 * 2752, 2752, T_FFN, T_MI);
                           gemv_steal(a, lds, ctrs + CTR_WORD(5), 64, 512); }
        }
        else if (PHM(4) && ph == 5) {
            pg8::Gemm g{H, (const bf16_t*)(ws + WS_WMI), MR, MIXIN, DM}; pg8::StaticOrder S; S.init(MR, MIXIN, G, bid);
            pg8::EpiMix E{MP, MIXIN, (const f32x2*)(ws + WS_ROPE)};
            pg8::gemm_phase<pg8::EpiMix, pg8::StaticOrder, true, true>(lds, g, S, E);
            convert_steal(a, lds, ctrs + CTR_WORD(6), T_FFN + T_MI + T_SQ, T_SQ + T_CI, 0, 0);
        }
        else if (ph == 6) {
            float* OATT = (float*)(ws + WS_OATT);
            if (G >= 128) { if (bid < 64 && PHM(5)) hgrn_unit(a, lds, bid); }
            else { for (int u = bid; u < 64; u += G) if (PHM(5)) hgrn_unit(a, lds, u); }
            volatile LAS int* bc = (volatile LAS int*)(lds + LDS_BYTES - 32);
            for (;;) {
                __syncthreads();
                if (otid() == 0) bc[0] = (int)__hip_atomic_fetch_add(ctrs + CTR_WORD(4), 1u, __ATOMIC_RELAXED, __HIP_MEMORY_SCOPE_AGENT);
                __syncthreads();
                const int u = bc[0];
                if (u >= 512) break;
                const int qb = u & 7, mp = (u >> 3) & 1, h = (u >> 4) & 7, b = u >> 7;
                const bf16_t* base = MP + (size_t)(b * RS) * MIXIN;
                if (PHM(6)) att::attn_body(base + (size_t)(CTX + qb * 256) * MIXIN + h * 128 + mp * 64, base + 1024 + h * 128 + mp * 64, base + 2048 + h * 128,
                               OATT + (size_t)mp * ML * 1024 + (size_t)(b * SEQ + qb * 256) * 1024 + h * 128, RS, (char*)smem);
            }
            convert_steal(a, lds, ctrs + CTR_WORD(7), T_FFN + T_MI, T_SQ, 0, 0);
            convert_steal(a, lds, ctrs + CTR_WORD(8), 6 * 2752, 2 * 2752, 11 * 2752, 2752);
        }
        else if (PHM(7) && ph == 7) { merge_phase(a, G); }
        else if (PHM(8) && ph == 17) { conv_phase(a, G); }
        if (ph + 1 < a.ph_hi) xcd_barrier(bar);
      }
    }

}

extern "C" void kernel_launch(void* const* d_in, const int* in_sizes, int n_in, void* d_out, int out_size, void* d_ws, size_t ws_size, hipStream_t stream) {
    static int grid = 0;
    if (grid == 0) {
        if (n_in != 19 || out_size != ML * DM || ws_size < WS_END) { fprintf(stderr, "kernel_launch: unexpected shapes: n_in %d out %d ws %zu (need %zu)\n", n_in, out_size, ws_size, (size_t)WS_END); grid = -1; return; }
        int dev = 0, cus = 0, per_cu = 0;
        hipGetDevice(&dev); hipDeviceGetAttribute(&cus, hipDeviceAttributeMultiprocessorCount, dev);
        if (hipFuncSetAttribute((const void*)mega, hipFuncAttributeMaxDynamicSharedMemorySize, LDS_BYTES) != hipSuccess) { fprintf(stderr, "kernel_launch: hipFuncSetAttribute failed\n"); grid = -1; return; }
        if (hipOccupancyMaxActiveBlocksPerMultiprocessor(&per_cu, (const void*)mega, 512, LDS_BYTES) != hipSuccess || per_cu < 1) { fprintf(stderr, "kernel_launch: occupancy query gave %d\n", per_cu); per_cu = 1; }
        (void)hipGetLastError();
        grid = cus * per_cu;
        fprintf(stderr, "kernel_launch: grid %d (cus %d x %d)\n", grid, cus, per_cu);
    }
    if (grid < 0) return;
#if MK_DIAG_ZERO
    (void)hipMemsetAsync(d_ws, 0, WS_END, stream);
    (void)hipMemsetAsync(d_out, 0, (size_t)ML * DM * 4, stream);
#endif
    (void)hipMemsetAsync((unsigned char*)d_ws + WS_BAR, 0, 16384, stream);
    Args a{};
    for (int i = 0; i < 19; ++i) a.in[i] = (const float*)d_in[i];
    a.out = (float*)d_out; a.ws = (unsigned char*)d_ws;
#if MK_MULTI
    for (int ph = 0; ph < NPHASE; ++ph) { a.ph_lo = ph; a.ph_hi = ph + 1; hipLaunchKernelGGL(mega, dim3(grid), dim3(512), LDS_BYTES, stream, a); }
#else
    a.ph_lo = 0; a.ph_hi = NPHASE;
    void* args[] = {&a};
    hipError_t e = hipLaunchCooperativeKernel((const void*)mega, dim3(grid), dim3(512), args, LDS_BYTES, stream);
    if (e != hipSuccess) fprintf(stderr, "kernel_launch: cooperative launch failed: %s (grid %d)\n", hipGetErrorString(e), grid);
#endif
}
```
